# Optimizing an MI355X kernel written in HIP

```python
import jax, jax.numpy as jnp
from jax import lax
import numpy as np

D_MODEL = 2048
BATCH = 8
SEQ = 4096
DEPTH = 1

D_MIX = D_MODEL
RET_WIDTH = D_MIX // 2
GDN_WIDTH = D_MIX - RET_WIDTH
RET_HEADS = 4
RET_V_DIM = RET_WIDTH // RET_HEADS
RET_QK_DIM = RET_V_DIM // 2
RET_QK_WIDTH = RET_HEADS * RET_QK_DIM
RET_CHUNK = 128
ROPE_BASE = 10000.0
GDN_HEAD_DIM = 128
GDN_HEADS = GDN_WIDTH // GDN_HEAD_DIM
GDN_CHUNK = 64
CONV_WIDTH = 4
RMS_EPS = 1e-6
GN_EPS = 1e-5
LN_EPS = 1e-5
DEEPNORM_ALPHA = (2.0 * DEPTH) ** 0.25
DEEPNORM_BETA = (8.0 * DEPTH) ** -0.25
IN_COLS = 2 * RET_QK_WIDTH + 2 * RET_WIDTH + 4 * GDN_WIDTH + 2 * GDN_HEADS

kernel_name = "hybrid_retention_gated_deltanet_deepnorm_adaln"

f32 = jnp.float32


def _split_sizes():
    return [RET_QK_WIDTH, RET_QK_WIDTH, RET_WIDTH, RET_WIDTH,
            3 * GDN_WIDTH, GDN_WIDTH, GDN_HEADS, GDN_HEADS]


def _split_points():
    pts, acc = [], 0
    for s in _split_sizes()[:-1]:
        acc += s
        pts.append(acc)
    return pts


def _to_chunks(t, chunk):
    b, t_len, h, d = t.shape
    return t.reshape(b, t_len // chunk, chunk, h, d).transpose(1, 0, 3, 2, 4)


def _from_chunks(t):
    n, b, h, c, d = t.shape
    return t.transpose(1, 0, 3, 2, 4).reshape(b, n * c, h, d)


def _rotary(t):
    t_len, d = t.shape[1], t.shape[-1]
    inv_freq = 1.0 / (ROPE_BASE ** (jnp.arange(0, d, 2, dtype=f32) / d))
    ang = jnp.arange(t_len, dtype=f32)[:, None] * inv_freq[None, :]
    cos = jnp.cos(ang)[None, :, None, :]
    sin = jnp.sin(ang)[None, :, None, :]
    t1, t2 = t[..., : d // 2], t[..., d // 2:]
    return jnp.concatenate([t1 * cos - t2 * sin, t1 * sin + t2 * cos], axis=-1)


def _retention(q, k, v):
    b, t_len, h, dk = q.shape
    dv = v.shape[-1]
    c = RET_CHUNK
    log_gamma = jnp.log(1.0 - 2.0 ** (-5.0 - jnp.arange(h, dtype=f32)))
    qc = _to_chunks(q, c)
    kc = _to_chunks(k * (dk ** -0.5), c)
    vc = _to_chunks(v, c)
    idx = jnp.arange(c, dtype=f32)
    diff = idx[:, None] - idx[None, :]
    decay = jnp.where(diff[None] >= 0,
                      jnp.exp(log_gamma[:, None, None] * jnp.maximum(diff, 0.0)[None]), 0.0)
    scores = jnp.einsum('nbhid,nbhjd->nbhij', qc, kc) * decay[None, None]
    intra = jnp.einsum('nbhij,nbhje->nbhie', scores, vc)
    q_dec = jnp.exp(log_gamma[:, None] * (idx[None, :] + 1.0))
    k_dec = jnp.exp(log_gamma[:, None] * (c - 1.0 - idx[None, :]))
    chunk_dec = jnp.exp(log_gamma * c)

    def step(state, inp):
        q_i, k_i, v_i = inp
        o = jnp.einsum('bhid,bhde->bhie', q_i, state) * q_dec[None, :, :, None]
        state = state * chunk_dec[None, :, None, None] + jnp.einsum(
            'bhjd,bhje->bhde', k_i * k_dec[None, :, :, None], v_i)
        return state, o

    s0 = jnp.zeros((b, h, dk, dv), f32)
    _, inter = lax.scan(step, s0, (qc, kc, vc))
    return _from_chunks(intra + inter)


def _gated_delta(q, k, v, g, beta):
    b, t_len, h, dk = q.shape
    dv = v.shape[-1]
    c = GDN_CHUNK
    n = t_len // c
    qc = _to_chunks(q * (dk ** -0.5), c)
    kc = _to_chunks(k, c)
    vc = _to_chunks(v, c)
    gc = g.reshape(b, n, c, h).transpose(1, 0, 3, 2)
    bc = beta.reshape(b, n, c, h).transpose(1, 0, 3, 2)
    gcum = jnp.cumsum(gc, axis=-1)
    idx = jnp.arange(c)
    tril = idx[:, None] >= idx[None, :]
    strict = idx[:, None] > idx[None, :]
    decay = jnp.exp(jnp.where(tril, gcum[..., :, None] - gcum[..., None, :], -jnp.inf))
    k_beta = kc * bc[..., None]
    v_beta = vc * bc[..., None]
    a_mat = jnp.where(strict, jnp.einsum('nbhid,nbhjd->nbhij', k_beta, kc) * decay, 0.0)
    eye = jnp.eye(c, dtype=f32)
    t_mat = lax.linalg.triangular_solve(eye + a_mat, jnp.broadcast_to(eye, a_mat.shape),
                                        left_side=True, lower=True, unit_diagonal=True)
    v_t = jnp.einsum('nbhij,nbhje->nbhie', t_mat, v_beta)
    k_cumdecay = jnp.einsum('nbhij,nbhjd->nbhid', t_mat, k_beta * jnp.exp(gcum)[..., None])
    attn_intra = jnp.where(tril, jnp.einsum('nbhid,nbhjd->nbhij', qc, kc) * decay, 0.0)
    q_exp = qc * jnp.exp(gcum)[..., None]
    g_last = gcum[..., -1]
    k_tail = kc * jnp.exp(g_last[..., None] - gcum)[..., None]

    def step(state, inp):
        q_e, kcd, vt, attn, kt, gl = inp
        v_new = vt - jnp.einsum('bhcd,bhde->bhce', kcd, state)
        o = jnp.einsum('bhcd,bhde->bhce', q_e, state) + jnp.einsum('bhij,bhje->bhie', attn, v_new)
        state = state * jnp.exp(gl)[..., None, None] + jnp.einsum('bhcd,bhce->bhde', kt, v_new)
        return state, o

    s0 = jnp.zeros((b, h, dk, dv), f32)
    _, out = lax.scan(step, s0, (q_exp, k_cumdecay, v_t, attn_intra, k_tail, g_last))
    return _from_chunks(out)


def _causal_conv(t, w):
    t_len = t.shape[1]
    tp = jnp.pad(t, ((0, 0), (CONV_WIDTH - 1, 0), (0, 0)))
    out = tp[:, 0:t_len] * w[0]
    for j in range(1, CONV_WIDTH):
        out = out + tp[:, j:j + t_len] * w[j]
    return out


def _l2norm(t):
    return t * lax.rsqrt(jnp.sum(t * t, axis=-1, keepdims=True) + RMS_EPS)


def _layernorm(t, w, b):
    t = t.astype(f32)
    mu = jnp.mean(t, axis=-1, keepdims=True)
    var = jnp.mean(jnp.square(t - mu), axis=-1, keepdims=True)
    return (t - mu) * lax.rsqrt(var + LN_EPS) * w + b


def setup_inputs(seed: int = 0) -> dict:
    key = jax.random.key(seed)
    ks = jax.random.split(key, 14)
    x = jax.random.normal(ks[0], (BATCH, SEQ, D_MODEL), f32)
    c = jax.random.normal(ks[1], (BATCH, D_MODEL), f32)
    w_ada = jax.random.normal(ks[2], (DEPTH, D_MODEL, 3 * D_MODEL), f32) * D_MODEL ** -0.5
    b_ada = 0.02 * jax.random.normal(ks[3], (DEPTH, 3 * D_MODEL), f32)
    col_scale = np.concatenate([
        np.ones(2 * RET_QK_WIDTH, np.float32),
        np.full(RET_WIDTH, DEEPNORM_BETA, np.float32),
        np.ones(RET_WIDTH, np.float32),
        np.ones(2 * GDN_WIDTH, np.float32),
        np.full(GDN_WIDTH, DEEPNORM_BETA, np.float32),
        np.ones(GDN_WIDTH + 2 * GDN_HEADS, np.float32)])
    w_in = jax.random.normal(ks[4], (DEPTH, D_MODEL, IN_COLS), f32) * (D_MODEL ** -0.5) * jnp.asarray(col_scale)
    gdn_conv_w = jax.random.normal(ks[5], (DEPTH, CONV_WIDTH, 3 * GDN_WIDTH), f32) * CONV_WIDTH ** -0.5
    gdn_a_log = jnp.log(jax.random.uniform(ks[6], (DEPTH, GDN_HEADS), f32, 1.0, 16.0))
    dt = jnp.exp(jax.random.uniform(ks[7], (DEPTH, GDN_HEADS), f32, float(np.log(1e-3)), float(np.log(1e-1))))
    gdn_dt_bias = dt + jnp.log(-jnp.expm1(-dt))
    ret_gn_w = 1.0 + 0.02 * jax.random.normal(ks[8], (DEPTH, RET_WIDTH), f32)
    ret_gn_b = 0.02 * jax.random.normal(ks[9], (DEPTH, RET_WIDTH), f32)
    gdn_norm_w = 1.0 + 0.02 * jax.random.normal(ks[10], (DEPTH, GDN_HEAD_DIM), f32)
    w_out = jax.random.normal(ks[11], (DEPTH, D_MIX, D_MODEL), f32) * (D_MIX ** -0.5) * DEEPNORM_BETA
    ln_w = 1.0 + 0.02 * jax.random.normal(ks[12], (DEPTH, D_MODEL), f32)
    ln_b = 0.02 * jax.random.normal(ks[13], (DEPTH, D_MODEL), f32)
    return {"x": x, "c": c, "w_ada": w_ada, "b_ada": b_ada, "w_in": w_in,
            "gdn_conv_w": gdn_conv_w, "gdn_a_log": gdn_a_log, "gdn_dt_bias": gdn_dt_bias,
            "ret_gn_w": ret_gn_w, "ret_gn_b": ret_gn_b, "gdn_norm_w": gdn_norm_w,
            "w_out": w_out, "ln_w": ln_w, "ln_b": ln_b}


def reference(x, c, w_ada, b_ada, w_in, gdn_conv_w, gdn_a_log, gdn_dt_bias,
              ret_gn_w, ret_gn_b, gdn_norm_w, w_out, ln_w, ln_b):
    out_dtype = x.dtype
    b, t_len, _ = x.shape
    h_stream = x.astype(f32)
    for l in range(DEPTH):
        mod = (jax.nn.silu(c) @ w_ada[l] + b_ada[l]).astype(f32)
        shift, scale, gate = jnp.split(mod, 3, axis=-1)
        hin = h_stream * (1.0 + scale[:, None, :]) + shift[:, None, :]
        proj = (hin.astype(w_in.dtype) @ w_in[l]).astype(f32)
        r_q, r_k, r_v, r_g, g_qkv, g_g, g_a, g_b = jnp.split(proj, _split_points(), axis=-1)

        rq = _rotary(r_q.reshape(b, t_len, RET_HEADS, RET_QK_DIM))
        rk = _rotary(r_k.reshape(b, t_len, RET_HEADS, RET_QK_DIM))
        rv = r_v.reshape(b, t_len, RET_HEADS, RET_V_DIM)
        ry = _retention(rq, rk, rv)
        mu = jnp.mean(ry, axis=-1, keepdims=True)
        var = jnp.mean(jnp.square(ry - mu), axis=-1, keepdims=True)
        ry = ((ry - mu) * lax.rsqrt(var + GN_EPS)).reshape(b, t_len, RET_WIDTH)
        ret_out = (ry * ret_gn_w[l] + ret_gn_b[l]) * jax.nn.silu(r_g)

        qkv = jax.nn.silu(_causal_conv(g_qkv, gdn_conv_w[l].astype(f32)))
        gq, gk, gv = jnp.split(qkv, 3, axis=-1)
        gq = _l2norm(gq.reshape(b, t_len, GDN_HEADS, GDN_HEAD_DIM))
        gk = _l2norm(gk.reshape(b, t_len, GDN_HEADS, GDN_HEAD_DIM))
        gv = gv.reshape(b, t_len, GDN_HEADS, GDN_HEAD_DIM)
        g_decay = -jnp.exp(gdn_a_log[l].astype(f32)) * jax.nn.softplus(g_a + gdn_dt_bias[l].astype(f32))
        beta = jax.nn.sigmoid(g_b)
        gy = _gated_delta(gq, gk, gv, g_decay, beta)
        gy = gy * lax.rsqrt(jnp.mean(gy * gy, axis=-1, keepdims=True) + RMS_EPS) * gdn_norm_w[l]
        gdn_out = gy.reshape(b, t_len, GDN_WIDTH) * jax.nn.silu(g_g)

        mixed = jnp.concatenate([ret_out, gdn_out], axis=-1)
        y = (mixed.astype(w_out.dtype) @ w_out[l]).astype(f32)
        h_stream = _layernorm(DEEPNORM_ALPHA * h_stream + gate[:, None, :] * y, ln_w[l], ln_b[l])
    return h_stream.astype(out_dtype)
```

```cpp
#include <hip/hip_runtime.h>
#include <hip/hip_cooperative_groups.h>
#include <cstdio>
#include <cstdint>
namespace cg = cooperative_groups;
namespace pg8 {
#define PG8_LAS __attribute__((address_space(3)))
typedef unsigned short bf16_t;
typedef short bf16x8 __attribute__((ext_vector_type(8)));
typedef float f32x4 __attribute__((ext_vector_type(4)));
typedef unsigned u32x4 __attribute__((ext_vector_type(4)));
constexpr int BM = 256, BK = 64, HALF = 128, HTB = HALF * BK * 2  , STAGE_BYTES = 8 * HTB, NXCD = 8, WGM = 8;

__host__ __device__ __forceinline__ int lds_byte(int r, int c) { const int st = (r >> 4) * 2 + (c >> 5), rr = r & 15, cc = c & 31, ob = rr * 64 + cc * 2; return st * 1024 + (ob ^ (((ob >> 9) & 1) << 5)); }
__host__ __device__ __forceinline__ void stage_rc(int b, int& R, int& C) { const int st = b / 1024, sb = b % 1024, swz = sb ^ (((sb >> 9) & 1) << 5); R = (st >> 1) * 16 + swz / 64; C = (st & 1) * 32 + (swz % 64) / 2; }
__host__ __device__ __forceinline__ int perm32(int rho) { const int n = rho >> 4, i = rho & 15; return 8 * (i >> 2) + 4 * n + (i & 3); }

struct Unit { int pm, pn; };
struct Gemm { const bf16_t* A; const bf16_t* Bt; int M, N, K; };

struct StaticOrder {
    int nM, nN, nwg, G, c, nrep;
    __host__ __device__ void init(int M, int N, int G_, int c_, int nrep_ = 1) { nM = M / BM; nN = N / BM; nwg = nM * nN; G = G_; c = c_; nrep = nrep_; }
    __host__ __device__ bool next(int i, Unit& u) const {
        const long L = (long)i * G + c; if (L >= (long)nwg * nrep) return false;
        int wgid = (int)(L % nwg); { const int q = nwg / NXCD, r = nwg % NXCD, xcd = wgid % NXCD, off = wgid / NXCD; wgid = (xcd < r ? xcd * (q + 1) : r * (q + 1) + (xcd - r) * q) + off; }
        const int nig = WGM * nN, gid = wgid / nig, fm = gid * WGM, gsz = (nM - fm) < WGM ? (nM - fm) : WGM;
        u.pm = fm + ((wgid % nig) % gsz); u.pn = (wgid % nig) / gsz; return true;
    }
    __device__ __forceinline__ void a_ready(const Unit&) const {}
    __device__ __forceinline__ void done(const Unit&) const {}
};

__device__ __forceinline__ unsigned cvt_pk_bf16(float lo, float hi) { unsigned r; asm volatile("v_cvt_pk_bf16_f32 %0, %1, %2" : "=v"(r) : "v"(lo), "v"(hi)); return r; }
struct EpiBf16 {
    static constexpr bool PERM = true, AFTER_DRAIN = false;
    bf16_t* O; int ldc;
    __device__ __forceinline__ void operator()(const f32x4 (&acc)[2][2][4][2], const Unit& u, int wr, int wc, int fr, int fq) const {
        const int row0 = u.pm * BM + wr * 64 + fr; const int col0 = u.pn * BM + wc * 32 + 8 * fq;
#pragma unroll
        for (int ai = 0; ai < 2; ++ai)
#pragma unroll
            for (int m = 0; m < 4; ++m) { bf16_t* rowp = O + (size_t)(row0 + ai * HALF + m * 16) * ldc + col0;
#pragma unroll
                for (int bj = 0; bj < 2; ++bj) { const f32x4 v0 = acc[ai][bj][m][0], v1 = acc[ai][bj][m][1];
                    u32x4 w; w.x = cvt_pk_bf16(v0[0], v0[1]); w.y = cvt_pk_bf16(v0[2], v0[3]); w.z = cvt_pk_bf16(v1[0], v1[1]); w.w = cvt_pk_bf16(v1[2], v1[3]);
                    *(u32x4*)(rowp + bj * HALF) = w; } }
    }
};
struct EpiZ {
    static constexpr bool PERM = false, AFTER_DRAIN = false;
    const float* x; const float* gate; float* out; float alpha;
    __device__ __forceinline__ void operator()(const f32x4 (&acc)[2][2][4][2], const Unit& u, int wr, int wc, int fr, int fq) const {
        const int col0 = u.pn * BM + wc * 32 + 4 * fq;
#pragma unroll
        for (int ai = 0; ai < 2; ++ai)
#pragma unroll
            for (int m = 0; m < 4; ++m) { const int r = u.pm * BM + ai * HALF + wr * 64 + m * 16 + fr; const size_t off = (size_t)r * 2048 + col0; const float* gb = gate + (size_t)(r >> 12) * 6144 + col0;
#pragma unroll
                for (int bj = 0; bj < 2; ++bj)
#pragma unroll
                    for (int n = 0; n < 2; ++n) { const f32x4 xv = *(const f32x4*)(x + off + bj * HALF + n * 16); const f32x4 gv = *(const f32x4*)(gb + bj * HALF + n * 16);
                        *(f32x4*)(out + off + bj * HALF + n * 16) = xv * alpha + gv * acc[ai][bj][m][n]; } }
    }
};
struct EpiZ16 {
    static constexpr bool PERM = true, AFTER_DRAIN = false;
    const float* x; const float* gate; bf16_t* z; float alpha;
    __device__ __forceinline__ void operator()(const f32x4 (&acc)[2][2][4][2], const Unit& u, int wr, int wc, int fr, int fq) const {
        const int col0 = u.pn * BM + wc * 32 + 8 * fq;
        const float* gb = gate + (size_t)((u.pm * BM) >> 12) * 6144 + col0;
        const f32x4 g00 = *(const f32x4*)(gb), g01 = *(const f32x4*)(gb + 4), g10 = *(const f32x4*)(gb + HALF), g11 = *(const f32x4*)(gb + HALF + 4);
#pragma unroll
        for (int ai = 0; ai < 2; ++ai)
#pragma unroll
            for (int m = 0; m < 4; ++m) { const int r = u.pm * BM + ai * HALF + wr * 64 + m * 16 + fr; const size_t off = (size_t)r * 2048 + col0;
#pragma unroll
                for (int bj = 0; bj < 2; ++bj) {
                    const f32x4 x0 = __builtin_nontemporal_load((const f32x4*)(x + off + bj * HALF)), x1 = __builtin_nontemporal_load((const f32x4*)(x + off + bj * HALF + 4));
                    const f32x4 v0 = x0 * alpha + (bj ? g10 : g00) * acc[ai][bj][m][0], v1 = x1 * alpha + (bj ? g11 : g01) * acc[ai][bj][m][1];
                    u32x4 w; w.x = cvt_pk_bf16(v0[0], v0[1]); w.y = cvt_pk_bf16(v0[2], v0[3]); w.z = cvt_pk_bf16(v1[0], v1[1]); w.w = cvt_pk_bf16(v1[2], v1[3]);
                    *(u32x4*)(z + off + bj * HALF) = w; } }
    }
};
template <class Epi, class Sched, bool ALIGN_EPI = false, bool SP2 = false>
__device__ __forceinline__ void gemm_phase(PG8_LAS unsigned char* lds, const Gemm g, const Sched& S, const Epi& E) {
    const int tid = threadIdx.x, wid = __builtin_amdgcn_readfirstlane(tid >> 6), lane = tid & 63, wr = wid >> 2, wc = wid & 3, fr = lane & 15, fq = lane >> 4;
    const int K = g.K, nt = K / BK;
    unsigned voffA[2], voffB[2];
#pragma unroll
    for (int i = 0; i < 2; ++i) { int R, C; stage_rc(tid * 16 + i * 8192, R, C); const int Rb = Epi::PERM ? ((R & ~31) + perm32(R & 31)) : R;
        voffA[i] = (unsigned)(R * K + C) * 2u; voffB[i] = (unsigned)(Rb * K + C) * 2u; }
    const size_t kstep = (size_t)(BK * 2);
    const size_t hstep = (size_t)HALF * K * 2;
    const size_t tstep = 2 * hstep;
    const unsigned ldsw = (unsigned)wid * 1024u;
    const int aoff = lds_byte(wr * 64 + fr, fq * 8), boff = lds_byte(wc * 32 + fr, fq * 8);
#define PG8_SA(b, h) (((b) * 2 + (h)) * HTB)
#define PG8_SB(b, h) ((4 + (b) * 2 + (h)) * HTB)
#define PG8_STAGE(bufoff, gbase, voff) do { _Pragma("unroll") for (int _i = 0; _i < 2; ++_i) \
        __builtin_amdgcn_global_load_lds((const unsigned*)((const char*)(gbase) + (voff)[_i]), (PG8_LAS unsigned*)(lds + (bufoff) + ldsw + _i * 8192), 16, 0, 0); } while (0)
#define PG8_LDA(dst, b, h) do { _Pragma("unroll") for (int m = 0; m < 4; ++m) _Pragma("unroll") for (int k = 0; k < 2; ++k) dst[m][k] = *(const PG8_LAS bf16x8*)(lds + PG8_SA(b, h) + aoff + m * 2048 + k * 1024); } while (0)
#define PG8_LDB(dst, b, h) do { _Pragma("unroll") for (int n = 0; n < 2; ++n) _Pragma("unroll") for (int k = 0; k < 2; ++k) dst[n][k] = *(const PG8_LAS bf16x8*)(lds + PG8_SB(b, h) + boff + n * 2048 + k * 1024); } while (0)
#define PG8_MMA(ai, bj, At, Bt) do { __builtin_amdgcn_s_setprio(1); _Pragma("unroll") for (int m = 0; m < 4; ++m) _Pragma("unroll") for (int n = 0; n < 2; ++n) _Pragma("unroll") for (int k = 0; k < 2; ++k) \
        acc[ai][bj][m][n] = __builtin_amdgcn_mfma_f32_16x16x32_bf16(Bt[n][k], At[m][k], acc[ai][bj][m][n], 0, 0, 0); __builtin_amdgcn_s_setprio(0); } while (0)
#define PG8_WAIT_V(n) asm volatile("s_waitcnt vmcnt(" #n ")" ::: "memory")
#define PG8_WAIT_L(n) asm volatile("s_waitcnt lgkmcnt(" #n ")" ::: "memory")
#define PG8_BAR __builtin_amdgcn_s_barrier()
#define PG8_SCHED __builtin_amdgcn_sched_barrier(0)
    Unit cur, nxt; int ui = 0;
    if (!S.next(0, cur)) return;
    f32x4 acc[2][2][4][2];
#pragma unroll
    for (int a = 0; a < 2; ++a)
#pragma unroll
        for (int b = 0; b < 2; ++b)
#pragma unroll
            for (int m = 0; m < 4; ++m)
#pragma unroll
                for (int n = 0; n < 2; ++n) acc[a][b][m][n] = (f32x4){0.f, 0.f, 0.f, 0.f};
    bf16x8 At[4][2], B0[2][2], B1[2][2];
    const char* cA = (const char*)g.A + (size_t)cur.pm * tstep; const char* cB = (const char*)g.Bt + (size_t)cur.pn * tstep;
    S.a_ready(cur);
    if constexpr (SP2) {
        PG8_STAGE(PG8_SB(0, 0), cB, voffB); PG8_STAGE(PG8_SB(0, 1), cB + hstep, voffB); PG8_STAGE(PG8_SA(0, 0), cA, voffA); PG8_STAGE(PG8_SA(0, 1), cA + hstep, voffA);
        if (wr == 1) PG8_BAR;
        PG8_WAIT_V(2); PG8_BAR;
        PG8_STAGE(PG8_SB(1, 0), cB + kstep, voffB); PG8_STAGE(PG8_SA(1, 0), cA + kstep, voffA); PG8_STAGE(PG8_SB(1, 1), cB + hstep + kstep, voffB);
        PG8_WAIT_V(6); PG8_BAR;
    } else {
        PG8_STAGE(PG8_SB(0, 0), cB, voffB); PG8_STAGE(PG8_SA(0, 0), cA, voffA); PG8_STAGE(PG8_SB(0, 1), cB + hstep, voffB); PG8_STAGE(PG8_SA(0, 1), cA + hstep, voffA);
        if (wr == 1) PG8_BAR;
        PG8_WAIT_V(4); PG8_BAR;
        PG8_STAGE(PG8_SB(1, 0), cB + kstep, voffB); PG8_STAGE(PG8_SA(1, 0), cA + kstep, voffA); PG8_STAGE(PG8_SB(1, 1), cB + hstep + kstep, voffB);
        PG8_WAIT_V(6); PG8_BAR;
    }
    for (;;) {
        const bool has_next = S.next(ui + 1, nxt);
        const char* nA = has_next ? (const char*)g.A + (size_t)nxt.pm * tstep : cA; const char* nB = has_next ? (const char*)g.Bt + (size_t)nxt.pn * tstep : cB;
        for (int t = 0; t < nt; t += 2) {
            const bool last = (t == nt - 2);
            const char* a1 = cA + (size_t)(t + 1) * kstep;
            const char* a2 = last ? nA : cA + (size_t)(t + 2) * kstep; const char* b2 = last ? nB : cB + (size_t)(t + 2) * kstep;
            const char* a3 = a2 + kstep; const char* b3 = b2 + kstep;
            if (last && has_next) S.a_ready(nxt);
            if constexpr (SP2) {
            PG8_LDB(B0, 0, 0); PG8_LDB(B1, 0, 1); PG8_SCHED; PG8_LDA(At, 0, 0); PG8_STAGE(PG8_SA(1, 1), a1 + hstep, voffA);
            PG8_WAIT_V(8); PG8_WAIT_L(0); PG8_BAR; PG8_MMA(0, 0, At, B0); PG8_MMA(0, 1, At, B1); PG8_BAR; PG8_SCHED;
            PG8_LDA(At, 0, 1); PG8_STAGE(PG8_SB(0, 0), b2, voffB); PG8_STAGE(PG8_SB(0, 1), b2 + hstep, voffB); PG8_STAGE(PG8_SA(0, 0), a2, voffA);
            PG8_WAIT_V(8); PG8_WAIT_L(0); PG8_BAR; PG8_MMA(1, 0, At, B0); PG8_MMA(1, 1, At, B1); PG8_BAR; PG8_SCHED;
            PG8_LDB(B0, 1, 0); PG8_LDB(B1, 1, 1); PG8_SCHED; PG8_LDA(At, 1, 0); PG8_STAGE(PG8_SA(0, 1), a2 + hstep, voffA);
            PG8_WAIT_V(8); PG8_WAIT_L(0); PG8_BAR; PG8_MMA(0, 0, At, B0); PG8_MMA(0, 1, At, B1); PG8_BAR; PG8_SCHED;
            PG8_LDA(At, 1, 1); PG8_STAGE(PG8_SB(1, 0), b3, voffB); PG8_STAGE(PG8_SB(1, 1), b3 + hstep, voffB); PG8_STAGE(PG8_SA(1, 0), a3, voffA);
            PG8_WAIT_V(8); PG8_WAIT_L(0); PG8_BAR; PG8_MMA(1, 0, At, B0); PG8_MMA(1, 1, At, B1); PG8_BAR; PG8_SCHED;
            } else {
            PG8_LDB(B0, 0, 0); PG8_SCHED; PG8_LDA(At, 0, 0); PG8_STAGE(PG8_SA(1, 1), a1 + hstep, voffA);
            PG8_WAIT_L(8); PG8_BAR; PG8_WAIT_L(0); PG8_MMA(0, 0, At, B0); PG8_BAR; PG8_SCHED;
            PG8_LDB(B1, 0, 1); PG8_STAGE(PG8_SB(0, 0), b2, voffB);
            PG8_BAR; PG8_WAIT_L(0); PG8_MMA(0, 1, At, B1); PG8_BAR;
            PG8_LDA(At, 0, 1); PG8_STAGE(PG8_SA(0, 0), a2, voffA);
            PG8_BAR; PG8_WAIT_L(0); PG8_MMA(1, 0, At, B0); PG8_BAR; PG8_SCHED;
            PG8_STAGE(PG8_SB(0, 1), b2 + hstep, voffB);
            PG8_WAIT_V(6); PG8_BAR; PG8_MMA(1, 1, At, B1); PG8_BAR;
            PG8_LDB(B0, 1, 0); PG8_SCHED; PG8_LDA(At, 1, 0); PG8_STAGE(PG8_SA(0, 1), a2 + hstep, voffA);
            PG8_WAIT_L(8); PG8_BAR; PG8_WAIT_L(0); PG8_MMA(0, 0, At, B0); PG8_BAR; PG8_SCHED;
            PG8_LDB(B1, 1, 1); PG8_STAGE(PG8_SB(1, 0), b3, voffB);
            PG8_BAR; PG8_WAIT_L(0); PG8_MMA(0, 1, At, B1); PG8_BAR;
            PG8_LDA(At, 1, 1); PG8_STAGE(PG8_SA(1, 0), a3, voffA);
            PG8_BAR; PG8_WAIT_L(0); PG8_MMA(1, 0, At, B0); PG8_BAR; PG8_SCHED;
            PG8_STAGE(PG8_SB(1, 1), b3 + hstep, voffB);
            PG8_WAIT_V(6); PG8_BAR; PG8_MMA(1, 1, At, B1); PG8_BAR;
            }
        }
        if constexpr (ALIGN_EPI) { if (wr == 0) PG8_BAR; }
        if constexpr (!Epi::AFTER_DRAIN) { E(acc, cur, wr, wc, fr, fq); S.done(cur); }
        if (!has_next) break;
#pragma unroll
        for (int a = 0; a < 2; ++a)
#pragma unroll
            for (int b = 0; b < 2; ++b)
#pragma unroll
                for (int m = 0; m < 4; ++m)
#pragma unroll
                    for (int n = 0; n < 2; ++n) acc[a][b][m][n] = (f32x4){0.f, 0.f, 0.f, 0.f};
        cur = nxt; cA = nA; cB = nB; ++ui;
        if constexpr (ALIGN_EPI) { if (wr == 1) PG8_BAR; }
    }
    PG8_WAIT_V(0);
    if constexpr (!ALIGN_EPI) { if (wr == 0) PG8_BAR; }
    PG8_BAR;
    if constexpr (Epi::AFTER_DRAIN) { E.fused(acc, cur, wr, wc, fr, fq, lds, wid, lane); S.done(cur); }
#undef PG8_SA
#undef PG8_SB
#undef PG8_STAGE
#undef PG8_LDA
#undef PG8_LDB
#undef PG8_MMA
#undef PG8_WAIT_V
#undef PG8_WAIT_L
#undef PG8_BAR
#undef PG8_SCHED
}
}

#define LAS __attribute__((address_space(3)))
typedef unsigned short bf16_t;
typedef short bf16x8 __attribute__((ext_vector_type(8)));
typedef float f32x4 __attribute__((ext_vector_type(4)));
typedef unsigned u32x4 __attribute__((ext_vector_type(4)));
typedef unsigned u32x2 __attribute__((ext_vector_type(2)));
constexpr int NWAVES = 8, NTHR = 512;
constexpr int NB = 8, T = 4096, D = 2048, M = NB * T;
constexpr int NC = 7168, INC = 7184;
constexpr int C_RQ = 0, C_RK = 512, C_RV = 1024, C_RG = 2048, C_GQ = 3072, C_GG = 6144;
constexpr size_t MiB = (size_t)1 << 20;
constexpr size_t WS_MOD = 0, WS_G = 1 * MiB, WS_BETA = 2 * MiB, WS_GL = 3 * MiB, WS_WOUT = 4 * MiB, WS_WIN = 12 * MiB, WS_HIN = 40 * MiB, WS_PROJ = 168 * MiB, WS_GPREP = 616 * MiB, WS_END = 904 * MiB;
constexpr int GP_W = 0, GP_QE = 16384, GP_KT = 32768, GP_AT = 49152, GP_UT = 57344, GP_BYTES = 73728;
constexpr int LDS_BYTES = 147456;
constexpr float QK_SCALE = 0.08838834764831845f;

typedef __bf16 bf16v2_t __attribute__((ext_vector_type(2)));
typedef float f32v2_t __attribute__((ext_vector_type(2)));
__device__ __forceinline__ unsigned pk2(float lo, float hi) { return __builtin_bit_cast(unsigned, __builtin_convertvector((f32v2_t){lo, hi}, bf16v2_t)); }
__device__ __forceinline__ unsigned f2bf(float f) { return (unsigned)__builtin_bit_cast(unsigned short, (__bf16)f); }
__device__ __forceinline__ float bf2f(unsigned h) { return __builtin_bit_cast(float, h << 16); }
__device__ __forceinline__ float bflo(unsigned w) { return __builtin_bit_cast(float, w << 16); }
__device__ __forceinline__ float bfhi(unsigned w) { return __builtin_bit_cast(float, w & 0xffff0000u); }
__device__ __forceinline__ float silu_f(float v) { return v * __builtin_amdgcn_rcpf(1.f + __expf(-v)); }
__device__ __forceinline__ void lds_barrier() { asm volatile("s_waitcnt lgkmcnt(0)\n\ts_barrier" ::: "memory"); }
__device__ __forceinline__ float wave_sum(float v) {
#pragma unroll
    for (int o = 1; o < 64; o <<= 1) v += __shfl_xor(v, o);
    return v;
}
__device__ __forceinline__ float sum16(float v) {
#pragma unroll
    for (int o = 1; o < 16; o <<= 1) v += __shfl_xor(v, o);
    return v;
}
template <int KS> __device__ __forceinline__ void mma_nt(f32x4& acc, const LAS bf16_t* A, int lda, const LAS bf16_t* Bt, int ldb, int lane) {
    const int r = lane & 15, g = lane >> 4;
    const LAS bf16_t* ap = A + r * lda + g * 8; const LAS bf16_t* bp = Bt + r * ldb + g * 8;
#pragma unroll
    for (int ks = 0; ks < KS; ++ks) {
        const bf16x8 a = *(const LAS bf16x8*)(ap + ks * 32); const bf16x8 b = *(const LAS bf16x8*)(bp + ks * 32);
        acc = __builtin_amdgcn_mfma_f32_16x16x32_bf16(a, b, acc, 0, 0, 0);
    }
}
__device__ __forceinline__ void unpack8(const u32x4 w, float* o) { o[0] = bflo(w.x); o[1] = bfhi(w.x); o[2] = bflo(w.y); o[3] = bfhi(w.y); o[4] = bflo(w.z); o[5] = bfhi(w.z); o[6] = bflo(w.w); o[7] = bfhi(w.w); }
__device__ __forceinline__ u32x4 pack8(const float* v) { u32x4 w; w.x = pk2(v[0], v[1]); w.y = pk2(v[2], v[3]); w.z = pk2(v[4], v[5]); w.w = pk2(v[6], v[7]); return w; }

__device__ __forceinline__ int kpos(int k) { const int kk = k & 31; return (k & ~31) + ((kk & 12) << 1) + (kk & 3) + ((kk & 16) >> 2); }
__device__ __forceinline__ bf16x8 pack_tiles(const f32x4 lo, const f32x4 hi) { u32x4 w; w.x = pk2(lo[0], lo[1]); w.y = pk2(lo[2], lo[3]); w.z = pk2(hi[0], hi[1]); w.w = pk2(hi[2], hi[3]); return __builtin_bit_cast(bf16x8, w); }

__device__ __forceinline__ void p0_transpose_item(const float* W, int ldw, int K, bf16_t* WT, LAS float* scr, int nblk, int item, int lane) {
    const int kb = item / nblk, nb = item % nblk, k0 = 64 * kb, n0 = 32 * nb;
#pragma unroll 8
    for (int i = 0; i < 32; ++i) { const int kk = 2 * i + (lane >> 5); scr[kk * 33 + (lane & 31)] = W[(size_t)(k0 + kk) * ldw + n0 + (lane & 31)]; }
    asm volatile("s_waitcnt lgkmcnt(0)" ::: "memory");
    const int c = lane & 7;
#pragma unroll
    for (int j = 0; j < 4; ++j) { const int n = (lane >> 3) + 8 * j; const LAS float* s = scr + (8 * c) * 33 + n;
        u32x4 o; o.x = pk2(s[0 * 33], s[1 * 33]); o.y = pk2(s[2 * 33], s[3 * 33]); o.z = pk2(s[4 * 33], s[5 * 33]); o.w = pk2(s[6 * 33], s[7 * 33]);
        *(u32x4*)(WT + (size_t)(n0 + n) * K + k0 + 8 * c) = o; }
    asm volatile("s_waitcnt lgkmcnt(0)" ::: "memory");
}
__device__ __forceinline__ void p0_phase(LAS unsigned char* lds, const float* cvec, const float* w_ada, const float* b_ada, const float* w_in, const float* w_out,
                                         float* mod, bf16_t* WinT, bf16_t* WoutT, int tid, int lane, int wave, int G, int nrep) {
    LAS float* sc = (LAS float*)lds;
    LAS float* part = (LAS float*)(lds + 65536);
    for (int blk_ = blockIdx.x; blk_ < 256 * nrep; blk_ += G) {
        const int blk = blk_ & 255; const int n0 = 24 * blk;
        for (int i = tid; i < 8 * 2048; i += NTHR) sc[i] = silu_f(cvec[i]);
        __syncthreads();
        const int kg = tid / 6, c4 = tid % 6;
        if (tid < 510) {
            float acc[8][4];
#pragma unroll
            for (int b = 0; b < 8; ++b)
#pragma unroll
                for (int j = 0; j < 4; ++j) acc[b][j] = 0.f;
            for (int k = kg; k < 2048; k += 85) {
                const f32x4 w = *(const f32x4*)(w_ada + (size_t)k * 6144 + n0 + 4 * c4);
#pragma unroll
                for (int b = 0; b < 8; ++b) { const float s = sc[b * 2048 + k]; acc[b][0] += s * w[0]; acc[b][1] += s * w[1]; acc[b][2] += s * w[2]; acc[b][3] += s * w[3]; }
            }
#pragma unroll
            for (int b = 0; b < 8; ++b)
#pragma unroll
                for (int j = 0; j < 4; ++j) part[kg * 192 + b * 24 + 4 * c4 + j] = acc[b][j];
        }
        __syncthreads();
        if (tid < 192) { float s = 0.f; for (int q = 0; q < 85; ++q) s += part[q * 192 + tid]; const int b = tid / 24, j = tid % 24; mod[b * 6144 + n0 + j] = s + b_ada[n0 + j]; }
        __syncthreads();
    }
    LAS float* scr = (LAS float*)(lds + wave * 16384);
    const int gw = blockIdx.x * NWAVES + wave, NGW = G * NWAVES;
    constexpr int I_IN = (D / 64) * (NC / 32), I_OUT = (D / 64) * (D / 32);
    for (int it_ = gw; it_ < (I_IN + I_OUT) * nrep; it_ += NGW) {
        const int it = it_ % (I_IN + I_OUT);
        if (it < I_IN) p0_transpose_item(w_in, INC, D, WinT, scr, NC / 32, it, lane);
        else p0_transpose_item(w_out, D, D, WoutT, scr, D / 32, it - I_IN, lane);
    }
}

__device__ __forceinline__ void p1_phase(LAS unsigned char* lds, const float* x, const float* w_in, const float* mod, const float* a_log, const float* dt_bias,
                                         bf16_t* hin, float* gdec, float* beta, int tid, int lane, int wave, int G, int nrep) {
    LAS float* wx = (LAS float*)lds;
    for (int k = tid; k < 2048; k += NTHR) {
        const f32x4* src = (const f32x4*)(w_in + (size_t)k * INC + NC);
#pragma unroll
        for (int q = 0; q < 4; ++q) { const f32x4 v = src[q]; wx[(4 * q + 0) * 2048 + k] = v[0]; wx[(4 * q + 1) * 2048 + k] = v[1]; wx[(4 * q + 2) * 2048 + k] = v[2]; wx[(4 * q + 3) * 2048 + k] = v[3]; }
    }
    __syncthreads();
    typedef float f32x2 __attribute__((ext_vector_type(2)));
    const int gw = blockIdx.x * NWAVES + wave, NGW = G * NWAVES;
    for (int pair_ = gw; pair_ < (M / 2) * nrep; pair_ += NGW) {
        const int pair = pair_ & (M / 2 - 1);
        const size_t m0 = (size_t)2 * pair; const int b = (int)(m0 >> 12);
        const float* modb = mod + b * 6144;
        float acc0[16], acc1[16];
#pragma unroll
        for (int o = 0; o < 16; ++o) { acc0[o] = 0.f; acc1[o] = 0.f; }
#pragma unroll 8
        for (int i = 0; i < 16; ++i) {
            const int k = 2 * lane + 128 * i;
            const f32x2 sh = *(const f32x2*)(modb + k), scl = *(const f32x2*)(modb + 2048 + k);
            const f32x2 x0 = __builtin_nontemporal_load((const f32x2*)(x + m0 * D + k)), x1 = __builtin_nontemporal_load((const f32x2*)(x + (m0 + 1) * D + k));
            const float h00 = x0[0] * (1.f + scl[0]) + sh[0], h01 = x0[1] * (1.f + scl[1]) + sh[1];
            const float h10 = x1[0] * (1.f + scl[0]) + sh[0], h11 = x1[1] * (1.f + scl[1]) + sh[1];
            *(unsigned*)(hin + m0 * D + k) = pk2(h00, h01);
            *(unsigned*)(hin + (m0 + 1) * D + k) = pk2(h10, h11);
#pragma unroll
            for (int o = 0; o < 16; ++o) { const f32x2 w = *(const LAS f32x2*)(wx + o * 2048 + k); acc0[o] += h00 * w[0] + h01 * w[1]; acc1[o] += h10 * w[0] + h11 * w[1]; }
        }
#pragma unroll
        for (int sft = 0; sft < 4; ++sft) {
            const bool hiLane = (lane >> sft) & 1;
#pragma unroll
            for (int t = 0; t < (8 >> sft); ++t) {
                const float k0 = hiLane ? acc0[2 * t + 1] : acc0[2 * t], s0 = hiLane ? acc0[2 * t] : acc0[2 * t + 1];
                const float k1 = hiLane ? acc1[2 * t + 1] : acc1[2 * t], s1 = hiLane ? acc1[2 * t] : acc1[2 * t + 1];
                acc0[t] = k0 + __shfl_xor(s0, 1 << sft); acc1[t] = k1 + __shfl_xor(s1, 1 << sft);
            }
        }
        float v0 = acc0[0], v1 = acc1[0];
        v0 += __shfl_xor(v0, 16); v0 += __shfl_xor(v0, 32); v1 += __shfl_xor(v1, 16); v1 += __shfl_xor(v1, 32);
        if (lane < 8) {
            const float al = -__expf(a_log[lane]), db = dt_bias[lane];
            const float y0 = v0 + db, y1 = v1 + db;
            const float sp0 = y0 > 20.f ? y0 : log1pf(__expf(y0)), sp1 = y1 > 20.f ? y1 : log1pf(__expf(y1));
            gdec[m0 * 8 + lane] = al * sp0; gdec[(m0 + 1) * 8 + lane] = al * sp1;
        } else if (lane < 16) {
            beta[m0 * 8 + lane - 8] = 1.f / (1.f + __expf(-v0)); beta[(m0 + 1) * 8 + lane - 8] = 1.f / (1.f + __expf(-v1));
        }
    }
}

__device__ __forceinline__ void rot16(float* lo, float* hi, int pos, int d0) {
#pragma unroll
    for (int e = 0; e < 16; ++e) {
        const float fturn = exp2f(-(float)(d0 + e) * (13.287712379549449f / 64.f)) * 0.15915494309189535f;
        const double r = (double)pos * (double)fturn; const float fr = (float)(r - floor(r));
        const float sn = __builtin_amdgcn_sinf(fr), cs = __builtin_amdgcn_cosf(fr);
        const float a = lo[e], b = hi[e];
        lo[e] = a * cs - b * sn; hi[e] = a * sn + b * cs;
    }
}

__device__ __forceinline__ void gdn_prep_block(LAS unsigned char* lds, int vb, const bf16_t* proj, const float* conv_w, const float* gdec, const float* beta,
                                               unsigned char* gprep, float* glv, int tid, int lane, int wave) {
    const int h = vb & 7, pq = vb >> 3;
    LAS float* GCB = (LAS float*)(lds + 116736);
    LAS float* CW = (LAS float*)(lds + 122880);
    for (int idx = tid; idx < 1536; idx += NTHR) { const int X = idx >> 9, r = idx & 511; CW[idx] = conv_w[(r >> 7) * 3072 + X * 1024 + h * 128 + (r & 127)]; }
    const int ti_ = tid >> 3, td0_ = (tid & 7) * 16;
    u32x4 pre[3][4][2];
#define GP_ITEM(k) (((((pq + 32 * (k)) >> 6) * 8 + h) << 6) + ((pq + 32 * (k)) & 63))
#define GP_STEP0(itm, GCp) do { const int n_ = (itm) & 63, b_ = (itm) >> 9; const long mm = (long)b_ * T + n_ * 64; \
        const float g_ = gdec[(mm + lane) * 8 + h], bt_ = beta[(mm + lane) * 8 + h]; float gc = g_; \
        _Pragma("unroll") for (int off = 1; off < 64; off <<= 1) { const float t_ = __shfl_up(gc, off); if (lane >= off) gc += t_; } \
        const float glast = __shfl(gc, 63); (GCp)[lane] = gc; (GCp)[64 + lane] = bt_; (GCp)[128 + lane] = __expf(gc); (GCp)[192 + lane] = __expf(glast - gc); \
        if (lane == 0) glv[itm] = __expf(glast); } while (0)
#define GP_LOADPRE(itm) do { const int n_ = (itm) & 63, b_ = (itm) >> 9; const long mm = (long)b_ * T + n_ * 64; \
        _Pragma("unroll") for (int X = 0; X < 3; ++X) _Pragma("unroll") for (int j = 0; j < 4; ++j) { \
            if (n_ * 64 + ti_ - 3 + j >= 0) { const u32x4* p_ = (const u32x4*)(proj + (size_t)(mm + ti_ - 3 + j) * NC + C_GQ + X * 1024 + h * 128 + td0_); pre[X][j][0] = p_[0]; pre[X][j][1] = p_[1]; } \
            else { pre[X][j][0] = (u32x4){0u, 0u, 0u, 0u}; pre[X][j][1] = (u32x4){0u, 0u, 0u, 0u}; } } } while (0)
    if (wave == 0) GP_STEP0(GP_ITEM(0), GCB);
    GP_LOADPRE(GP_ITEM(0));
    lds_barrier();
    for (int k = 0; k < 16; ++k) {
    const int item = GP_ITEM(k);
    { unsigned zoff = 0; asm volatile("" : "+s"(zoff)); lds += zoff; tid += zoff; lane += zoff; }
    const int n = item & 63, b = item >> 9; const int t0 = n * 64; const long m0 = (long)b * T + t0;
    LAS bf16_t* KN = (LAS bf16_t*)lds;
    LAS bf16_t* QN = (LAS bf16_t*)(lds + 17408);
    LAS bf16_t* KBGT = (LAS bf16_t*)(lds + 34816);
    LAS bf16_t* VBT = (LAS bf16_t*)(lds + 53248);
    LAS bf16_t* KTT = (LAS bf16_t*)(lds + 71680);
    LAS bf16_t* TM = (LAS bf16_t*)(lds + 90112);
    LAS float* AM = (LAS float*)(lds + 99328);
    LAS bf16_t* AB = (LAS bf16_t*)(lds + 117760);
    LAS bf16_t* T11T = (LAS bf16_t*)(lds + 120320);
    LAS float* GC = (LAS float*)(lds + ((k & 1) ? 129024 : 116736));
    LAS float* BT = GC + 64; LAS float* EG = GC + 128; LAS float* EK = GC + 192;
    unsigned char* gp = gprep + (size_t)item * GP_BYTES;
    {
        const int i = tid >> 3, d0 = (tid & 7) * 16;
        const float bti = BT[i], egi = EG[i], eki = EK[i];
#pragma unroll
        for (int X = 0; X < 3; ++X) {
            float val[16];
#pragma unroll
            for (int e = 0; e < 16; ++e) val[e] = 0.f;
#pragma unroll
            for (int j = 0; j < 4; ++j) {
                float in[16]; unpack8(pre[X][j][0], in); unpack8(pre[X][j][1], in + 8);
                const LAS f32x4* wp = (const LAS f32x4*)(CW + (X * 4 + j) * 128 + d0);
#pragma unroll
                for (int q = 0; q < 4; ++q) { const f32x4 w = wp[q]; val[4 * q + 0] += in[4 * q + 0] * w[0]; val[4 * q + 1] += in[4 * q + 1] * w[1]; val[4 * q + 2] += in[4 * q + 2] * w[2]; val[4 * q + 3] += in[4 * q + 3] * w[3]; }
            }
            float ss = 0.f;
#pragma unroll
            for (int e = 0; e < 16; ++e) { val[e] = silu_f(val[e]); ss += val[e] * val[e]; }
            if (X < 2) {
                ss += __shfl_xor(ss, 1); ss += __shfl_xor(ss, 2); ss += __shfl_xor(ss, 4);
                const float rn = rsqrtf(ss + 1e-6f) * (X == 0 ? QK_SCALE : 1.f);
#pragma unroll
                for (int e = 0; e < 16; ++e) val[e] *= rn;
            }
            if (X == 0) {
                *(LAS u32x4*)(QN + i * 136 + d0) = pack8(val); *(LAS u32x4*)(QN + i * 136 + d0 + 8) = pack8(val + 8);
                float qe[16];
#pragma unroll
                for (int e = 0; e < 16; ++e) qe[e] = val[e] * egi;
                bf16_t* qg = (bf16_t*)(gp + GP_QE) + i * 128 + (d0 & ~31) + ((d0 & 16) >> 2);
#pragma unroll
                for (int gq = 0; gq < 4; ++gq) { u32x2 w; w.x = pk2(qe[4 * gq], qe[4 * gq + 1]); w.y = pk2(qe[4 * gq + 2], qe[4 * gq + 3]); *(u32x2*)(qg + 8 * gq) = w; }
            } else if (X == 1) {
                *(LAS u32x4*)(KN + i * 136 + d0) = pack8(val); *(LAS u32x4*)(KN + i * 136 + d0 + 8) = pack8(val + 8);
#pragma unroll
                for (int e = 0; e < 16; ++e) { KBGT[(d0 + e) * 72 + i] = (bf16_t)f2bf(val[e] * bti * egi); KTT[(d0 + e) * 72 + kpos(i)] = (bf16_t)f2bf(val[e] * eki); }
            } else {
#pragma unroll
                for (int e = 0; e < 16; ++e) VBT[(d0 + e) * 72 + i] = (bf16_t)f2bf(val[e] * bti);
            }
        }
    }
    lds_barrier();
    {
        const int c = lane & 15, g = lane >> 4;
        bf16_t* at = (bf16_t*)(gp + GP_AT);
#pragma unroll
        for (int rep = 0; rep < 2; ++rep) {
            const int tt = wave + 8 * rep, ti = tt >> 2, tj = tt & 3;
            f32x4 a1 = {0.f, 0.f, 0.f, 0.f}, a2 = {0.f, 0.f, 0.f, 0.f};
            if (tj <= ti) { mma_nt<4>(a1, KN + 16 * ti * 136, 136, KN + 16 * tj * 136, 136, lane); mma_nt<4>(a2, QN + 16 * ti * 136, 136, KN + 16 * tj * 136, 136, lane); }
            const int j = 16 * tj + c; const float gcj = GC[j];
            const f32x4 gci = *(const LAS f32x4*)(GC + 16 * ti + 4 * g), bti4 = *(const LAS f32x4*)(BT + 16 * ti + 4 * g);
            f32x4 av;
#pragma unroll
            for (int rr = 0; rr < 4; ++rr) {
                const int i = 16 * ti + 4 * g + rr;
                const float dec = (i >= j) ? __expf(gci[rr] - gcj) : 0.f;
                const float aij = (i > j) ? a1[rr] * bti4[rr] * dec : 0.f;
                av[rr] = aij;
                if (ti >= 2 && tj < 2) AB[(i - 32) * 40 + j] = (bf16_t)f2bf(aij);
                at[i * 64 + kpos(j)] = (bf16_t)f2bf((i >= j) ? a2[rr] * dec : 0.f);
            }
            *(LAS f32x4*)(AM + j * 68 + 16 * ti + 4 * g) = av;
        }
    }
    lds_barrier();
    if (k + 1 < 16) {
        GP_LOADPRE(GP_ITEM(k + 1));
        if (wave == 1) { LAS float* GCn = (k & 1) ? GCB : (LAS float*)(lds + 129024); GP_STEP0(GP_ITEM(k + 1), GCn); }
    }
    if (wave == 0) {
        const int half = lane >> 5, cl = lane & 31, c = lane & 15, g = lane >> 4;
        const LAS float* Ab = AM + (32 * half) * 68 + 32 * half;
        float sv[32];
#pragma unroll
        for (int i = 0; i < 32; ++i) sv[i] = (cl == i) ? 1.f : 0.f;
        f32x4 ca[8], cb[8];
#define SV_LD(dst, j) do { _Pragma("unroll") for (int q = ((j) + 1) / 4; q < 8; ++q) dst[q] = *(const LAS f32x4*)(Ab + (j) * 68 + 4 * q); asm volatile("" ::: "memory"); } while (0)
#define SV_FM(src, j) do { const float tj = sv[j]; _Pragma("unroll") for (int q = ((j) + 1) / 4; q < 8; ++q) _Pragma("unroll") for (int e = 0; e < 4; ++e) if (4 * q + e > (j)) sv[4 * q + e] -= src[q][e] * tj; \
        asm volatile("" : "+v"(sv[0]), "+v"(sv[1]), "+v"(sv[2]), "+v"(sv[3]), "+v"(sv[4]), "+v"(sv[5]), "+v"(sv[6]), "+v"(sv[7]), "+v"(sv[8]), "+v"(sv[9]), "+v"(sv[10]), "+v"(sv[11]), "+v"(sv[12]), "+v"(sv[13]), "+v"(sv[14]), "+v"(sv[15]) :: "memory"); \
        asm volatile("" : "+v"(sv[16]), "+v"(sv[17]), "+v"(sv[18]), "+v"(sv[19]), "+v"(sv[20]), "+v"(sv[21]), "+v"(sv[22]), "+v"(sv[23]), "+v"(sv[24]), "+v"(sv[25]), "+v"(sv[26]), "+v"(sv[27]), "+v"(sv[28]), "+v"(sv[29]), "+v"(sv[30]), "+v"(sv[31]) :: "memory"); } while (0)
        SV_LD(ca, 0);
#pragma unroll
        for (int j = 0; j < 30; j += 2) {
            SV_LD(cb, j + 1); SV_FM(ca, j);
            SV_LD(ca, j + 2); SV_FM(cb, j + 1);
        }
        SV_FM(ca, 30);
#undef SV_LD
#undef SV_FM
#pragma unroll
        for (int i = 0; i < 32; ++i) TM[(32 * half + i) * 72 + 32 * half + cl] = (bf16_t)f2bf(sv[i]);
        if (half == 0) {
#pragma unroll
            for (int i = 0; i < 32; ++i) TM[i * 72 + 32 + cl] = (bf16_t)0;
#pragma unroll
            for (int q = 0; q < 4; ++q) { u32x4 w; w.x = pk2(sv[8 * q], sv[8 * q + 1]); w.y = pk2(sv[8 * q + 2], sv[8 * q + 3]); w.z = pk2(sv[8 * q + 4], sv[8 * q + 5]); w.w = pk2(sv[8 * q + 6], sv[8 * q + 7]); *(LAS u32x4*)(T11T + cl * 40 + 8 * q) = w; }
        }
        asm volatile("s_waitcnt lgkmcnt(0)" ::: "memory");
        f32x4 X[2][2];
#pragma unroll
        for (int t2 = 0; t2 < 2; ++t2)
#pragma unroll
            for (int tc = 0; tc < 2; ++tc) { X[t2][tc] = (f32x4){0.f, 0.f, 0.f, 0.f}; mma_nt<1>(X[t2][tc], AB + 16 * t2 * 40, 40, T11T + 16 * tc * 40, 40, lane); }
#pragma unroll
        for (int t2 = 0; t2 < 2; ++t2) {
            const LAS bf16_t* trow = TM + (32 + 16 * t2 + c) * 72 + 32 + 4 * g;
            const u32x2 lo = *(const LAS u32x2*)trow, hi = *(const LAS u32x2*)(trow + 16);
            const bf16x8 af = __builtin_bit_cast(bf16x8, (u32x4){lo.x, lo.y, hi.x, hi.y});
#pragma unroll
            for (int tc = 0; tc < 2; ++tc) {
                f32x4 acc = {0.f, 0.f, 0.f, 0.f};
                acc = __builtin_amdgcn_mfma_f32_16x16x32_bf16(af, pack_tiles(X[0][tc], X[1][tc]), acc, 0, 0, 0);
#pragma unroll
                for (int rr = 0; rr < 4; ++rr) TM[(32 + 16 * t2 + 4 * g + rr) * 72 + 16 * tc + c] = (bf16_t)f2bf(-acc[rr]);
            }
        }
    }
    lds_barrier();
    {
        const int c = lane & 15, g = lane >> 4;
#pragma unroll
        for (int rep = 0; rep < 8; ++rep) {
            const int tt = wave * 8 + rep;
            f32x4 acc = {0.f, 0.f, 0.f, 0.f};
            if (tt < 32) {
                const int ti = tt >> 3, te = tt & 7;
                mma_nt<2>(acc, TM + 16 * ti * 72, 72, VBT + 16 * te * 72, 72, lane);
                u32x2 w; w.x = pk2(acc[0], acc[1]); w.y = pk2(acc[2], acc[3]);
                *(u32x2*)((bf16_t*)(gp + GP_UT) + (16 * te + c) * 64 + 16 * ti + 4 * g) = w;
            } else {
                const int t2 = tt - 32, ti = t2 >> 3, td = t2 & 7;
                mma_nt<2>(acc, KBGT + 16 * td * 72, 72, TM + 16 * ti * 72, 72, lane);
                u32x2 w; w.x = pk2(acc[0], acc[1]); w.y = pk2(acc[2], acc[3]);
                *(u32x2*)((bf16_t*)(gp + GP_W) + (16 * ti + c) * 128 + kpos(16 * td + 4 * g)) = w;
            }
        }
#pragma unroll
        for (int u = 0; u < 2; ++u) { const int q = tid + NTHR * u, d = q >> 3, part = q & 7; *(u32x4*)(gp + GP_KT + (size_t)q * 16) = *(const LAS u32x4*)(KTT + d * 72 + part * 8); }
    }
    lds_barrier();
    }
#undef GP_ITEM
#undef GP_STEP0
#undef GP_LOADPRE
}

__device__ __forceinline__ void ret_kv_item(LAS unsigned char* lds, int item, const bf16_t* proj, float* KV, int tid, int lane, int wave) {
    const int n = item & 31, bh = item >> 5, h = bh & 3, b = bh >> 2;
    const int t0 = n * 128; const size_t m0 = (size_t)b * T + t0;
    LAS bf16_t* VT = (LAS bf16_t*)lds;
    LAS bf16_t* KDT = (LAS bf16_t*)(lds + 69632);
    const float lg = __logf(1.f - exp2f(-5.f - (float)h));
    {
        const int j = tid >> 2, part = tid & 3, d0 = 16 * part;
        const bf16_t* kp = proj + (m0 + j) * NC + C_RK + h * 128 + d0;
        float lo[16], hi[16];
        unpack8(((const u32x4*)kp)[0], lo); unpack8(((const u32x4*)kp)[1], lo + 8); unpack8(((const u32x4*)(kp + 64))[0], hi); unpack8(((const u32x4*)(kp + 64))[1], hi + 8);
        rot16(lo, hi, t0 + j, d0);
        const float kdec = __expf(lg * (float)(127 - j)) * QK_SCALE;
#pragma unroll
        for (int e = 0; e < 16; ++e) { KDT[(d0 + e) * 136 + j] = (bf16_t)f2bf(lo[e] * kdec); KDT[(64 + d0 + e) * 136 + j] = (bf16_t)f2bf(hi[e] * kdec); }
        const int e0 = 64 * part;
        const u32x4* vp = (const u32x4*)(proj + (m0 + j) * NC + C_RV + h * 256 + e0);
#pragma unroll
        for (int q = 0; q < 8; ++q) { const u32x4 w = vp[q]; const unsigned ww[4] = {w.x, w.y, w.z, w.w};
#pragma unroll
            for (int p = 0; p < 4; ++p) { VT[(e0 + 8 * q + 2 * p) * 136 + j] = (bf16_t)(ww[p] & 0xffffu); VT[(e0 + 8 * q + 2 * p + 1) * 136 + j] = (bf16_t)(ww[p] >> 16); } }
    }
    lds_barrier();
    {
        const int c = lane & 15, g = lane >> 4;
        bf16_t* kv = (bf16_t*)KV + (size_t)item * 32768;
#pragma unroll
        for (int r2 = 0; r2 < 2; ++r2) {
            const int te = 2 * wave + r2;
#pragma unroll
            for (int td = 0; td < 8; ++td) {
                f32x4 acc = {0.f, 0.f, 0.f, 0.f};
                mma_nt<4>(acc, KDT + 16 * td * 136, 136, VT + 16 * te * 136, 136, lane);
                u32x2 w; w.x = pk2(acc[0], acc[1]); w.y = pk2(acc[2], acc[3]);
                *(u32x2*)(kv + (16 * te + c) * 128 + 16 * td + 4 * g) = w;
            }
        }
    }
    lds_barrier();
}

constexpr int SC_UT = 62464, SC_GL = 67072, SC_BUF = 67088;
__device__ __forceinline__ void gdn_scan_task(LAS unsigned char* lds, int s, int slice, const unsigned char* gprep, const float* glv, bf16_t* mixed, float* KV, int rs_blk, int tid, int lane, int wave) {
    const int b = s >> 3, h = s & 7;
    const int c = lane & 15, g = lane >> 4, e0 = 32 * slice + 16 * (wave & 1);
    u32x4 SU[8]; bf16x8 Sb[4];
#pragma unroll
    for (int td = 0; td < 8; ++td) SU[td] = (u32x4){0u, 0u, 0u, 0u};
#pragma unroll
    for (int q = 0; q < 4; ++q) Sb[q] = (bf16x8){0, 0, 0, 0, 0, 0, 0, 0};
    u32x4 pf[8];
    const unsigned char* gp0 = gprep + (size_t)(s * 64) * GP_BYTES;
#define SC_LOAD(gq) do { _Pragma("unroll") for (int u = 0; u < 2; ++u) { pf[u] = *(const u32x4*)((gq) + GP_W + (size_t)(tid + NTHR * u) * 16); pf[2 + u] = *(const u32x4*)((gq) + GP_QE + (size_t)(tid + NTHR * u) * 16); \
        pf[5 + u] = *(const u32x4*)((gq) + GP_KT + (size_t)(tid + NTHR * u) * 16); } pf[4] = *(const u32x4*)((gq) + GP_AT + (size_t)tid * 16); \
        if (tid >= 256) pf[7] = *(const u32x4*)((gq) + GP_UT + (size_t)(32 * slice + ((tid - 256) >> 3)) * 128 + ((tid - 256) & 7) * 16); } while (0)
#define SC_STORE(bufp, itm) do { if (tid >= 256) *(LAS u32x4*)((bufp) + SC_UT + ((tid - 256) >> 3) * 144 + ((tid - 256) & 7) * 16) = pf[7]; if (tid == 255) *(LAS float*)((bufp) + SC_GL) = glv[itm]; \
        _Pragma("unroll") for (int u = 0; u < 2; ++u) { const int q = tid + NTHR * u; \
        *(LAS u32x4*)((LAS bf16_t*)(bufp) + (q >> 4) * 136 + (q & 15) * 8) = pf[u]; *(LAS u32x4*)((LAS bf16_t*)((bufp) + 17408) + (q >> 4) * 136 + (q & 15) * 8) = pf[2 + u]; \
        *(LAS u32x4*)((LAS bf16_t*)((bufp) + 44032) + (q >> 3) * 72 + (q & 7) * 8) = pf[5 + u]; } \
        *(LAS u32x4*)((LAS bf16_t*)((bufp) + 34816) + (tid >> 3) * 72 + (tid & 7) * 8) = pf[4]; } while (0)
    SC_LOAD(gp0); SC_STORE(lds, s * 64); SC_LOAD(gp0 + GP_BYTES);
    lds_barrier();
    for (int n = 0; n < 64; ++n) {
        LAS unsigned char* cur = lds + (n & 1) * SC_BUF; LAS unsigned char* nxt = lds + ((n + 1) & 1) * SC_BUF;
        const unsigned char* gp = gp0 + (size_t)n * GP_BYTES;
        if (n >= 1 && tid >= 128 && tid < 384) {
            const int u = tid - 128;
            const LAS bf16_t* OLp = (const LAS bf16_t*)(lds + 2 * SC_BUF + ((n - 1) & 1) * 5120);
            *(u32x4*)(mixed + ((size_t)b * T + (n - 1) * 64 + (u >> 2)) * D + 1024 + h * 128 + 32 * slice + (u & 3) * 8) = *(const LAS u32x4*)(OLp + (u >> 2) * 40 + (u & 3) * 8);
        }
        if (n + 1 < 64) SC_STORE(nxt, s * 64 + n + 1);
        if (n + 2 < 64) SC_LOAD(gp + 2 * GP_BYTES);
        if (wave >= 2 && rs_blk >= 0 && n < 7) {
            const int u = tid - 128;
            if (n >= 1 && (n - 1) * 384 + u < 2048) {
                const int cp = rs_blk * 2048 + (n - 1) * 384 + u, stream = cp >> 14;
                const float dec = __expf(128.f * __logf(1.f - exp2f(-5.f - (float)(stream & 3))));
                unsigned* p = (unsigned*)((bf16_t*)KV + (size_t)stream * 32 * 32768) + (cp & 16383);
                float st0 = 0.f, st1 = 0.f;
#pragma unroll
                for (int i = 0; i < 32; ++i) { const unsigned w = SU[i >> 2][i & 3]; p[(size_t)i * 16384] = pk2(st0, st1); st0 = st0 * dec + bflo(w); st1 = st1 * dec + bfhi(w); }
            }
            if (n < 6 && n * 384 + u < 2048) {
                const int cp = rs_blk * 2048 + n * 384 + u, stream = cp >> 14;
                const unsigned* p = (const unsigned*)((const bf16_t*)KV + (size_t)stream * 32 * 32768) + (cp & 16383);
#pragma unroll
                for (int i = 0; i < 32; ++i) SU[i >> 2][i & 3] = p[(size_t)i * 16384];
            }
        }
        if (wave < 2) {
            const LAS bf16_t* WL = (const LAS bf16_t*)cur; const LAS bf16_t* QE = (const LAS bf16_t*)(cur + 17408); const LAS bf16_t* AT = (const LAS bf16_t*)(cur + 34816); const LAS bf16_t* KT = (const LAS bf16_t*)(cur + 44032);
            const size_t m0 = (size_t)b * T + n * 64;
            const float gl = *(const LAS float*)(cur + SC_GL);
#define SC_SB __builtin_amdgcn_sched_barrier(0)
#define SC_LDP(dst, ti) do { _Pragma("unroll") for (int q = 0; q < 4; ++q) { dst[q] = *(const LAS bf16x8*)(WL + (16 * (ti) + c) * 136 + 32 * q + 8 * g); dst[4 + q] = *(const LAS bf16x8*)(QE + (16 * (ti) + c) * 136 + 32 * q + 8 * g); } } while (0)
#define SC_MMP(src, ti) do { _Pragma("unroll") for (int q = 0; q < 4; ++q) { P[ti] = __builtin_amdgcn_mfma_f32_16x16x32_bf16(src[q], Sb[q], P[ti], 0, 0, 0); O[ti] = __builtin_amdgcn_mfma_f32_16x16x32_bf16(src[4 + q], Sb[q], O[ti], 0, 0, 0); } } while (0)
#define SC_LDK(dst, t0) do { _Pragma("unroll") for (int t = 0; t < 4; ++t) _Pragma("unroll") for (int q = 0; q < 2; ++q) dst[2 * t + q] = *(const LAS bf16x8*)(KT + (16 * ((t0) + t) + c) * 72 + 32 * q + 8 * g); } while (0)
#define SC_MMK(src, t0) do { _Pragma("unroll") for (int t = 0; t < 4; ++t) { f32x4 a = __builtin_bit_cast(f32x4, SU[(t0) + t]) * gl; _Pragma("unroll") for (int q = 0; q < 2; ++q) a = __builtin_amdgcn_mfma_f32_16x16x32_bf16(src[2 * t + q], Vb[q], a, 0, 0, 0); SU[(t0) + t] = __builtin_bit_cast(u32x4, a); } } while (0)
            f32x4 P[4], O[4];
#pragma unroll
            for (int ti = 0; ti < 4; ++ti) { P[ti] = (f32x4){0.f, 0.f, 0.f, 0.f}; O[ti] = (f32x4){0.f, 0.f, 0.f, 0.f}; }
            bf16x8 fa[8], fb[8];
            SC_LDP(fa, 0);
            SC_LDP(fb, 1); SC_SB; SC_MMP(fa, 0); SC_SB;
            SC_LDP(fa, 2); SC_SB; SC_MMP(fb, 1); SC_SB;
            SC_LDP(fb, 3); SC_SB; SC_MMP(fa, 2); SC_SB;
#pragma unroll
            for (int ti = 0; ti < 4; ++ti)
#pragma unroll
                for (int q = 0; q < 2; ++q) fa[2 * ti + q] = *(const LAS bf16x8*)(AT + (16 * ti + c) * 72 + 32 * q + 8 * g);
            SC_SB; SC_MMP(fb, 3); SC_SB;
            u32x2 ut[4];
#pragma unroll
            for (int ti = 0; ti < 4; ++ti) ut[ti] = *(const LAS u32x2*)((const LAS bf16_t*)(cur + SC_UT) + (16 * (wave & 1) + c) * 72 + 16 * ti + 4 * g);
            f32x4 vn[4];
#pragma unroll
            for (int ti = 0; ti < 4; ++ti) vn[ti] = (f32x4){bflo(ut[ti].x) - P[ti][0], bfhi(ut[ti].x) - P[ti][1], bflo(ut[ti].y) - P[ti][2], bfhi(ut[ti].y) - P[ti][3]};
            bf16x8 Vb[2];
            Vb[0] = pack_tiles(vn[0], vn[1]); Vb[1] = pack_tiles(vn[2], vn[3]);
            SC_LDK(fb, 0); SC_SB;
#pragma unroll
            for (int ti = 0; ti < 4; ++ti)
#pragma unroll
                for (int q = 0; q < 2; ++q) O[ti] = __builtin_amdgcn_mfma_f32_16x16x32_bf16(fa[2 * ti + q], Vb[q], O[ti], 0, 0, 0);
            SC_SB;
            SC_LDK(fa, 4); SC_SB; SC_MMK(fb, 0); SC_SB;
            SC_MMK(fa, 4);
#undef SC_SB
#undef SC_LDP
#undef SC_MMP
#undef SC_LDK
#undef SC_MMK
#pragma unroll
            for (int q = 0; q < 4; ++q) Sb[q] = pack_tiles(__builtin_bit_cast(f32x4, SU[2 * q]), __builtin_bit_cast(f32x4, SU[2 * q + 1]));
            LAS bf16_t* OL = (LAS bf16_t*)(lds + 2 * SC_BUF + (n & 1) * 5120) + (4 * g) * 40 + 16 * (wave & 1) + c;
#pragma unroll
            for (int ti = 0; ti < 4; ++ti)
#pragma unroll
                for (int rr = 0; rr < 4; ++rr) OL[(16 * ti + rr) * 40] = (bf16_t)f2bf(O[ti][rr]);
        }
        lds_barrier();
    }
    if (tid >= 128 && tid < 384) {
        const int u = tid - 128;
        const LAS bf16_t* OLp = (const LAS bf16_t*)(lds + 2 * SC_BUF + 5120);
        *(u32x4*)(mixed + ((size_t)b * T + 63 * 64 + (u >> 2)) * D + 1024 + h * 128 + 32 * slice + (u & 3) * 8) = *(const LAS u32x4*)(OLp + (u >> 2) * 40 + (u & 3) * 8);
    }
    lds_barrier();
#undef SC_LOAD
#undef SC_STORE
}
__device__ __forceinline__ void gdn_norm_rows(const bf16_t* proj, const float* norm_w, bf16_t* mixed, int lane, int wave, int G) {
    const int gw = blockIdx.x * NWAVES + wave, NGW = G * NWAVES;
    float nw[16];
#pragma unroll
    for (int q = 0; q < 4; ++q) { const f32x4 w = *(const f32x4*)(norm_w + (lane & 7) * 16 + 4 * q); nw[4 * q] = w[0]; nw[4 * q + 1] = w[1]; nw[4 * q + 2] = w[2]; nw[4 * q + 3] = w[3]; }
    for (int m = gw; m < M; m += NGW) {
        bf16_t* op = mixed + (size_t)m * D + 1024 + lane * 16;
        const bf16_t* gq = proj + (size_t)m * NC + C_GG + lane * 16;
        float o[16], gg[16];
        unpack8(((const u32x4*)op)[0], o); unpack8(((const u32x4*)op)[1], o + 8); unpack8(__builtin_nontemporal_load((const u32x4*)gq), gg); unpack8(__builtin_nontemporal_load((const u32x4*)gq + 1), gg + 8);
        float ss = 0.f;
#pragma unroll
        for (int e = 0; e < 16; ++e) ss += o[e] * o[e];
        ss += __shfl_xor(ss, 1); ss += __shfl_xor(ss, 2); ss += __shfl_xor(ss, 4);
        const float rstd = rsqrtf(ss * (1.f / 128.f) + 1e-6f);
#pragma unroll
        for (int e = 0; e < 16; ++e) o[e] = o[e] * rstd * nw[e] * silu_f(gg[e]);
        ((u32x4*)op)[0] = pack8(o); ((u32x4*)op)[1] = pack8(o + 8);
    }
}

__device__ __forceinline__ void ret_scan(float* KV, float* KVdst, int tid, int first_blk, int G) {
    const long nthreads = (long)(G - first_blk) * NTHR, gid = (long)(blockIdx.x - first_blk) * NTHR + tid;
    for (long cp = gid; cp < 32L * 16384; cp += nthreads) {
        const int stream = (int)(cp >> 14), h = stream & 3;
        const float dec = __expf(128.f * __logf(1.f - exp2f(-5.f - (float)h)));
        const unsigned* p = (const unsigned*)((const bf16_t*)KV + (size_t)stream * 32 * 32768) + (cp & 16383);
        unsigned* pd = (unsigned*)((bf16_t*)KVdst + (size_t)stream * 32 * 32768) + (cp & 16383);
        unsigned kv[32];
#pragma unroll
        for (int n = 0; n < 32; ++n) kv[n] = p[(size_t)n * 16384];
        float st0 = 0.f, st1 = 0.f;
#pragma unroll
        for (int n = 0; n < 32; ++n) { pd[(size_t)n * 16384] = pk2(st0, st1); st0 = st0 * dec + bflo(kv[n]); st1 = st1 * dec + bfhi(kv[n]); }
    }
}

__device__ __forceinline__ void ret_out_item(LAS unsigned char* lds, int item, const bf16_t* proj, const float* KV, const float* gn_w, const float* gn_b, bf16_t* mixed, int tid, int lane, int wave) {
    const int n = item & 31, bh = item >> 5, h = bh & 3, b = bh >> 2;
    const int t0 = n * 128; const size_t m0 = (size_t)b * T + t0;
    LAS bf16_t* QS = (LAS bf16_t*)lds;
    LAS bf16_t* KD = (LAS bf16_t*)(lds + 34816);
    LAS bf16_t* VT = (LAS bf16_t*)(lds + 69632);
    LAS bf16_t* ST = (LAS bf16_t*)(lds + 104448);
    const float lg = __logf(1.f - exp2f(-5.f - (float)h));
    const int c = lane & 15, g = lane >> 4;
    {
        const int j = tid >> 2, part = tid & 3, d0 = 16 * part;
        float lo[16], hi[16];
        const bf16_t* qp = proj + (m0 + j) * NC + C_RQ + h * 128 + d0;
        unpack8(((const u32x4*)qp)[0], lo); unpack8(((const u32x4*)qp)[1], lo + 8); unpack8(((const u32x4*)(qp + 64))[0], hi); unpack8(((const u32x4*)(qp + 64))[1], hi + 8);
        rot16(lo, hi, t0 + j, d0);
        *(LAS u32x4*)(QS + j * 136 + d0) = pack8(lo); *(LAS u32x4*)(QS + j * 136 + d0 + 8) = pack8(lo + 8);
        *(LAS u32x4*)(QS + j * 136 + 64 + d0) = pack8(hi); *(LAS u32x4*)(QS + j * 136 + 64 + d0 + 8) = pack8(hi + 8);
        const bf16_t* kp = proj + (m0 + j) * NC + C_RK + h * 128 + d0;
        unpack8(((const u32x4*)kp)[0], lo); unpack8(((const u32x4*)kp)[1], lo + 8); unpack8(((const u32x4*)(kp + 64))[0], hi); unpack8(((const u32x4*)(kp + 64))[1], hi + 8);
        rot16(lo, hi, t0 + j, d0);
#pragma unroll
        for (int e = 0; e < 16; ++e) { lo[e] *= QK_SCALE; hi[e] *= QK_SCALE; }
        *(LAS u32x4*)(KD + j * 136 + d0) = pack8(lo); *(LAS u32x4*)(KD + j * 136 + d0 + 8) = pack8(lo + 8);
        *(LAS u32x4*)(KD + j * 136 + 64 + d0) = pack8(hi); *(LAS u32x4*)(KD + j * 136 + 64 + d0 + 8) = pack8(hi + 8);
    }
    lds_barrier();
    f32x4 sc[8];
#pragma unroll
    for (int tj = 0; tj < 8; ++tj) { sc[tj] = (f32x4){0.f, 0.f, 0.f, 0.f}; if (tj <= wave) mma_nt<4>(sc[tj], QS + 16 * wave * 136, 136, KD + 16 * tj * 136, 136, lane); }
    lds_barrier();
#pragma unroll
    for (int tj = 0; tj < 8; ++tj) {
        const int j = 16 * tj + c; const float gpw = __expf(-lg * (float)(j + 1));
#pragma unroll
        for (int rr = 0; rr < 4; ++rr) { const int i = 16 * wave + 4 * g + rr; KD[i * 136 + j] = (bf16_t)f2bf((i >= j) ? sc[tj][rr] * gpw : 0.f); }
    }
    f32x4 acc[16];
#pragma unroll
    for (int half = 0; half < 2; ++half) {
        if (half == 1) lds_barrier();
        {
            const int j = tid >> 2, part = tid & 3, e0 = 32 * part;
            const u32x4* vp = (const u32x4*)(proj + (m0 + j) * NC + C_RV + h * 256 + half * 128 + e0);
#pragma unroll
            for (int q = 0; q < 4; ++q) { const u32x4 w = vp[q]; const unsigned ww[4] = {w.x, w.y, w.z, w.w};
#pragma unroll
                for (int p = 0; p < 4; ++p) { VT[(e0 + 8 * q + 2 * p) * 136 + j] = (bf16_t)(ww[p] & 0xffffu); VT[(e0 + 8 * q + 2 * p + 1) * 136 + j] = (bf16_t)(ww[p] >> 16); } }
            const bf16_t* kv = (const bf16_t*)KV + (size_t)item * 32768 + (size_t)half * 128 * 128;
#pragma unroll
            for (int u = 0; u < 4; ++u) { const int q = tid + NTHR * u, e = q >> 4, part = q & 15; *(LAS u32x4*)(ST + e * 136 + part * 8) = *(const u32x4*)(kv + e * 128 + part * 8); }
        }
        lds_barrier();
#pragma unroll
        for (int te = 0; te < 8; ++te) {
            f32x4 a = {0.f, 0.f, 0.f, 0.f};
            mma_nt<4>(a, VT + 16 * te * 136, 136, KD + 16 * wave * 136, 136, lane);
            mma_nt<4>(a, ST + 16 * te * 136, 136, QS + 16 * wave * 136, 136, lane);
            acc[half * 8 + te] = a;
        }
    }
    {
        const int i = 16 * wave + c;
        const float qd = __expf(lg * (float)(i + 1));
        float sm = 0.f;
#pragma unroll
        for (int t = 0; t < 16; ++t) { acc[t] = acc[t] * qd; sm += (acc[t][0] + acc[t][1]) + (acc[t][2] + acc[t][3]); }
        sm += __shfl_xor(sm, 16); sm += __shfl_xor(sm, 32);
        const float mean = sm * (1.f / 256.f);
        float v = 0.f;
#pragma unroll
        for (int t = 0; t < 16; ++t) { acc[t] = acc[t] - mean; v += (acc[t][0] * acc[t][0] + acc[t][1] * acc[t][1]) + (acc[t][2] * acc[t][2] + acc[t][3] * acc[t][3]); }
        v += __shfl_xor(v, 16); v += __shfl_xor(v, 32);
        const float rstd = rsqrtf(v * (1.f / 256.f) + 1e-5f);
        const bf16_t* rg = proj + (m0 + i) * NC + C_RG + h * 256 + 4 * g;
        bf16_t* mo = mixed + (m0 + i) * D + h * 256 + 4 * g;
        const float* gw_ = gn_w + h * 256 + 4 * g; const float* gb_ = gn_b + h * 256 + 4 * g;
#pragma unroll
        for (int t = 0; t < 16; ++t) {
            const u32x2 rgv = *(const u32x2*)(rg + 16 * t);
            const f32x4 w4 = *(const f32x4*)(gw_ + 16 * t), b4 = *(const f32x4*)(gb_ + 16 * t);
            const f32x4 o = acc[t] * rstd * w4 + b4;
            u32x2 w; w.x = pk2(o[0] * silu_f(bflo(rgv.x)), o[1] * silu_f(bfhi(rgv.x))); w.y = pk2(o[2] * silu_f(bflo(rgv.y)), o[3] * silu_f(bfhi(rgv.y)));
            *(u32x2*)(mo + 16 * t) = w;
        }
    }
    lds_barrier();
}

__device__ __forceinline__ void ln_rows(const bf16_t* z, float* dst, const float* ln_w, const float* ln_b, int lane, int wave, int G) {
    const int gw = blockIdx.x * NWAVES + wave, NGW = G * NWAVES;
    for (int m = gw; m < M; m += NGW) {
        const u32x4* zr = (const u32x4*)(z + (size_t)m * D) + lane;
        float v[4][8]; float s = 0.f;
#pragma unroll
        for (int j = 0; j < 4; ++j) { unpack8(__builtin_nontemporal_load(zr + 64 * j), v[j]);
#pragma unroll
            for (int e = 0; e < 8; ++e) s += v[j][e]; }
        const float mean = wave_sum(s) * (1.f / D); float s2 = 0.f;
#pragma unroll
        for (int j = 0; j < 4; ++j)
#pragma unroll
            for (int e = 0; e < 8; ++e) { v[j][e] -= mean; s2 += v[j][e] * v[j][e]; }
        const float rstd = rsqrtf(wave_sum(s2) * (1.f / D) + 1e-5f);
        float* drow = dst + (size_t)m * D + 8 * lane;
#pragma unroll
        for (int j = 0; j < 4; ++j) {
            const f32x4 w0 = *(const f32x4*)(ln_w + 8 * lane + 512 * j), w1 = *(const f32x4*)(ln_w + 8 * lane + 512 * j + 4);
            const f32x4 b0 = *(const f32x4*)(ln_b + 8 * lane + 512 * j), b1 = *(const f32x4*)(ln_b + 8 * lane + 512 * j + 4);
            __builtin_nontemporal_store((f32x4){v[j][0], v[j][1], v[j][2], v[j][3]} * rstd * w0 + b0, (f32x4*)(drow + 512 * j));
            __builtin_nontemporal_store((f32x4){v[j][4], v[j][5], v[j][6], v[j][7]} * rstd * w1 + b1, (f32x4*)(drow + 512 * j + 4));
        }
    }
}

#ifndef MK_N_LAUNCHES
#define MK_N_LAUNCHES 1
#endif
constexpr int N_PHASES = 8;
constexpr size_t WS_CTL = 3 * MiB + 512 * 1024; constexpr int CTL_BYTES = 16384;
#define XB_TMO      128
#define XB_XCNT(j)  (256  + 64 * (j))
#define XB_XSUB(j)  (1280 + 64 * (j))
#define XB_XGEN(j)  (2304 + 64 * (j))
#define XB_TOP      3328
#define XB_TOPGEN   3392
#define XCD_BAR_WORDS 3456
#define XB_SPIN_CAP (1u << 18)

__device__ __forceinline__ unsigned xb_ld(unsigned* p)              { return __hip_atomic_load(p, __ATOMIC_RELAXED, __HIP_MEMORY_SCOPE_AGENT); }
__device__ __forceinline__ unsigned xb_add(unsigned* p, unsigned v) { return __hip_atomic_fetch_add(p, v, __ATOMIC_RELAXED, __HIP_MEMORY_SCOPE_AGENT); }
__device__ __forceinline__ unsigned xb_xcc_id() { return (unsigned)__builtin_amdgcn_s_getreg((3 << 11) | 20) & 0xFu; }
#define XB_SPIN(cond, bar) do { unsigned _sp = 0; while (cond) { __builtin_amdgcn_s_sleep(1); \
    if ((++_sp & 255u) == 0u) { if (xb_ld(&(bar)[XB_TMO])) break; if (_sp > XB_SPIN_CAP) { atomicAdd(&(bar)[XB_TMO], 1u); break; } } } } while (0)

struct XcdBarrier {
    unsigned* bar; unsigned x;
    volatile LAS unsigned* st;
};

__device__ __forceinline__ XcdBarrier xcd_barrier_post(unsigned* bar, volatile LAS unsigned* st) {
    XcdBarrier b; b.bar = bar; b.x = xb_xcc_id(); b.st = st;
    if (threadIdx.x == 0) (void)xb_add(&bar[XB_XCNT(b.x)], 1u);
    return b;
}
__device__ __forceinline__ void xcd_barrier_complete(unsigned* bar, unsigned x, unsigned& nloc, unsigned& nx) {
    const unsigned G = gridDim.x * gridDim.y * gridDim.z;
    unsigned sum, cnt, mine, sp = 0u;
    for (;;) {
        sum = 0u; cnt = 0u; mine = 0u;
#pragma unroll
        for (unsigned j = 0; j < 16; ++j) { const unsigned c = xb_ld(&bar[XB_XCNT(j)]); sum += c; cnt += (c > 0u) ? 1u : 0u; mine = (j == x) ? c : mine; }
        if (sum == G) break;
        __builtin_amdgcn_s_sleep(1);
        if ((++sp & 255u) == 0u) { if (xb_ld(&bar[XB_TMO])) break; if (sp > XB_SPIN_CAP) { atomicAdd(&bar[XB_TMO], 1u); break; } }
    }
    nloc = mine > 0u ? mine : 1u; nx = cnt > 0u ? cnt : 1u;
}

__device__ __forceinline__ void xcd_barrier(const XcdBarrier& b) {
    asm volatile("s_waitcnt vmcnt(0)" ::: "memory");
    __syncthreads();
    if (threadIdx.x == 0) {
        unsigned* bar = b.bar;
        __builtin_amdgcn_s_waitcnt(0);
        unsigned nloc = b.st[0], nx = b.st[1];
        if (nloc == 0u) { xcd_barrier_complete(bar, b.x, nloc, nx); b.st[0] = nloc; b.st[1] = nx; }
        const unsigned old = xb_add(&bar[XB_XSUB(b.x)], 1u);
        const unsigned gen = old / nloc;
        if (old + 1u == (gen + 1u) * nloc) {
            __builtin_amdgcn_fence(__ATOMIC_RELEASE, "agent");
            asm volatile("s_waitcnt vmcnt(0)" ::: "memory");
            const unsigned og = xb_add(&bar[XB_TOP], 1u);
            const unsigned tg = og / nx;
            if (og + 1u == (tg + 1u) * nx) xb_add(&bar[XB_TOPGEN], 1u);
            else XB_SPIN(xb_ld(&bar[XB_TOPGEN]) == tg, bar);
            __builtin_amdgcn_fence(__ATOMIC_ACQUIRE, "agent");
            xb_add(&bar[XB_XGEN(b.x)], 1u);
            asm volatile("s_waitcnt vmcnt(0)" ::: "memory");
        } else {
            XB_SPIN(xb_ld(&bar[XB_XGEN(b.x)]) == gen, bar);
            __builtin_amdgcn_fence(__ATOMIC_ACQUIRE, "agent");
            asm volatile("s_waitcnt vmcnt(0)" ::: "memory");
        }
    }
    __syncthreads();
}

struct Args { const float* in[14]; float* out; unsigned char* ws; int ph_lo, ph_hi, nsync, pad; };
__global__ void __launch_bounds__(NTHR) hybrid_fwd(Args args) {
    extern __shared__ __attribute__((aligned(16))) unsigned char lds_raw[];
    LAS unsigned char* lds = (LAS unsigned char*)lds_raw;
    cg::grid_group grid = cg::this_grid();
    const int tid = threadIdx.x, lane = tid & 63, wave = __builtin_amdgcn_readfirstlane(tid >> 6), G = gridDim.x;
    const float* x = args.in[0]; const float* cvec = args.in[1]; const float* w_ada = args.in[2]; const float* b_ada = args.in[3]; const float* w_in = args.in[4];
    const float* conv_w = args.in[5]; const float* a_log = args.in[6]; const float* dt_bias = args.in[7]; const float* gn_w = args.in[8]; const float* gn_b = args.in[9];
    const float* norm_w = args.in[10]; const float* w_out = args.in[11]; const float* ln_w = args.in[12]; const float* ln_b = args.in[13];
    unsigned char* ws = args.ws; float* out = args.out;
    float* mod = (float*)(ws + WS_MOD); float* gdec = (float*)(ws + WS_G); float* beta = (float*)(ws + WS_BETA); float* glv = (float*)(ws + WS_GL);
    bf16_t* WoutT = (bf16_t*)(ws + WS_WOUT); bf16_t* WinT = (bf16_t*)(ws + WS_WIN); bf16_t* hin = (bf16_t*)(ws + WS_HIN); bf16_t* mixed = hin;
    bf16_t* proj = (bf16_t*)(ws + WS_PROJ); unsigned char* gprep = ws + WS_GPREP; float* KV = out;
    const int lo = args.ph_lo, hi = args.ph_hi;
#define IN(k) (lo <= (k) && (k) < hi)
#define SEAM(k) do { if (IN(k) && IN((k) + 1)) xcd_barrier(bar); } while (0)

    volatile LAS unsigned* bst = (volatile LAS unsigned*)(lds + LDS_BYTES - 16);
    if (tid == 0) { bst[0] = 0u; bst[1] = 0u; }
    __syncthreads();
    XcdBarrier bar = xcd_barrier_post((unsigned*)(ws + WS_CTL), bst);
    for (int i = 0; i < args.nsync; ++i) grid.sync();
    if (IN(0)) p0_phase(lds, cvec, w_ada, b_ada, w_in, w_out, mod, WinT, WoutT, tid, lane, wave, G, 1);
    SEAM(0);
    if (IN(1)) p1_phase(lds, x, w_in, mod, a_log, dt_bias, hin, gdec, beta, tid, lane, wave, G, 1);
    SEAM(1);
    if (IN(2)) {
        pg8::Gemm g{hin, WinT, M, NC, D}; pg8::StaticOrder S; S.init(M, NC, G, (int)blockIdx.x, 1);
        pg8::EpiBf16 E{proj, NC};
        pg8::gemm_phase<pg8::EpiBf16, pg8::StaticOrder, true, true>(lds, g, S, E);
    }
    SEAM(2);
    if (IN(3)) {
        for (int v = blockIdx.x; v < 256; v += G) gdn_prep_block(lds, v & 255, proj, conv_w, gdec, beta, gprep, glv, tid, lane, wave);
        for (int it = blockIdx.x; it < 1024; it += G) ret_kv_item(lds, it & 1023, proj, KV, tid, lane, wave);
    }
    SEAM(3);
    if (IN(4)) {
        const bool fuse = (G == 256);
        for (int task = blockIdx.x; task < 256; task += G) { const int tk = task & 255, xcd = tk & 7, loc = tk >> 3; gdn_scan_task(lds, xcd * 8 + (loc >> 2), loc & 3, gprep, glv, mixed, KV, (fuse && task < 256) ? tk : -1, tid, lane, wave); }
        if (!fuse) ret_scan(KV, KV, tid, 0, G);
    }
    SEAM(4);
    if (IN(5)) { for (int it = blockIdx.x; it < 1024; it += G) ret_out_item(lds, it & 1023, proj, KV, gn_w, gn_b, mixed, tid, lane, wave);
        gdn_norm_rows(proj, norm_w, mixed, lane, wave, G); }
    SEAM(5);
    if (IN(6)) {
        pg8::Gemm g{mixed, WoutT, M, D, D}; pg8::StaticOrder S; S.init(M, D, G, (int)blockIdx.x, 1);
        pg8::EpiZ16 E{x, mod + 4096, (bf16_t*)(ws + WS_PROJ), 1.189207115002721f};
        pg8::gemm_phase<pg8::EpiZ16, pg8::StaticOrder, true, true>(lds, g, S, E);
    }
    SEAM(6);
    if (IN(7)) { ln_rows((const bf16_t*)(ws + WS_PROJ), out, ln_w, ln_b, lane, wave, G); }
#undef IN
#undef SEAM
}

extern "C" void kernel_launch(void* const* d_in, const int* in_sizes, int n_in, void* d_out, int out_size, void* d_ws, size_t ws_size, hipStream_t stream) {
    static int grid = 0;
    if (grid == 0) {
        if (n_in != 14 || out_size != M * D || ws_size < WS_END) { fprintf(stderr, "kernel_launch: unexpected problem (n_in %d, out %d, ws %zu)\n", n_in, out_size, ws_size); grid = -1; return; }
        int dev = 0, cus = 0, per_cu = 0;
        if (hipGetDevice(&dev) != hipSuccess || hipDeviceGetAttribute(&cus, hipDeviceAttributeMultiprocessorCount, dev) != hipSuccess) { grid = -1; return; }
        if (hipFuncSetAttribute((const void*)hybrid_fwd, hipFuncAttributeMaxDynamicSharedMemorySize, LDS_BYTES) != hipSuccess) { fprintf(stderr, "kernel_launch: hipFuncSetAttribute failed\n"); grid = -1; return; }
        if (hipOccupancyMaxActiveBlocksPerMultiprocessor(&per_cu, (const void*)hybrid_fwd, NTHR, LDS_BYTES) != hipSuccess || per_cu < 1) { fprintf(stderr, "kernel_launch: occupancy query reports %d blocks per CU\n", per_cu); (void)hipGetLastError(); per_cu = 1; }
        grid = cus * 1;
    }
    if (grid < 0) return;
    if (hipMemsetAsync((char*)d_ws + WS_CTL, 0, CTL_BYTES, stream) != hipSuccess) { fprintf(stderr, "kernel_launch: memset of the barrier words failed\n"); return; }
    Args a{};
    for (int i = 0; i < 14; ++i) a.in[i] = (const float*)d_in[i];
    a.out = (float*)d_out; a.ws = (unsigned char*)d_ws; a.nsync = 0;
    for (int li = 0; li < MK_N_LAUNCHES; ++li) {
        if (MK_N_LAUNCHES == 1) { a.ph_lo = 0; a.ph_hi = N_PHASES; } else { a.ph_lo = li; a.ph_hi = li + 1; }
        void* kargs[] = {&a};
        const hipError_t e = hipLaunchCooperativeKernel((const void*)hybrid_fwd, dim3(grid), dim3(NTHR), kargs, LDS_BYTES, stream);
        if (e != hipSuccess) { fprintf(stderr, "kernel_launch: cooperative launch failed: %s (grid %d)\n", hipGetErrorString(e), grid); break; }
    }
}
```

```cpp
#include <hip/hip_runtime.h>
#include <hip/hip_cooperative_groups.h>
#include <cstdio>
#include <cstdint>
namespace cg = cooperative_groups;
namespace pg8 {
#define PG8_LAS __attribute__((address_space(3)))
typedef unsigned short bf16_t;
typedef short bf16x8 __attribute__((ext_vector_type(8)));
typedef float f32x4 __attribute__((ext_vector_type(4)));
typedef unsigned u32x4 __attribute__((ext_vector_type(4)));
constexpr int BM = 256, BK = 64, HALF = 128, HTB = HALF * BK * 2  , STAGE_BYTES = 8 * HTB, NXCD = 8, WGM = 8;

__host__ __device__ __forceinline__ int lds_byte(int r, int c) { const int st = (r >> 4) * 2 + (c >> 5), rr = r & 15, cc = c & 31, ob = rr * 64 + cc * 2; return st * 1024 + (ob ^ (((ob >> 9) & 1) << 5)); }
__host__ __device__ __forceinline__ void stage_rc(int b, int& R, int& C) { const int st = b / 1024, sb = b % 1024, swz = sb ^ (((sb >> 9) & 1) << 5); R = (st >> 1) * 16 + swz / 64; C = (st & 1) * 32 + (swz % 64) / 2; }
__host__ __device__ __forceinline__ int perm32(int rho) { const int n = rho >> 4, i = rho & 15; return 8 * (i >> 2) + 4 * n + (i & 3); }

struct Unit { int pm, pn; };
struct Gemm { const bf16_t* A; const bf16_t* Bt; int M, N, K; };

struct StaticOrder {
    int nM, nN, nwg, G, c, nrep;
    __host__ __device__ void init(int M, int N, int G_, int c_, int nrep_ = 1) { nM = M / BM; nN = N / BM; nwg = nM * nN; G = G_; c = c_; nrep = nrep_; }
    __host__ __device__ bool next(int i, Unit& u) const {
        const long L = (long)i * G + c; if (L >= (long)nwg * nrep) return false;
        int wgid = (int)(L % nwg); { const int q = nwg / NXCD, r = nwg % NXCD, xcd = wgid % NXCD, off = wgid / NXCD; wgid = (xcd < r ? xcd * (q + 1) : r * (q + 1) + (xcd - r) * q) + off; }
        const int nig = WGM * nN, gid = wgid / nig, fm = gid * WGM, gsz = (nM - fm) < WGM ? (nM - fm) : WGM;
        u.pm = fm + ((wgid % nig) % gsz); u.pn = (wgid % nig) / gsz; return true;
    }
    __device__ __forceinline__ void a_ready(const Unit&) const {}
    __device__ __forceinline__ void done(const Unit&) const {}
};

__device__ __forceinline__ unsigned cvt_pk_bf16(float lo, float hi) { unsigned r; asm volatile("v_cvt_pk_bf16_f32 %0, %1, %2" : "=v"(r) : "v"(lo), "v"(hi)); return r; }
struct EpiBf16 {
    static constexpr bool PERM = true, AFTER_DRAIN = false;
    bf16_t* O; int ldc;
    __device__ __forceinline__ void operator()(const f32x4 (&acc)[2][2][4][2], const Unit& u, int wr, int wc, int fr, int fq) const {
        const int row0 = u.pm * BM + wr * 64 + fr; const int col0 = u.pn * BM + wc * 32 + 8 * fq;
#pragma unroll
        for (int ai = 0; ai < 2; ++ai)
#pragma unroll
            for (int m = 0; m < 4; ++m) { bf16_t* rowp = O + (size_t)(row0 + ai * HALF + m * 16) * ldc + col0;
#pragma unroll
                for (int bj = 0; bj < 2; ++bj) { const f32x4 v0 = acc[ai][bj][m][0], v1 = acc[ai][bj][m][1];
                    u32x4 w; w.x = cvt_pk_bf16(v0[0], v0[1]); w.y = cvt_pk_bf16(v0[2], v0[3]); w.z = cvt_pk_bf16(v1[0], v1[1]); w.w = cvt_pk_bf16(v1[2], v1[3]);
                    *(u32x4*)(rowp + bj * HALF) = w; } }
    }
};
struct EpiZ {
    static constexpr bool PERM = false, AFTER_DRAIN = false;
    const float* x; const float* gate; float* out; float alpha;
    __device__ __forceinline__ void operator()(const f32x4 (&acc)[2][2][4][2], const Unit& u, int wr, int wc, int fr, int fq) const {
        const int col0 = u.pn * BM + wc * 32 + 4 * fq;
#pragma unroll
        for (int ai = 0; ai < 2; ++ai)
#pragma unroll
            for (int m = 0; m < 4; ++m) { const int r = u.pm * BM + ai * HALF + wr * 64 + m * 16 + fr; const size_t off = (size_t)r * 2048 + col0; const float* gb = gate + (size_t)(r >> 12) * 6144 + col0;
#pragma unroll
                for (int bj = 0; bj < 2; ++bj)
#pragma unroll
                    for (int n = 0; n < 2; ++n) { const f32x4 xv = *(const f32x4*)(x + off + bj * HALF + n * 16); const f32x4 gv = *(const f32x4*)(gb + bj * HALF + n * 16);
                        *(f32x4*)(out + off + bj * HALF + n * 16) = xv * alpha + gv * acc[ai][bj][m][n]; } }
    }
};
struct EpiZ16 {
    static constexpr bool PERM = true, AFTER_DRAIN = false;
    const float* x; const float* gate; bf16_t* z; float alpha;
    __device__ __forceinline__ void operator()(const f32x4 (&acc)[2][2][4][2], const Unit& u, int wr, int wc, int fr, int fq) const {
        const int col0 = u.pn * BM + wc * 32 + 8 * fq;
        const float* gb = gate + (size_t)((u.pm * BM) >> 12) * 6144 + col0;
        const f32x4 g00 = *(const f32x4*)(gb), g01 = *(const f32x4*)(gb + 4), g10 = *(const f32x4*)(gb + HALF), g11 = *(const f32x4*)(gb + HALF + 4);
#pragma unroll
        for (int ai = 0; ai < 2; ++ai)
#pragma unroll
            for (int m = 0; m < 4; ++m) { const int r = u.pm * BM + ai * HALF + wr * 64 + m * 16 + fr; const size_t off = (size_t)r * 2048 + col0;
#pragma unroll
                for (int bj = 0; bj < 2; ++bj) {
                    const f32x4 x0 = __builtin_nontemporal_load((const f32x4*)(x + off + bj * HALF)), x1 = __builtin_nontemporal_load((const f32x4*)(x + off + bj * HALF + 4));
                    const f32x4 v0 = x0 * alpha + (bj ? g10 : g00) * acc[ai][bj][m][0], v1 = x1 * alpha + (bj ? g11 : g01) * acc[ai][bj][m][1];
                    u32x4 w; w.x = cvt_pk_bf16(v0[0], v0[1]); w.y = cvt_pk_bf16(v0[2], v0[3]); w.z = cvt_pk_bf16(v1[0], v1[1]); w.w = cvt_pk_bf16(v1[2], v1[3]);
                    *(u32x4*)(z + off + bj * HALF) = w; } }
    }
};
template <class Epi, class Sched, bool ALIGN_EPI = false, bool SP2 = false>
__device__ __forceinline__ void gemm_phase(PG8_LAS unsigned char* lds, const Gemm g, const Sched& S, const Epi& E) {
    const int tid = threadIdx.x, wid = __builtin_amdgcn_readfirstlane(tid >> 6), lane = tid & 63, wr = wid >> 2, wc = wid & 3, fr = lane & 15, fq = lane >> 4;
    const int K = g.K, nt = K / BK;
    unsigned voffA[2], voffB[2];
#pragma unroll
    for (int i = 0; i < 2; ++i) { int R, C; stage_rc(tid * 16 + i * 8192, R, C); const int Rb = Epi::PERM ? ((R & ~31) + perm32(R & 31)) : R;
        voffA[i] = (unsigned)(R * K + C) * 2u; voffB[i] = (unsigned)(Rb * K + C) * 2u; }
    const size_t kstep = (size_t)(BK * 2);
    const size_t hstep = (size_t)HALF * K * 2;
    const size_t tstep = 2 * hstep;
    const unsigned ldsw = (unsigned)wid * 1024u;
    const int aoff = lds_byte(wr * 64 + fr, fq * 8), boff = lds_byte(wc * 32 + fr, fq * 8);
#define PG8_SA(b, h) (((b) * 2 + (h)) * HTB)
#define PG8_SB(b, h) ((4 + (b) * 2 + (h)) * HTB)
#define PG8_STAGE(bufoff, gbase, voff) do { _Pragma("unroll") for (int _i = 0; _i < 2; ++_i) \
        __builtin_amdgcn_global_load_lds((const unsigned*)((const char*)(gbase) + (voff)[_i]), (PG8_LAS unsigned*)(lds + (bufoff) + ldsw + _i * 8192), 16, 0, 0); } while (0)
#define PG8_LDA(dst, b, h) do { _Pragma("unroll") for (int m = 0; m < 4; ++m) _Pragma("unroll") for (int k = 0; k < 2; ++k) dst[m][k] = *(const PG8_LAS bf16x8*)(lds + PG8_SA(b, h) + aoff + m * 2048 + k * 1024); } while (0)
#define PG8_LDB(dst, b, h) do { _Pragma("unroll") for (int n = 0; n < 2; ++n) _Pragma("unroll") for (int k = 0; k < 2; ++k) dst[n][k] = *(const PG8_LAS bf16x8*)(lds + PG8_SB(b, h) + boff + n * 2048 + k * 1024); } while (0)
#define PG8_MMA(ai, bj, At, Bt) do { __builtin_amdgcn_s_setprio(1); _Pragma("unroll") for (int m = 0; m < 4; ++m) _Pragma("unroll") for (int n = 0; n < 2; ++n) _Pragma("unroll") for (int k = 0; k < 2; ++k) \
        acc[ai][bj][m][n] = __builtin_amdgcn_mfma_f32_16x16x32_bf16(Bt[n][k], At[m][k], acc[ai][bj][m][n], 0, 0, 0); __builtin_amdgcn_s_setprio(0); } while (0)
#define PG8_WAIT_V(n) asm volatile("s_waitcnt vmcnt(" #n ")" ::: "memory")
#define PG8_WAIT_L(n) asm volatile("s_waitcnt lgkmcnt(" #n ")" ::: "memory")
#define PG8_BAR __builtin_amdgcn_s_barrier()
#define PG8_SCHED __builtin_amdgcn_sched_barrier(0)
    Unit cur, nxt; int ui = 0;
    if (!S.next(0, cur)) return;
    f32x4 acc[2][2][4][2];
#pragma unroll
    for (int a = 0; a < 2; ++a)
#pragma unroll
        for (int b = 0; b < 2; ++b)
#pragma unroll
            for (int m = 0; m < 4; ++m)
#pragma unroll
                for (int n = 0; n < 2; ++n) acc[a][b][m][n] = (f32x4){0.f, 0.f, 0.f, 0.f};
    bf16x8 At[4][2], B0[2][2], B1[2][2];
    const char* cA = (const char*)g.A + (size_t)cur.pm * tstep; const char* cB = (const char*)g.Bt + (size_t)cur.pn * tstep;
    S.a_ready(cur);
    if constexpr (SP2) {
        PG8_STAGE(PG8_SB(0, 0), cB, voffB); PG8_STAGE(PG8_SB(0, 1), cB + hstep, voffB); PG8_STAGE(PG8_SA(0, 0), cA, voffA); PG8_STAGE(PG8_SA(0, 1), cA + hstep, voffA);
        if (wr == 1) PG8_BAR;
        PG8_WAIT_V(2); PG8_BAR;
        PG8_STAGE(PG8_SB(1, 0), cB + kstep, voffB); PG8_STAGE(PG8_SA(1, 0), cA + kstep, voffA); PG8_STAGE(PG8_SB(1, 1), cB + hstep + kstep, voffB);
        PG8_WAIT_V(6); PG8_BAR;
    } else {
        PG8_STAGE(PG8_SB(0, 0), cB, voffB); PG8_STAGE(PG8_SA(0, 0), cA, voffA); PG8_STAGE(PG8_SB(0, 1), cB + hstep, voffB); PG8_STAGE(PG8_SA(0, 1), cA + hstep, voffA);
        if (wr == 1) PG8_BAR;
        PG8_WAIT_V(4); PG8_BAR;
        PG8_STAGE(PG8_SB(1, 0), cB + kstep, voffB); PG8_STAGE(PG8_SA(1, 0), cA + kstep, voffA); PG8_STAGE(PG8_SB(1, 1), cB + hstep + kstep, voffB);
        PG8_WAIT_V(6); PG8_BAR;
    }
    for (;;) {
        const bool has_next = S.next(ui + 1, nxt);
        const char* nA = has_next ? (const char*)g.A + (size_t)nxt.pm * tstep : cA; const char* nB = has_next ? (const char*)g.Bt + (size_t)nxt.pn * tstep : cB;
        for (int t = 0; t < nt; t += 2) {
            const bool last = (t == nt - 2);
            const char* a1 = cA + (size_t)(t + 1) * kstep;
            const char* a2 = last ? nA : cA + (size_t)(t + 2) * kstep; const char* b2 = last ? nB : cB + (size_t)(t + 2) * kstep;
            const char* a3 = a2 + kstep; const char* b3 = b2 + kstep;
            if (last && has_next) S.a_ready(nxt);
            if constexpr (SP2) {
            PG8_LDB(B0, 0, 0); PG8_LDB(B1, 0, 1); PG8_SCHED; PG8_LDA(At, 0, 0); PG8_STAGE(PG8_SA(1, 1), a1 + hstep, voffA);
            PG8_WAIT_V(8); PG8_WAIT_L(0); PG8_BAR; PG8_MMA(0, 0, At, B0); PG8_MMA(0, 1, At, B1); PG8_BAR; PG8_SCHED;
            PG8_LDA(At, 0, 1); PG8_STAGE(PG8_SB(0, 0), b2, voffB); PG8_STAGE(PG8_SB(0, 1), b2 + hstep, voffB); PG8_STAGE(PG8_SA(0, 0), a2, voffA);
            PG8_WAIT_V(8); PG8_WAIT_L(0); PG8_BAR; PG8_MMA(1, 0, At, B0); PG8_MMA(1, 1, At, B1); PG8_BAR; PG8_SCHED;
            PG8_LDB(B0, 1, 0); PG8_LDB(B1, 1, 1); PG8_SCHED; PG8_LDA(At, 1, 0); PG8_STAGE(PG8_SA(0, 1), a2 + hstep, voffA);
            PG8_WAIT_V(8); PG8_WAIT_L(0); PG8_BAR; PG8_MMA(0, 0, At, B0); PG8_MMA(0, 1, At, B1); PG8_BAR; PG8_SCHED;
            PG8_LDA(At, 1, 1); PG8_STAGE(PG8_SB(1, 0), b3, voffB); PG8_STAGE(PG8_SB(1, 1), b3 + hstep, voffB); PG8_STAGE(PG8_SA(1, 0), a3, voffA);
            PG8_WAIT_V(8); PG8_WAIT_L(0); PG8_BAR; PG8_MMA(1, 0, At, B0); PG8_MMA(1, 1, At, B1); PG8_BAR; PG8_SCHED;
            } else {
            PG8_LDB(B0, 0, 0); PG8_SCHED; PG8_LDA(At, 0, 0); PG8_STAGE(PG8_SA(1, 1), a1 + hstep, voffA);
            PG8_WAIT_L(8); PG8_BAR; PG8_WAIT_L(0); PG8_MMA(0, 0, At, B0); PG8_BAR; PG8_SCHED;
            PG8_LDB(B1, 0, 1); PG8_STAGE(PG8_SB(0, 0), b2, voffB);
            PG8_BAR; PG8_WAIT_L(0); PG8_MMA(0, 1, At, B1); PG8_BAR;
            PG8_LDA(At, 0, 1); PG8_STAGE(PG8_SA(0, 0), a2, voffA);
            PG8_BAR; PG8_WAIT_L(0); PG8_MMA(1, 0, At, B0); PG8_BAR; PG8_SCHED;
            PG8_STAGE(PG8_SB(0, 1), b2 + hstep, voffB);
            PG8_WAIT_V(6); PG8_BAR; PG8_MMA(1, 1, At, B1); PG8_BAR;
            PG8_LDB(B0, 1, 0); PG8_SCHED; PG8_LDA(At, 1, 0); PG8_STAGE(PG8_SA(0, 1), a2 + hstep, voffA);
            PG8_WAIT_L(8); PG8_BAR; PG8_WAIT_L(0); PG8_MMA(0, 0, At, B0); PG8_BAR; PG8_SCHED;
            PG8_LDB(B1, 1, 1); PG8_STAGE(PG8_SB(1, 0), b3, voffB);
            PG8_BAR; PG8_WAIT_L(0); PG8_MMA(0, 1, At, B1); PG8_BAR;
            PG8_LDA(At, 1, 1); PG8_STAGE(PG8_SA(1, 0), a3, voffA);
            PG8_BAR; PG8_WAIT_L(0); PG8_MMA(1, 0, At, B0); PG8_BAR; PG8_SCHED;
            PG8_STAGE(PG8_SB(1, 1), b3 + hstep, voffB);
            PG8_WAIT_V(6); PG8_BAR; PG8_MMA(1, 1, At, B1); PG8_BAR;
            }
        }
        if constexpr (ALIGN_EPI) { if (wr == 0) PG8_BAR; }
        if constexpr (!Epi::AFTER_DRAIN) { E(acc, cur, wr, wc, fr, fq); S.done(cur); }
        if (!has_next) break;
#pragma unroll
        for (int a = 0; a < 2; ++a)
#pragma unroll
            for (int b = 0; b < 2; ++b)
#pragma unroll
                for (int m = 0; m < 4; ++m)
#pragma unroll
                    for (int n = 0; n < 2; ++n) acc[a][b][m][n] = (f32x4){0.f, 0.f, 0.f, 0.f};
        cur = nxt; cA = nA; cB = nB; ++ui;
        if constexpr (ALIGN_EPI) { if (wr == 1) PG8_BAR; }
    }
    PG8_WAIT_V(0);
    if constexpr (!ALIGN_EPI) { if (wr == 0) PG8_BAR; }
    PG8_BAR;
    if constexpr (Epi::AFTER_DRAIN) { E.fused(acc, cur, wr, wc, fr, fq, lds, wid, lane); S.done(cur); }
#undef PG8_SA
#undef PG8_SB
#undef PG8_STAGE
#undef PG8_LDA
#undef PG8_LDB
#undef PG8_MMA
#undef PG8_WAIT_V
#undef PG8_WAIT_L
#undef PG8_BAR
#undef PG8_SCHED
}
}

#define LAS __attribute__((address_space(3)))
typedef unsigned short bf16_t;
typedef short bf16x8 __attribute__((ext_vector_type(8)));
typedef float f32x4 __attribute__((ext_vector_type(4)));
typedef unsigned u32x4 __attribute__((ext_vector_type(4)));
typedef unsigned u32x2 __attribute__((ext_vector_type(2)));
constexpr int NWAVES = 8, NTHR = 512;
constexpr int NB = 8, T = 4096, D = 2048, M = NB * T;
constexpr int NC = 7168, INC = 7184;
constexpr int C_RQ = 0, C_RK = 512, C_RV = 1024, C_RG = 2048, C_GQ = 3072, C_GG = 6144;
constexpr size_t MiB = (size_t)1 << 20;
constexpr size_t WS_MOD = 0, WS_G = 1 * MiB, WS_BETA = 2 * MiB, WS_GL = 3 * MiB, WS_WOUT = 4 * MiB, WS_WIN = 12 * MiB, WS_HIN = 40 * MiB, WS_PROJ = 168 * MiB, WS_GPREP = 616 * MiB, WS_END = 904 * MiB;
constexpr int GP_W = 0, GP_QE = 16384, GP_KT = 32768, GP_AT = 49152, GP_UT = 57344, GP_BYTES = 73728;
constexpr int LDS_BYTES = 147456;
constexpr float QK_SCALE = 0.08838834764831845f;

typedef __bf16 bf16v2_t __attribute__((ext_vector_type(2)));
typedef float f32v2_t __attribute__((ext_vector_type(2)));
__device__ __forceinline__ unsigned pk2(float lo, float hi) { return __builtin_bit_cast(unsigned, __builtin_convertvector((f32v2_t){lo, hi}, bf16v2_t)); }
__device__ __forceinline__ unsigned f2bf(float f) { return (unsigned)__builtin_bit_cast(unsigned short, (__bf16)f); }
__device__ __forceinline__ float bf2f(unsigned h) { return __builtin_bit_cast(float, h << 16); }
__device__ __forceinline__ float bflo(unsigned w) { return __builtin_bit_cast(float, w << 16); }
__device__ __forceinline__ float bfhi(unsigned w) { return __builtin_bit_cast(float, w & 0xffff0000u); }
__device__ __forceinline__ float silu_f(float v) { return v * __builtin_amdgcn_rcpf(1.f + __expf(-v)); }
__device__ __forceinline__ void lds_barrier() { asm volatile("s_waitcnt lgkmcnt(0)\n\ts_barrier" ::: "memory"); }
__device__ __forceinline__ float wave_sum(float v) {
#pragma unroll
    for (int o = 1; o < 64; o <<= 1) v += __shfl_xor(v, o);
    return v;
}
__device__ __forceinline__ float sum16(float v) {
#pragma unroll
    for (int o = 1; o < 16; o <<= 1) v += __shfl_xor(v, o);
    return v;
}
template <int KS> __device__ __forceinline__ void mma_nt(f32x4& acc, const LAS bf16_t* A, int lda, const LAS bf16_t* Bt, int ldb, int lane) {
    const int r = lane & 15, g = lane >> 4;
    const LAS bf16_t* ap = A + r * lda + g * 8; const LAS bf16_t* bp = Bt + r * ldb + g * 8;
#pragma unroll
    for (int ks = 0; ks < KS; ++ks) {
        const bf16x8 a = *(const LAS bf16x8*)(ap + ks * 32); const bf16x8 b = *(const LAS bf16x8*)(bp + ks * 32);
        acc = __builtin_amdgcn_mfma_f32_16x16x32_bf16(a, b, acc, 0, 0, 0);
    }
}
__device__ __forceinline__ void unpack8(const u32x4 w, float* o) { o[0] = bflo(w.x); o[1] = bfhi(w.x); o[2] = bflo(w.y); o[3] = bfhi(w.y); o[4] = bflo(w.z); o[5] = bfhi(w.z); o[6] = bflo(w.w); o[7] = bfhi(w.w); }
__device__ __forceinline__ u32x4 pack8(const float* v) { u32x4 w; w.x = pk2(v[0], v[1]); w.y = pk2(v[2], v[3]); w.z = pk2(v[4], v[5]); w.w = pk2(v[6], v[7]); return w; }

__device__ __forceinline__ int kpos(int k) { const int kk = k & 31; return (k & ~31) + ((kk & 12) << 1) + (kk & 3) + ((kk & 16) >> 2); }
__device__ __forceinline__ bf16x8 pack_tiles(const f32x4 lo, const f32x4 hi) { u32x4 w; w.x = pk2(lo[0], lo[1]); w.y = pk2(lo[2], lo[3]); w.z = pk2(hi[0], hi[1]); w.w = pk2(hi[2], hi[3]); return __builtin_bit_cast(bf16x8, w); }

__device__ __forceinline__ void p0_transpose_item(const float* W, int ldw, int K, bf16_t* WT, LAS float* scr, int nblk, int item, int lane) {
    const int kb = item / nblk, nb = item % nblk, k0 = 64 * kb, n0 = 32 * nb;
#pragma unroll 8
    for (int i = 0; i < 32; ++i) { const int kk = 2 * i + (lane >> 5); scr[kk * 33 + (lane & 31)] = W[(size_t)(k0 + kk) * ldw + n0 + (lane & 31)]; }
    asm volatile("s_waitcnt lgkmcnt(0)" ::: "memory");
    const int c = lane & 7;
#pragma unroll
    for (int j = 0; j < 4; ++j) { const int n = (lane >> 3) + 8 * j; const LAS float* s = scr + (8 * c) * 33 + n;
        u32x4 o; o.x = pk2(s[0 * 33], s[1 * 33]); o.y = pk2(s[2 * 33], s[3 * 33]); o.z = pk2(s[4 * 33], s[5 * 33]); o.w = pk2(s[6 * 33], s[7 * 33]);
        *(u32x4*)(WT + (size_t)(n0 + n) * K + k0 + 8 * c) = o; }
    asm volatile("s_waitcnt lgkmcnt(0)" ::: "memory");
}
__device__ __forceinline__ void p0_phase(LAS unsigned char* lds, const float* cvec, const float* w_ada, const float* b_ada, const float* w_in, const float* w_out,
                                         float* mod, bf16_t* WinT, bf16_t* WoutT, int tid, int lane, int wave, int G, int nrep) {
    LAS float* sc = (LAS float*)lds;
    LAS float* part = (LAS float*)(lds + 65536);
    for (int blk_ = blockIdx.x; blk_ < 256 * nrep; blk_ += G) {
        const int blk = blk_ & 255; const int n0 = 24 * blk;
        for (int i = tid; i < 8 * 2048; i += NTHR) sc[i] = silu_f(cvec[i]);
        __syncthreads();
        const int kg = tid / 6, c4 = tid % 6;
        if (tid < 510) {
            float acc[8][4];
#pragma unroll
            for (int b = 0; b < 8; ++b)
#pragma unroll
                for (int j = 0; j < 4; ++j) acc[b][j] = 0.f;
            for (int k = kg; k < 2048; k += 85) {
                const f32x4 w = *(const f32x4*)(w_ada + (size_t)k * 6144 + n0 + 4 * c4);
#pragma unroll
                for (int b = 0; b < 8; ++b) { const float s = sc[b * 2048 + k]; acc[b][0] += s * w[0]; acc[b][1] += s * w[1]; acc[b][2] += s * w[2]; acc[b][3] += s * w[3]; }
            }
#pragma unroll
            for (int b = 0; b < 8; ++b)
#pragma unroll
                for (int j = 0; j < 4; ++j) part[kg * 192 + b * 24 + 4 * c4 + j] = acc[b][j];
        }
        __syncthreads();
        if (tid < 192) { float s = 0.f; for (int q = 0; q < 85; ++q) s += part[q * 192 + tid]; const int b = tid / 24, j = tid % 24; mod[b * 6144 + n0 + j] = s + b_ada[n0 + j]; }
        __syncthreads();
    }
    LAS float* scr = (LAS float*)(lds + wave * 16384);
    const int gw = blockIdx.x * NWAVES + wave, NGW = G * NWAVES;
    constexpr int I_IN = (D / 64) * (NC / 32), I_OUT = (D / 64) * (D / 32);
    for (int it_ = gw; it_ < (I_IN + I_OUT) * nrep; it_ += NGW) {
        const int it = it_ % (I_IN + I_OUT);
        if (it < I_IN) p0_transpose_item(w_in, INC, D, WinT, scr, NC / 32, it, lane);
        else p0_transpose_item(w_out, D, D, WoutT, scr, D / 32, it - I_IN, lane);
    }
}

__device__ __forceinline__ void p1_phase(LAS unsigned char* lds, const float* x, const float* w_in, const float* mod, const float* a_log, const float* dt_bias,
                                         bf16_t* hin, float* gdec, float* beta, int tid, int lane, int wave, int G, int nrep) {
    LAS float* wx = (LAS float*)lds;
    for (int k = tid; k < 2048; k += NTHR) {
        const f32x4* src = (const f32x4*)(w_in + (size_t)k * INC + NC);
#pragma unroll
        for (int q = 0; q < 4; ++q) { const f32x4 v = src[q]; wx[(4 * q + 0) * 2048 + k] = v[0]; wx[(4 * q + 1) * 2048 + k] = v[1]; wx[(4 * q + 2) * 2048 + k] = v[2]; wx[(4 * q + 3) * 2048 + k] = v[3]; }
    }
    __syncthreads();
    typedef float f32x2 __attribute__((ext_vector_type(2)));
    const int gw = blockIdx.x * NWAVES + wave, NGW = G * NWAVES;
    for (int pair_ = gw; pair_ < (M / 2) * nrep; pair_ += NGW) {
        const int pair = pair_ & (M / 2 - 1);
        const size_t m0 = (size_t)2 * pair; const int b = (int)(m0 >> 12);
        const float* modb = mod + b * 6144;
        float acc0[16], acc1[16];
#pragma unroll
        for (int o = 0; o < 16; ++o) { acc0[o] = 0.f; acc1[o] = 0.f; }
#pragma unroll 8
        for (int i = 0; i < 16; ++i) {
            const int k = 2 * lane + 128 * i;
            const f32x2 sh = *(const f32x2*)(modb + k), scl = *(const f32x2*)(modb + 2048 + k);
            const f32x2 x0 = __builtin_nontemporal_load((const f32x2*)(x + m0 * D + k)), x1 = __builtin_nontemporal_load((const f32x2*)(x + (m0 + 1) * D + k));
            const float h00 = x0[0] * (1.f + scl[0]) + sh[0], h01 = x0[1] * (1.f + scl[1]) + sh[1];
            const float h10 = x1[0] * (1.f + scl[0]) + sh[0], h11 = x1[1] * (1.f + scl[1]) + sh[1];
            *(unsigned*)(hin + m0 * D + k) = pk2(h00, h01);
            *(unsigned*)(hin + (m0 + 1) * D + k) = pk2(h10, h11);
#pragma unroll
            for (int o = 0; o < 16; ++o) { const f32x2 w = *(const LAS f32x2*)(wx + o * 2048 + k); acc0[o] += h00 * w[0] + h01 * w[1]; acc1[o] += h10 * w[0] + h11 * w[1]; }
        }
#pragma unroll
        for (int sft = 0; sft < 4; ++sft) {
            const bool hiLane = (lane >> sft) & 1;
#pragma unroll
            for (int t = 0; t < (8 >> sft); ++t) {
                const float k0 = hiLane ? acc0[2 * t + 1] : acc0[2 * t], s0 = hiLane ? acc0[2 * t] : acc0[2 * t + 1];
                const float k1 = hiLane ? acc1[2 * t + 1] : acc1[2 * t], s1 = hiLane ? acc1[2 * t] : acc1[2 * t + 1];
                acc0[t] = k0 + __shfl_xor(s0, 1 << sft); acc1[t] = k1 + __shfl_xor(s1, 1 << sft);
            }
        }
        float v0 = acc0[0], v1 = acc1[0];
        v0 += __shfl_xor(v0, 16); v0 += __shfl_xor(v0, 32); v1 += __shfl_xor(v1, 16); v1 += __shfl_xor(v1, 32);
        if (lane < 8) {
            const float al = -__expf(a_log[lane]), db = dt_bias[lane];
            const float y0 = v0 + db, y1 = v1 + db;
            const float sp0 = y0 > 20.f ? y0 : log1pf(__expf(y0)), sp1 = y1 > 20.f ? y1 : log1pf(__expf(y1));
            gdec[m0 * 8 + lane] = al * sp0; gdec[(m0 + 1) * 8 + lane] = al * sp1;
        } else if (lane < 16) {
            beta[m0 * 8 + lane - 8] = 1.f / (1.f + __expf(-v0)); beta[(m0 + 1) * 8 + lane - 8] = 1.f / (1.f + __expf(-v1));
        }
    }
}

__device__ __forceinline__ void rot16(float* lo, float* hi, int pos, int d0) {
#pragma unroll
    for (int e = 0; e < 16; ++e) {
        const float fturn = exp2f(-(float)(d0 + e) * (13.287712379549449f / 64.f)) * 0.15915494309189535f;
        const double r = (double)pos * (double)fturn; const float fr = (float)(r - floor(r));
        const float sn = __builtin_amdgcn_sinf(fr), cs = __builtin_amdgcn_cosf(fr);
        const float a = lo[e], b = hi[e];
        lo[e] = a * cs - b * sn; hi[e] = a * sn + b * cs;
    }
}

__device__ __forceinline__ void gdn_prep_block(LAS unsigned char* lds, int vb, const bf16_t* proj, const float* conv_w, const float* gdec, const float* beta,
                                               unsigned char* gprep, float* glv, int tid, int lane, int wave) {
    const int h = vb & 7, pq = vb >> 3;
    LAS float* GCB = (LAS float*)(lds + 116736);
    LAS float* CW = (LAS float*)(lds + 122880);
    for (int idx = tid; idx < 1536; idx += NTHR) { const int X = idx >> 9, r = idx & 511; CW[idx] = conv_w[(r >> 7) * 3072 + X * 1024 + h * 128 + (r & 127)]; }
    const int ti_ = tid >> 3, td0_ = (tid & 7) * 16;
    u32x4 pre[3][4][2];
#define GP_ITEM(k) (((((pq + 32 * (k)) >> 6) * 8 + h) << 6) + ((pq + 32 * (k)) & 63))
#define GP_STEP0(itm, GCp) do { const int n_ = (itm) & 63, b_ = (itm) >> 9; const long mm = (long)b_ * T + n_ * 64; \
        const float g_ = gdec[(mm + lane) * 8 + h], bt_ = beta[(mm + lane) * 8 + h]; float gc = g_; \
        _Pragma("unroll") for (int off = 1; off < 64; off <<= 1) { const float t_ = __shfl_up(gc, off); if (lane >= off) gc += t_; } \
        const float glast = __shfl(gc, 63); (GCp)[lane] = gc; (GCp)[64 + lane] = bt_; (GCp)[128 + lane] = __expf(gc); (GCp)[192 + lane] = __expf(glast - gc); \
        if (lane == 0) glv[itm] = __expf(glast); } while (0)
#define GP_LOADPRE(itm) do { const int n_ = (itm) & 63, b_ = (itm) >> 9; const long mm = (long)b_ * T + n_ * 64; \
        _Pragma("unroll") for (int X = 0; X < 3; ++X) _Pragma("unroll") for (int j = 0; j < 4; ++j) { \
            if (n_ * 64 + ti_ - 3 + j >= 0) { const u32x4* p_ = (const u32x4*)(proj + (size_t)(mm + ti_ - 3 + j) * NC + C_GQ + X * 1024 + h * 128 + td0_); pre[X][j][0] = p_[0]; pre[X][j][1] = p_[1]; } \
            else { pre[X][j][0] = (u32x4){0u, 0u, 0u, 0u}; pre[X][j][1] = (u32x4){0u, 0u, 0u, 0u}; } } } while (0)
    if (wave == 0) GP_STEP0(GP_ITEM(0), GCB);
    GP_LOADPRE(GP_ITEM(0));
    lds_barrier();
    for (int k = 0; k < 16; ++k) {
    const int item = GP_ITEM(k);
    { unsigned zoff = 0; asm volatile("" : "+s"(zoff)); lds += zoff; tid += zoff; lane += zoff; }
    const int n = item & 63, b = item >> 9; const int t0 = n * 64; const long m0 = (long)b * T + t0;
    LAS bf16_t* KN = (LAS bf16_t*)lds;
    LAS bf16_t* QN = (LAS bf16_t*)(lds + 17408);
    LAS bf16_t* KBGT = (LAS bf16_t*)(lds + 34816);
    LAS bf16_t* VBT = (LAS bf16_t*)(lds + 53248);
    LAS bf16_t* KTT = (LAS bf16_t*)(lds + 71680);
    LAS bf16_t* TM = (LAS bf16_t*)(lds + 90112);
    LAS float* AM = (LAS float*)(lds + 99328);
    LAS bf16_t* AB = (LAS bf16_t*)(lds + 117760);
    LAS bf16_t* T11T = (LAS bf16_t*)(lds + 120320);
    LAS float* GC = (LAS float*)(lds + ((k & 1) ? 129024 : 116736));
    LAS float* BT = GC + 64; LAS float* EG = GC + 128; LAS float* EK = GC + 192;
    unsigned char* gp = gprep + (size_t)item * GP_BYTES;
    {
        const int i = tid >> 3, d0 = (tid & 7) * 16;
        const float bti = BT[i], egi = EG[i], eki = EK[i];
#pragma unroll
        for (int X = 0; X < 3; ++X) {
            float val[16];
#pragma unroll
            for (int e = 0; e < 16; ++e) val[e] = 0.f;
#pragma unroll
            for (int j = 0; j < 4; ++j) {
                float in[16]; unpack8(pre[X][j][0], in); unpack8(pre[X][j][1], in + 8);
                const LAS f32x4* wp = (const LAS f32x4*)(CW + (X * 4 + j) * 128 + d0);
#pragma unroll
                for (int q = 0; q < 4; ++q) { const f32x4 w = wp[q]; val[4 * q + 0] += in[4 * q + 0] * w[0]; val[4 * q + 1] += in[4 * q + 1] * w[1]; val[4 * q + 2] += in[4 * q + 2] * w[2]; val[4 * q + 3] += in[4 * q + 3] * w[3]; }
            }
            float ss = 0.f;
#pragma unroll
            for (int e = 0; e < 16; ++e) { val[e] = silu_f(val[e]); ss += val[e] * val[e]; }
            if (X < 2) {
                ss += __shfl_xor(ss, 1); ss += __shfl_xor(ss, 2); ss += __shfl_xor(ss, 4);
                const float rn = rsqrtf(ss + 1e-6f) * (X == 0 ? QK_SCALE : 1.f);
#pragma unroll
                for (int e = 0; e < 16; ++e) val[e] *= rn;
            }
            if (X == 0) {
                *(LAS u32x4*)(QN + i * 136 + d0) = pack8(val); *(LAS u32x4*)(QN + i * 136 + d0 + 8) = pack8(val + 8);
                float qe[16];
#pragma unroll
                for (int e = 0; e < 16; ++e) qe[e] = val[e] * egi;
                bf16_t* qg = (bf16_t*)(gp + GP_QE) + i * 128 + (d0 & ~31) + ((d0 & 16) >> 2);
#pragma unroll
                for (int gq = 0; gq < 4; ++gq) { u32x2 w; w.x = pk2(qe[4 * gq], qe[4 * gq + 1]); w.y = pk2(qe[4 * gq + 2], qe[4 * gq + 3]); *(u32x2*)(qg + 8 * gq) = w; }
            } else if (X == 1) {
                *(LAS u32x4*)(KN + i * 136 + d0) = pack8(val); *(LAS u32x4*)(KN + i * 136 + d0 + 8) = pack8(val + 8);
#pragma unroll
                for (int e = 0; e < 16; ++e) { KBGT[(d0 + e) * 72 + i] = (bf16_t)f2bf(val[e] * bti * egi); KTT[(d0 + e) * 72 + kpos(i)] = (bf16_t)f2bf(val[e] * eki); }
            } else {
#pragma unroll
                for (int e = 0; e < 16; ++e) VBT[(d0 + e) * 72 + i] = (bf16_t)f2bf(val[e] * bti);
            }
        }
    }
    lds_barrier();
    {
        const int c = lane & 15, g = lane >> 4;
        bf16_t* at = (bf16_t*)(gp + GP_AT);
#pragma unroll
        for (int rep = 0; rep < 2; ++rep) {
            const int tt = wave + 8 * rep, ti = tt >> 2, tj = tt & 3;
            f32x4 a1 = {0.f, 0.f, 0.f, 0.f}, a2 = {0.f, 0.f, 0.f, 0.f};
            if (tj <= ti) { mma_nt<4>(a1, KN + 16 * ti * 136, 136, KN + 16 * tj * 136, 136, lane); mma_nt<4>(a2, QN + 16 * ti * 136, 136, KN + 16 * tj * 136, 136, lane); }
            const int j = 16 * tj + c; const float gcj = GC[j];
            const f32x4 gci = *(const LAS f32x4*)(GC + 16 * ti + 4 * g), bti4 = *(const LAS f32x4*)(BT + 16 * ti + 4 * g);
            f32x4 av;
#pragma unroll
            for (int rr = 0; rr < 4; ++rr) {
                const int i = 16 * ti + 4 * g + rr;
                const float dec = (i >= j) ? __expf(gci[rr] - gcj) : 0.f;
                const float aij = (i > j) ? a1[rr] * bti4[rr] * dec : 0.f;
                av[rr] = aij;
                if (ti >= 2 && tj < 2) AB[(i - 32) * 40 + j] = (bf16_t)f2bf(aij);
                at[i * 64 + kpos(j)] = (bf16_t)f2bf((i >= j) ? a2[rr] * dec : 0.f);
            }
            *(LAS f32x4*)(AM + j * 68 + 16 * ti + 4 * g) = av;
        }
    }
    lds_barrier();
    if (k + 1 < 16) {
        GP_LOADPRE(GP_ITEM(k + 1));
        if (wave == 1) { LAS float* GCn = (k & 1) ? GCB : (LAS float*)(lds + 129024); GP_STEP0(GP_ITEM(k + 1), GCn); }
    }
    if (wave == 0) {
        const int half = lane >> 5, cl = lane & 31, c = lane & 15, g = lane >> 4;
        const LAS float* Ab = AM + (32 * half) * 68 + 32 * half;
        float sv[32];
#pragma unroll
        for (int i = 0; i < 32; ++i) sv[i] = (cl == i) ? 1.f : 0.f;
        f32x4 ca[8], cb[8];
#define SV_LD(dst, j) do { _Pragma("unroll") for (int q = ((j) + 1) / 4; q < 8; ++q) dst[q] = *(const LAS f32x4*)(Ab + (j) * 68 + 4 * q); asm volatile("" ::: "memory"); } while (0)
#define SV_FM(src, j) do { const float tj = sv[j]; _Pragma("unroll") for (int q = ((j) + 1) / 4; q < 8; ++q) _Pragma("unroll") for (int e = 0; e < 4; ++e) if (4 * q + e > (j)) sv[4 * q + e] -= src[q][e] * tj; \
        asm volatile("" : "+v"(sv[0]), "+v"(sv[1]), "+v"(sv[2]), "+v"(sv[3]), "+v"(sv[4]), "+v"(sv[5]), "+v"(sv[6]), "+v"(sv[7]), "+v"(sv[8]), "+v"(sv[9]), "+v"(sv[10]), "+v"(sv[11]), "+v"(sv[12]), "+v"(sv[13]), "+v"(sv[14]), "+v"(sv[15]) :: "memory"); \
        asm volatile("" : "+v"(sv[16]), "+v"(sv[17]), "+v"(sv[18]), "+v"(sv[19]), "+v"(sv[20]), "+v"(sv[21]), "+v"(sv[22]), "+v"(sv[23]), "+v"(sv[24]), "+v"(sv[25]), "+v"(sv[26]), "+v"(sv[27]), "+v"(sv[28]), "+v"(sv[29]), "+v"(sv[30]), "+v"(sv[31]) :: "memory"); } while (0)
        SV_LD(ca, 0);
#pragma unroll
        for (int j = 0; j < 30; j += 2) {
            SV_LD(cb, j + 1); SV_FM(ca, j);
            SV_LD(ca, j + 2); SV_FM(cb, j + 1);
        }
        SV_FM(ca, 30);
#undef SV_LD
#undef SV_FM
#pragma unroll
        for (int i = 0; i < 32; ++i) TM[(32 * half + i) * 72 + 32 * half + cl] = (bf16_t)f2bf(sv[i]);
        if (half == 0) {
#pragma unroll
            for (int i = 0; i < 32; ++i) TM[i * 72 + 32 + cl] = (bf16_t)0;
#pragma unroll
            for (int q = 0; q < 4; ++q) { u32x4 w; w.x = pk2(sv[8 * q], sv[8 * q + 1]); w.y = pk2(sv[8 * q + 2], sv[8 * q + 3]); w.z = pk2(sv[8 * q + 4], sv[8 * q + 5]); w.w = pk2(sv[8 * q + 6], sv[8 * q + 7]); *(LAS u32x4*)(T11T + cl * 40 + 8 * q) = w; }
        }
        asm volatile("s_waitcnt lgkmcnt(0)" ::: "memory");
        f32x4 X[2][2];
#pragma unroll
        for (int t2 = 0; t2 < 2; ++t2)
#pragma unroll
            for (int tc = 0; tc < 2; ++tc) { X[t2][tc] = (f32x4){0.f, 0.f, 0.f, 0.f}; mma_nt<1>(X[t2][tc], AB + 16 * t2 * 40, 40, T11T + 16 * tc * 40, 40, lane); }
#pragma unroll
        for (int t2 = 0; t2 < 2; ++t2) {
            const LAS bf16_t* trow = TM + (32 + 16 * t2 + c) * 72 + 32 + 4 * g;
            const u32x2 lo = *(const LAS u32x2*)trow, hi = *(const LAS u32x2*)(trow + 16);
            const bf16x8 af = __builtin_bit_cast(bf16x8, (u32x4){lo.x, lo.y, hi.x, hi.y});
#pragma unroll
            for (int tc = 0; tc < 2; ++tc) {
                f32x4 acc = {0.f, 0.f, 0.f, 0.f};
                acc = __builtin_amdgcn_mfma_f32_16x16x32_bf16(af, pack_tiles(X[0][tc], X[1][tc]), acc, 0, 0, 0);
#pragma unroll
                for (int rr = 0; rr < 4; ++rr) TM[(32 + 16 * t2 + 4 * g + rr) * 72 + 16 * tc + c] = (bf16_t)f2bf(-acc[rr]);
            }
        }
    }
    lds_barrier();
    {
        const int c = lane & 15, g = lane >> 4;
#pragma unroll
        for (int rep = 0; rep < 8; ++rep) {
            const int tt = wave * 8 + rep;
            f32x4 acc = {0.f, 0.f, 0.f, 0.f};
            if (tt < 32) {
                const int ti = tt >> 3, te = tt & 7;
                mma_nt<2>(acc, TM + 16 * ti * 72, 72, VBT + 16 * te * 72, 72, lane);
                u32x2 w; w.x = pk2(acc[0], acc[1]); w.y = pk2(acc[2], acc[3]);
                *(u32x2*)((bf16_t*)(gp + GP_UT) + (16 * te + c) * 64 + 16 * ti + 4 * g) = w;
            } else {
                const int t2 = tt - 32, ti = t2 >> 3, td = t2 & 7;
                mma_nt<2>(acc, KBGT + 16 * td * 72, 72, TM + 16 * ti * 72, 72, lane);
                u32x2 w; w.x = pk2(acc[0], acc[1]); w.y = pk2(acc[2], acc[3]);
                *(u32x2*)((bf16_t*)(gp + GP_W) + (16 * ti + c) * 128 + kpos(16 * td + 4 * g)) = w;
            }
        }
#pragma unroll
        for (int u = 0; u < 2; ++u) { const int q = tid + NTHR * u, d = q >> 3, part = q & 7; *(u32x4*)(gp + GP_KT + (size_t)q * 16) = *(const LAS u32x4*)(KTT + d * 72 + part * 8); }
    }
    lds_barrier();
    }
#undef GP_ITEM
#undef GP_STEP0
#undef GP_LOADPRE
}

__device__ __forceinline__ void ret_kv_item(LAS unsigned char* lds, int item, const bf16_t* proj, float* KV, int tid, int lane, int wave) {
    const int n = item & 31, bh = item >> 5, h = bh & 3, b = bh >> 2;
    const int t0 = n * 128; const size_t m0 = (size_t)b * T + t0;
    LAS bf16_t* VT = (LAS bf16_t*)lds;
    LAS bf16_t* KDT = (LAS bf16_t*)(lds + 69632);
    const float lg = __logf(1.f - exp2f(-5.f - (float)h));
    {
        const int j = tid >> 2, part = tid & 3, d0 = 16 * part;
        const bf16_t* kp = proj + (m0 + j) * NC + C_RK + h * 128 + d0;
        float lo[16], hi[16];
        unpack8(((const u32x4*)kp)[0], lo); unpack8(((const u32x4*)kp)[1], lo + 8); unpack8(((const u32x4*)(kp + 64))[0], hi); unpack8(((const u32x4*)(kp + 64))[1], hi + 8);
        rot16(lo, hi, t0 + j, d0);
        const float kdec = __expf(lg * (float)(127 - j)) * QK_SCALE;
#pragma unroll
        for (int e = 0; e < 16; ++e) { KDT[(d0 + e) * 136 + j] = (bf16_t)f2bf(lo[e] * kdec); KDT[(64 + d0 + e) * 136 + j] = (bf16_t)f2bf(hi[e] * kdec); }
        const int e0 = 64 * part;
        const u32x4* vp = (const u32x4*)(proj + (m0 + j) * NC + C_RV + h * 256 + e0);
#pragma unroll
        for (int q = 0; q < 8; ++q) { const u32x4 w = vp[q]; const unsigned ww[4] = {w.x, w.y, w.z, w.w};
#pragma unroll
            for (int p = 0; p < 4; ++p) { VT[(e0 + 8 * q + 2 * p) * 136 + j] = (bf16_t)(ww[p] & 0xffffu); VT[(e0 + 8 * q + 2 * p + 1) * 136 + j] = (bf16_t)(ww[p] >> 16); } }
    }
    lds_barrier();
    {
        const int c = lane & 15, g = lane >> 4;
        bf16_t* kv = (bf16_t*)KV + (size_t)item * 32768;
#pragma unroll
        for (int r2 = 0; r2 < 2; ++r2) {
            const int te = 2 * wave + r2;
#pragma unroll
            for (int td = 0; td < 8; ++td) {
                f32x4 acc = {0.f, 0.f, 0.f, 0.f};
                mma_nt<4>(acc, KDT + 16 * td * 136, 136, VT + 16 * te * 136, 136, lane);
                u32x2 w; w.x = pk2(acc[0], acc[1]); w.y = pk2(acc[2], acc[3]);
                *(u32x2*)(kv + (16 * te + c) * 128 + 16 * td + 4 * g) = w;
            }
        }
    }
    lds_barrier();
}

constexpr int SC_UT = 62464, SC_GL = 67072, SC_BUF = 67088;
__device__ __forceinline__ void gdn_scan_task(LAS unsigned char* lds, int s, int slice, const unsigned char* gprep, const float* glv, bf16_t* mixed, float* KV, int rs_blk, int tid, int lane, int wave) {
    const int b = s >> 3, h = s & 7;
    const int c = lane & 15, g = lane >> 4, e0 = 32 * slice + 16 * (wave & 1);
    u32x4 SU[8]; bf16x8 Sb[4];
#pragma unroll
    for (int td = 0; td < 8; ++td) SU[td] = (u32x4){0u, 0u, 0u, 0u};
#pragma unroll
    for (int q = 0; q < 4; ++q) Sb[q] = (bf16x8){0, 0, 0, 0, 0, 0, 0, 0};
    u32x4 pf[8];
    const unsigned char* gp0 = gprep + (size_t)(s * 64) * GP_BYTES;
#define SC_LOAD(gq) do { _Pragma("unroll") for (int u = 0; u < 2; ++u) { pf[u] = *(const u32x4*)((gq) + GP_W + (size_t)(tid + NTHR * u) * 16); pf[2 + u] = *(const u32x4*)((gq) + GP_QE + (size_t)(tid + NTHR * u) * 16); \
        pf[5 + u] = *(const u32x4*)((gq) + GP_KT + (size_t)(tid + NTHR * u) * 16); } pf[4] = *(const u32x4*)((gq) + GP_AT + (size_t)tid * 16); \
        if (tid >= 256) pf[7] = *(const u32x4*)((gq) + GP_UT + (size_t)(32 * slice + ((tid - 256) >> 3)) * 128 + ((tid - 256) & 7) * 16); } while (0)
#define SC_STORE(bufp, itm) do { if (tid >= 256) *(LAS u32x4*)((bufp) + SC_UT + ((tid - 256) >> 3) * 144 + ((tid - 256) & 7) * 16) = pf[7]; if (tid == 255) *(LAS float*)((bufp) + SC_GL) = glv[itm]; \
        _Pragma("unroll") for (int u = 0; u < 2; ++u) { const int q = tid + NTHR * u; \
        *(LAS u32x4*)((LAS bf16_t*)(bufp) + (q >> 4) * 136 + (q & 15) * 8) = pf[u]; *(LAS u32x4*)((LAS bf16_t*)((bufp) + 17408) + (q >> 4) * 136 + (q & 15) * 8) = pf[2 + u]; \
        *(LAS u32x4*)((LAS bf16_t*)((bufp) + 44032) + (q >> 3) * 72 + (q & 7) * 8) = pf[5 + u]; } \
        *(LAS u32x4*)((LAS bf16_t*)((bufp) + 34816) + (tid >> 3) * 72 + (tid & 7) * 8) = pf[4]; } while (0)
    SC_LOAD(gp0); SC_STORE(lds, s * 64); SC_LOAD(gp0 + GP_BYTES);
    lds_barrier();
    for (int n = 0; n < 64; ++n) {
        LAS unsigned char* cur = lds + (n & 1) * SC_BUF; LAS unsigned char* nxt = lds + ((n + 1) & 1) * SC_BUF;
        const unsigned char* gp = gp0 + (size_t)n * GP_BYTES;
        if (n >= 1 && tid >= 128 && tid < 384) {
            const int u = tid - 128;
            const LAS bf16_t* OLp = (const LAS bf16_t*)(lds + 2 * SC_BUF + ((n - 1) & 1) * 5120);
            *(u32x4*)(mixed + ((size_t)b * T + (n - 1) * 64 + (u >> 2)) * D + 1024 + h * 128 + 32 * slice + (u & 3) * 8) = *(const LAS u32x4*)(OLp + (u >> 2) * 40 + (u & 3) * 8);
        }
        if (n + 1 < 64) SC_STORE(nxt, s * 64 + n + 1);
        if (n + 2 < 64) SC_LOAD(gp + 2 * GP_BYTES);
        if (wave >= 2 && rs_blk >= 0 && n < 7) {
            const int u = tid - 128;
            if (n >= 1 && (n - 1) * 384 + u < 2048) {
                const int cp = rs_blk * 2048 + (n - 1) * 384 + u, stream = cp >> 14;
                const float dec = __expf(128.f * __logf(1.f - exp2f(-5.f - (float)(stream & 3))));
                unsigned* p = (unsigned*)((bf16_t*)KV + (size_t)stream * 32 * 32768) + (cp & 16383);
                float st0 = 0.f, st1 = 0.f;
#pragma unroll
                for (int i = 0; i < 32; ++i) { const unsigned w = SU[i >> 2][i & 3]; p[(size_t)i * 16384] = pk2(st0, st1); st0 = st0 * dec + bflo(w); st1 = st1 * dec + bfhi(w); }
            }
            if (n < 6 && n * 384 + u < 2048) {
                const int cp = rs_blk * 2048 + n * 384 + u, stream = cp >> 14;
                const unsigned* p = (const unsigned*)((const bf16_t*)KV + (size_t)stream * 32 * 32768) + (cp & 16383);
#pragma unroll
                for (int i = 0; i < 32; ++i) SU[i >> 2][i & 3] = p[(size_t)i * 16384];
            }
        }
        if (wave < 2) {
            const LAS bf16_t* WL = (const LAS bf16_t*)cur; const LAS bf16_t* QE = (const LAS bf16_t*)(cur + 17408); const LAS bf16_t* AT = (const LAS bf16_t*)(cur + 34816); const LAS bf16_t* KT = (const LAS bf16_t*)(cur + 44032);
            const size_t m0 = (size_t)b * T + n * 64;
            const float gl = *(const LAS float*)(cur + SC_GL);
#define SC_SB __builtin_amdgcn_sched_barrier(0)
#define SC_LDP(dst, ti) do { _Pragma("unroll") for (int q = 0; q < 4; ++q) { dst[q] = *(const LAS bf16x8*)(WL + (16 * (ti) + c) * 136 + 32 * q + 8 * g); dst[4 + q] = *(const LAS bf16x8*)(QE + (16 * (ti) + c) * 136 + 32 * q + 8 * g); } } while (0)
#define SC_MMP(src, ti) do { _Pragma("unroll") for (int q = 0; q < 4; ++q) { P[ti] = __builtin_amdgcn_mfma_f32_16x16x32_bf16(src[q], Sb[q], P[ti], 0, 0, 0); O[ti] = __builtin_amdgcn_mfma_f32_16x16x32_bf16(src[4 + q], Sb[q], O[ti], 0, 0, 0); } } while (0)
#define SC_LDK(dst, t0) do { _Pragma("unroll") for (int t = 0; t < 4; ++t) _Pragma("unroll") for (int q = 0; q < 2; ++q) dst[2 * t + q] = *(const LAS bf16x8*)(KT + (16 * ((t0) + t) + c) * 72 + 32 * q + 8 * g); } while (0)
#define SC_MMK(src, t0) do { _Pragma("unroll") for (int t = 0; t < 4; ++t) { f32x4 a = __builtin_bit_cast(f32x4, SU[(t0) + t]) * gl; _Pragma("unroll") for (int q = 0; q < 2; ++q) a = __builtin_amdgcn_mfma_f32_16x16x32_bf16(src[2 * t + q], Vb[q], a, 0, 0, 0); SU[(t0) + t] = __builtin_bit_cast(u32x4, a); } } while (0)
            f32x4 P[4], O[4];
#pragma unroll
            for (int ti = 0; ti < 4; ++ti) { P[ti] = (f32x4){0.f, 0.f, 0.f, 0.f}; O[ti] = (f32x4){0.f, 0.f, 0.f, 0.f}; }
            bf16x8 fa[8], fb[8];
            SC_LDP(fa, 0);
            SC_LDP(fb, 1); SC_SB; SC_MMP(fa, 0); SC_SB;
            SC_LDP(fa, 2); SC_SB; SC_MMP(fb, 1); SC_SB;
            SC_LDP(fb, 3); SC_SB; SC_MMP(fa, 2); SC_SB;
#pragma unroll
            for (int ti = 0; ti < 4; ++ti)
#pragma unroll
                for (int q = 0; q < 2; ++q) fa[2 * ti + q] = *(const LAS bf16x8*)(AT + (16 * ti + c) * 72 + 32 * q + 8 * g);
            SC_SB; SC_MMP(fb, 3); SC_SB;
            u32x2 ut[4];
#pragma unroll
            for (int ti = 0; ti < 4; ++ti) ut[ti] = *(const LAS u32x2*)((const LAS bf16_t*)(cur + SC_UT) + (16 * (wave & 1) + c) * 72 + 16 * ti + 4 * g);
            f32x4 vn[4];
#pragma unroll
            for (int ti = 0; ti < 4; ++ti) vn[ti] = (f32x4){bflo(ut[ti].x) - P[ti][0], bfhi(ut[ti].x) - P[ti][1], bflo(ut[ti].y) - P[ti][2], bfhi(ut[ti].y) - P[ti][3]};
            bf16x8 Vb[2];
            Vb[0] = pack_tiles(vn[0], vn[1]); Vb[1] = pack_tiles(vn[2], vn[3]);
            SC_LDK(fb, 0); SC_SB;
#pragma unroll
            for (int ti = 0; ti < 4; ++ti)
#pragma unroll
                for (int q = 0; q < 2; ++q) O[ti] = __builtin_amdgcn_mfma_f32_16x16x32_bf16(fa[2 * ti + q], Vb[q], O[ti], 0, 0, 0);
            SC_SB;
            SC_LDK(fa, 4); SC_SB; SC_MMK(fb, 0); SC_SB;
            SC_MMK(fa, 4);
#undef SC_SB
#undef SC_LDP
#undef SC_MMP
#undef SC_LDK
#undef SC_MMK
#pragma unroll
            for (int q = 0; q < 4; ++q) Sb[q] = pack_tiles(__builtin_bit_cast(f32x4, SU[2 * q]), __builtin_bit_cast(f32x4, SU[2 * q + 1]));
            LAS bf16_t* OL = (LAS bf16_t*)(lds + 2 * SC_BUF + (n & 1) * 5120) + (4 * g) * 40 + 16 * (wave & 1) + c;
#pragma unroll
            for (int ti = 0; ti < 4; ++ti)
#pragma unroll
                for (int rr = 0; rr < 4; ++rr) OL[(16 * ti + rr) * 40] = (bf16_t)f2bf(O[ti][rr]);
        }
        lds_barrier();
    }
    if (tid >= 128 && tid < 384) {
        const int u = tid - 128;
        const LAS bf16_t* OLp = (const LAS bf16_t*)(lds + 2 * SC_BUF + 5120);
        *(u32x4*)(mixed + ((size_t)b * T + 63 * 64 + (u >> 2)) * D + 1024 + h * 128 + 32 * slice + (u & 3) * 8) = *(const LAS u32x4*)(OLp + (u >> 2) * 40 + (u & 3) * 8);
    }
    lds_barrier();
#undef SC_LOAD
#undef SC_STORE
}
__device__ __forceinline__ void gdn_norm_rows(const bf16_t* proj, const float* norm_w, bf16_t* mixed, int lane, int wave, int G) {
    const int gw = blockIdx.x * NWAVES + wave, NGW = G * NWAVES;
    float nw[16];
#pragma unroll
    for (int q = 0; q < 4; ++q) { const f32x4 w = *(const f32x4*)(norm_w + (lane & 7) * 16 + 4 * q); nw[4 * q] = w[0]; nw[4 * q + 1] = w[1]; nw[4 * q + 2] = w[2]; nw[4 * q + 3] = w[3]; }
    for (int m = gw; m < M; m += NGW) {
        bf16_t* op = mixed + (size_t)m * D + 1024 + lane * 16;
        const bf16_t* gq = proj + (size_t)m * NC + C_GG + lane * 16;
        float o[16], gg[16];
        unpack8(((const u32x4*)op)[0], o); unpack8(((const u32x4*)op)[1], o + 8); unpack8(__builtin_nontemporal_load((const u32x4*)gq), gg); unpack8(__builtin_nontemporal_load((const u32x4*)gq + 1), gg + 8);
        float ss = 0.f;
#pragma unroll
        for (int e = 0; e < 16; ++e) ss += o[e] * o[e];
        ss += __shfl_xor(ss, 1); ss += __shfl_xor(ss, 2); ss += __shfl_xor(ss, 4);
        const float rstd = rsqrtf(ss * (1.f / 128.f) + 1e-6f);
#pragma unroll
        for (int e = 0; e < 16; ++e) o[e] = o[e] * rstd * nw[e] * silu_f(gg[e]);
        ((u32x4*)op)[0] = pack8(o); ((u32x4*)op)[1] = pack8(o + 8);
    }
}

__device__ __forceinline__ void ret_scan(float* KV, float* KVdst, int tid, int first_blk, int G) {
    const long nthreads = (long)(G - first_blk) * NTHR, gid = (long)(blockIdx.x - first_blk) * NTHR + tid;
    for (long cp = gid; cp < 32L * 16384; cp += nthreads) {
        const int stream = (int)(cp >> 14), h = stream & 3;
        const float dec = __expf(128.f * __logf(1.f - exp2f(-5.f - (float)h)));
        const unsigned* p = (const unsigned*)((const bf16_t*)KV + (size_t)stream * 32 * 32768) + (cp & 16383);
        unsigned* pd = (unsigned*)((bf16_t*)KVdst + (size_t)stream * 32 * 32768) + (cp & 16383);
        unsigned kv[32];
#pragma unroll
        for (int n = 0; n < 32; ++n) kv[n] = p[(size_t)n * 16384];
        float st0 = 0.f, st1 = 0.f;
#pragma unroll
        for (int n = 0; n < 32; ++n) { pd[(size_t)n * 16384] = pk2(st0, st1); st0 = st0 * dec + bflo(kv[n]); st1 = st1 * dec + bfhi(kv[n]); }
    }
}

__device__ __forceinline__ void ret_out_item(LAS unsigned char* lds, int item, const bf16_t* proj, const float* KV, const float* gn_w, const float* gn_b, bf16_t* mixed, int tid, int lane, int wave) {
    const int n = item & 31, bh = item >> 5, h = bh & 3, b = bh >> 2;
    const int t0 = n * 128; const size_t m0 = (size_t)b * T + t0;
    LAS bf16_t* QS = (LAS bf16_t*)lds;
    LAS bf16_t* KD = (LAS bf16_t*)(lds + 34816);
    LAS bf16_t* VT = (LAS bf16_t*)(lds + 69632);
    LAS bf16_t* ST = (LAS bf16_t*)(lds + 104448);
    const float lg = __logf(1.f - exp2f(-5.f - (float)h));
    const int c = lane & 15, g = lane >> 4;
    {
        const int j = tid >> 2, part = tid & 3, d0 = 16 * part;
        float lo[16], hi[16];
        const bf16_t* qp = proj + (m0 + j) * NC + C_RQ + h * 128 + d0;
        unpack8(((const u32x4*)qp)[0], lo); unpack8(((const u32x4*)qp)[1], lo + 8); unpack8(((const u32x4*)(qp + 64))[0], hi); unpack8(((const u32x4*)(qp + 64))[1], hi + 8);
        rot16(lo, hi, t0 + j, d0);
        *(LAS u32x4*)(QS + j * 136 + d0) = pack8(lo); *(LAS u32x4*)(QS + j * 136 + d0 + 8) = pack8(lo + 8);
        *(LAS u32x4*)(QS + j * 136 + 64 + d0) = pack8(hi); *(LAS u32x4*)(QS + j * 136 + 64 + d0 + 8) = pack8(hi + 8);
        const bf16_t* kp = proj + (m0 + j) * NC + C_RK + h * 128 + d0;
        unpack8(((const u32x4*)kp)[0], lo); unpack8(((const u32x4*)kp)[1], lo + 8); unpack8(((const u32x4*)(kp + 64))[0], hi); unpack8(((const u32x4*)(kp + 64))[1], hi + 8);
        rot16(lo, hi, t0 + j, d0);
#pragma unroll
        for (int e = 0; e < 16; ++e) { lo[e] *= QK_SCALE; hi[e] *= QK_SCALE; }
        *(LAS u32x4*)(KD + j * 136 + d0) = pack8(lo); *(LAS u32x4*)(KD + j * 136 + d0 + 8) = pack8(lo + 8);
        *(LAS u32x4*)(KD + j * 136 + 64 + d0) = pack8(hi); *(LAS u32x4*)(KD + j * 136 + 64 + d0 + 8) = pack8(hi + 8);
    }
    lds_barrier();
    f32x4 sc[8];
#pragma unroll
    for (int tj = 0; tj < 8; ++tj) { sc[tj] = (f32x4){0.f, 0.f, 0.f, 0.f}; if (tj <= wave) mma_nt<4>(sc[tj], QS + 16 * wave * 136, 136, KD + 16 * tj * 136, 136, lane); }
    lds_barrier();
#pragma unroll
    for (int tj = 0; tj < 8; ++tj) {
        const int j = 16 * tj + c; const float gpw = __expf(-lg * (float)(j + 1));
#pragma unroll
        for (int rr = 0; rr < 4; ++rr) { const int i = 16 * wave + 4 * g + rr; KD[i * 136 + j] = (bf16_t)f2bf((i >= j) ? sc[tj][rr] * gpw : 0.f); }
    }
    f32x4 acc[16];
#pragma unroll
    for (int half = 0; half < 2; ++half) {
        if (half == 1) lds_barrier();
        {
            const int j = tid >> 2, part = tid & 3, e0 = 32 * part;
            const u32x4* vp = (const u32x4*)(proj + (m0 + j) * NC + C_RV + h * 256 + half * 128 + e0);
#pragma unroll
            for (int q = 0; q < 4; ++q) { const u32x4 w = vp[q]; const unsigned ww[4] = {w.x, w.y, w.z, w.w};
#pragma unroll
                for (int p = 0; p < 4; ++p) { VT[(e0 + 8 * q + 2 * p) * 136 + j] = (bf16_t)(ww[p] & 0xffffu); VT[(e0 + 8 * q + 2 * p + 1) * 136 + j] = (bf16_t)(ww[p] >> 16); } }
            const bf16_t* kv = (const bf16_t*)KV + (size_t)item * 32768 + (size_t)half * 128 * 128;
#pragma unroll
            for (int u = 0; u < 4; ++u) { const int q = tid + NTHR * u, e = q >> 4, part = q & 15; *(LAS u32x4*)(ST + e * 136 + part * 8) = *(const u32x4*)(kv + e * 128 + part * 8); }
        }
        lds_barrier();
#pragma unroll
        for (int te = 0; te < 8; ++te) {
            f32x4 a = {0.f, 0.f, 0.f, 0.f};
            mma_nt<4>(a, VT + 16 * te * 136, 136, KD + 16 * wave * 136, 136, lane);
            mma_nt<4>(a, ST + 16 * te * 136, 136, QS + 16 * wave * 136, 136, lane);
            acc[half * 8 + te] = a;
        }
    }
    {
        const int i = 16 * wave + c;
        const float qd = __expf(lg * (float)(i + 1));
        float sm = 0.f;
#pragma unroll
        for (int t = 0; t < 16; ++t) { acc[t] = acc[t] * qd; sm += (acc[t][0] + acc[t][1]) + (acc[t][2] + acc[t][3]); }
        sm += __shfl_xor(sm, 16); sm += __shfl_xor(sm, 32);
        const float mean = sm * (1.f / 256.f);
        float v = 0.f;
#pragma unroll
        for (int t = 0; t < 16; ++t) { acc[t] = acc[t] - mean; v += (acc[t][0] * acc[t][0] + acc[t][1] * acc[t][1]) + (acc[t][2] * acc[t][2] + acc[t][3] * acc[t][3]); }
        v += __shfl_xor(v, 16); v += __shfl_xor(v, 32);
        const float rstd = rsqrtf(v * (1.f / 256.f) + 1e-5f);
        const bf16_t* rg = proj + (m0 + i) * NC + C_RG + h * 256 + 4 * g;
        bf16_t* mo = mixed + (m0 + i) * D + h * 256 + 4 * g;
        const float* gw_ = gn_w + h * 256 + 4 * g; const float* gb_ = gn_b + h * 256 + 4 * g;
#pragma unroll
        for (int t = 0; t < 16; ++t) {
            const u32x2 rgv = *(const u32x2*)(rg + 16 * t);
            const f32x4 w4 = *(const f32x4*)(gw_ + 16 * t), b4 = *(const f32x4*)(gb_ + 16 * t);
            const f32x4 o = acc[t] * rstd * w4 + b4;
            u32x2 w; w.x = pk2(o[0] * silu_f(bflo(rgv.x)), o[1] * silu_f(bfhi(rgv.x))); w.y = pk2(o[2] * silu_f(bflo(rgv.y)), o[3] * silu_f(bfhi(rgv.y)));
            *(u32x2*)(mo + 16 * t) = w;
        }
    }
    lds_barrier();
}

__device__ __forceinline__ void ln_rows(const bf16_t* z, float* dst, const float* ln_w, const float* ln_b, int lane, int wave, int G) {
    const int gw = blockIdx.x * NWAVES + wave, NGW = G * NWAVES;
    for (int m = gw; m < M; m += NGW) {
        const u32x4* zr = (const u32x4*)(z + (size_t)m * D) + lane;
        float v[4][8]; float s = 0.f;
#pragma unroll
        for (int j = 0; j < 4; ++j) { unpack8(__builtin_nontemporal_load(zr + 64 * j), v[j]);
#pragma unroll
            for (int e = 0; e < 8; ++e) s += v[j][e]; }
        const float mean = wave_sum(s) * (1.f / D); float s2 = 0.f;
#pragma unroll
        for (int j = 0; j < 4; ++j)
#pragma unroll
            for (int e = 0; e < 8; ++e) { v[j][e] -= mean; s2 += v[j][e] * v[j][e]; }
        const float rstd = rsqrtf(wave_sum(s2) * (1.f / D) + 1e-5f);
        float* drow = dst + (size_t)m * D + 8 * lane;
#pragma unroll
        for (int j = 0; j < 4; ++j) {
            const f32x4 w0 = *(const f32x4*)(ln_w + 8 * lane + 512 * j), w1 = *(const f32x4*)(ln_w + 8 * lane + 512 * j + 4);
            const f32x4 b0 = *(const f32x4*)(ln_b + 8 * lane + 512 * j), b1 = *(const f32x4*)(ln_b + 8 * lane + 512 * j + 4);
            __builtin_nontemporal_store((f32x4){v[j][0], v[j][1], v[j][2], v[j][3]} * rstd * w0 + b0, (f32x4*)(drow + 512 * j));
            __builtin_nontemporal_store((f32x4){v[j][4], v[j][5], v[j][6], v[j][7]} * rstd * w1 + b1, (f32x4*)(drow + 512 * j + 4));
        }
    }
}

#ifndef MK_N_LAUNCHES
#define MK_N_LAUNCHES 1
#endif
constexpr int N_PHASES = 8;
constexpr size_t WS_CTL = 3 * MiB + 512 * 1024; constexpr int CTL_BYTES = 16384;
#define XB_TMO      128
#define XB_XCNT(j)  (256  + 64 * (j))
#define XB_XSUB(j)  (1280 + 64 * (j))
#define XB_XGEN(j)  (2304 + 64 * (j))
#define XB_TOP      3328
#define XB_TOPGEN   3392
#define XCD_BAR_WORDS 3456
#define XB_SPIN_CAP (1u << 18)

__device__ __forceinline__ unsigned xb_ld(unsigned* p)              { return __hip_atomic_load(p, __ATOMIC_RELAXED, __HIP_MEMORY_SCOPE_AGENT); }
__device__ __forceinline__ unsigned xb_add(unsigned* p, unsigned v) { return __hip_atomic_fetch_add(p, v, __ATOMIC_RELAXED, __HIP_MEMORY_SCOPE_AGENT); }
__device__ __forceinline__ unsigned xb_xcc_id() { return (unsigned)__builtin_amdgcn_s_getreg((3 << 11) | 20) & 0xFu; }
#define XB_SPIN(cond, bar) do { unsigned _sp = 0; while (cond) { __builtin_amdgcn_s_sleep(1); \
    if ((++_sp & 255u) == 0u) { if (xb_ld(&(bar)[XB_TMO])) break; if (_sp > XB_SPIN_CAP) { atomicAdd(&(bar)[XB_TMO], 1u); break; } } } } while (0)

struct XcdBarrier {
    unsigned* bar; unsigned x;
    volatile LAS unsigned* st;
};

__device__ __forceinline__ XcdBarrier xcd_barrier_post(unsigned* bar, volatile LAS unsigned* st) {
    XcdBarrier b; b.bar = bar; b.x = xb_xcc_id(); b.st = st;
    if (threadIdx.x == 0) (void)xb_add(&bar[XB_XCNT(b.x)], 1u);
    return b;
}
__device__ __forceinline__ void xcd_barrier_complete(unsigned* bar, unsigned x, unsigned& nloc, unsigned& nx) {
    const unsigned G = gridDim.x * gridDim.y * gridDim.z;
    unsigned sum, cnt, mine, sp = 0u;
    for (;;) {
        sum = 0u; cnt = 0u; mine = 0u;
#pragma unroll
        for (unsigned j = 0; j < 16; ++j) { const unsigned c = xb_ld(&bar[XB_XCNT(j)]); sum += c; cnt += (c > 0u) ? 1u : 0u; mine = (j == x) ? c : mine; }
        if (sum == G) break;
        __builtin_amdgcn_s_sleep(1);
        if ((++sp & 255u) == 0u) { if (xb_ld(&bar[XB_TMO])) break; if (sp > XB_SPIN_CAP) { atomicAdd(&bar[XB_TMO], 1u); break; } }
    }
    nloc = mine > 0u ? mine : 1u; nx = cnt > 0u ? cnt : 1u;
}

__device__ __forceinline__ void xcd_barrier(const XcdBarrier& b) {
    asm volatile("s_waitcnt vmcnt(0)" ::: "memory");
    __syncthreads();
    if (threadIdx.x == 0) {
        unsigned* bar = b.bar;
        __builtin_amdgcn_s_waitcnt(0);
        unsigned nloc = b.st[0], nx = b.st[1];
        if (nloc == 0u) { xcd_barrier_complete(bar, b.x, nloc, nx); b.st[0] = nloc; b.st[1] = nx; }
        const unsigned old = xb_add(&bar[XB_XSUB(b.x)], 1u);
        const unsigned gen = old / nloc;
        if (old + 1u == (gen + 1u) * nloc) {
            __builtin_amdgcn_fence(__ATOMIC_RELEASE, "agent");
            asm volatile("s_waitcnt vmcnt(0)" ::: "memory");
            const unsigned og = xb_add(&bar[XB_TOP], 1u);
            const unsigned tg = og / nx;
            if (og + 1u == (tg + 1u) * nx) xb_add(&bar[XB_TOPGEN], 1u);
            else XB_SPIN(xb_ld(&bar[XB_TOPGEN]) == tg, bar);
            __builtin_amdgcn_fence(__ATOMIC_ACQUIRE, "agent");
            xb_add(&bar[XB_XGEN(b.x)], 1u);
            asm volatile("s_waitcnt vmcnt(0)" ::: "memory");
        } else {
            XB_SPIN(xb_ld(&bar[XB_XGEN(b.x)]) == gen, bar);
            __builtin_amdgcn_fence(__ATOMIC_ACQUIRE, "agent");
            asm volatile("s_waitcnt vmcnt(0)" ::: "memory");
        }
    }
    __syncthreads();
}

struct Args { const float* in[14]; float* out; unsigned char* ws; int ph_lo, ph_hi, nsync, pad; };
__global__ void __launch_bounds__(NTHR) hybrid_fwd(Args args) {
    extern __shared__ __attribute__((aligned(16))) unsigned char lds_raw[];
    LAS unsigned char* lds = (LAS unsigned char*)lds_raw;
    cg::grid_group grid = cg::this_grid();
    const int tid = threadIdx.x, lane = tid & 63, wave = __builtin_amdgcn_readfirstlane(tid >> 6), G = gridDim.x;
    const float* x = args.in[0]; const float* cvec = args.in[1]; const float* w_ada = args.in[2]; const float* b_ada = args.in[3]; const float* w_in = args.in[4];
    const float* conv_w = args.in[5]; const float* a_log = args.in[6]; const float* dt_bias = args.in[7]; const float* gn_w = args.in[8]; const float* gn_b = args.in[9];
    const float* norm_w = args.in[10]; const float* w_out = args.in[11]; const float* ln_w = args.in[12]; const float* ln_b = args.in[13];
    unsigned char* ws = args.ws; float* out = args.out;
    float* mod = (float*)(ws + WS_MOD); float* gdec = (float*)(ws + WS_G); float* beta = (float*)(ws + WS_BETA); float* glv = (float*)(ws + WS_GL);
    bf16_t* WoutT = (bf16_t*)(ws + WS_WOUT); bf16_t* WinT = (bf16_t*)(ws + WS_WIN); bf16_t* hin = (bf16_t*)(ws + WS_HIN); bf16_t* mixed = hin;
    bf16_t* proj = (bf16_t*)(ws + WS_PROJ); unsigned char* gprep = ws + WS_GPREP; float* KV = out;
    const int lo = args.ph_lo, hi = args.ph_hi;
#define IN(k) (lo <= (k) && (k) < hi)
#define SEAM(k) do { if (IN(k) && IN((k) + 1)) xcd_barrier(bar); } while (0)

    volatile LAS unsigned* bst = (volatile LAS unsigned*)(lds + LDS_BYTES - 16);
    if (tid == 0) { bst[0] = 0u; bst[1] = 0u; }
    __syncthreads();
    XcdBarrier bar = xcd_barrier_post((unsigned*)(ws + WS_CTL), bst);
    for (int i = 0; i < args.nsync; ++i) grid.sync();
    if (IN(0)) p0_phase(lds, cvec, w_ada, b_ada, w_in, w_out, mod, WinT, WoutT, tid, lane, wave, G, 1);
    SEAM(0);
    if (IN(1)) p1_phase(lds, x, w_in, mod, a_log, dt_bias, hin, gdec, beta, tid, lane, wave, G, 1);
    SEAM(1);
    if (IN(2)) {
        pg8::Gemm g{hin, WinT, M, NC, D}; pg8::StaticOrder S; S.init(M, NC, G, (int)blockIdx.x, 1);
        pg8::EpiBf16 E{proj, NC};
        pg8::gemm_phase<pg8::EpiBf16, pg8::StaticOrder, true, true>(lds, g, S, E);
    }
    SEAM(2);
    if (IN(3)) {
        for (int v = blockIdx.x; v < 256; v += G) gdn_prep_block(lds, v & 255, proj, conv_w, gdec, beta, gprep, glv, tid, lane, wave);
        for (int it = blockIdx.x; it < 1024; it += G) ret_kv_item(lds, it & 1023, proj, KV, tid, lane, wave);
    }
    SEAM(3);
    if (IN(4)) {
        const bool fuse = (G == 256);
        for (int task = blockIdx.x; task < 256; task += G) { const int tk = task & 255, xcd = tk & 7, loc = tk >> 3; gdn_scan_task(lds, xcd * 8 + (loc >> 2), loc & 3, gprep, glv, mixed, KV, (fuse && task < 256) ? tk : -1, tid, lane, wave); }
        if (!fuse) ret_scan(KV, KV, tid, 0, G);
    }
    SEAM(4);
    if (IN(5)) { gdn_norm_rows(proj, norm_w, mixed, lane, wave, G);
        for (int it = blockIdx.x; it < 1024; it += G) ret_out_item(lds, it & 1023, proj, KV, gn_w, gn_b, mixed, tid, lane, wave); }
    SEAM(5);
    if (IN(6)) {
        pg8::Gemm g{mixed, WoutT, M, D, D}; pg8::StaticOrder S; S.init(M, D, G, (int)blockIdx.x, 1);
        pg8::EpiZ16 E{x, mod + 4096, (bf16_t*)(ws + WS_PROJ), 1.189207115002721f};
        pg8::gemm_phase<pg8::EpiZ16, pg8::StaticOrder, true, true>(lds, g, S, E);
    }
    SEAM(6);
    if (IN(7)) { ln_rows((const bf16_t*)(ws + WS_PROJ), out, ln_w, ln_b, lane, wave, G); }
#undef IN
#undef SEAM
}

extern "C" void kernel_launch(void* const* d_in, const int* in_sizes, int n_in, void* d_out, int out_size, void* d_ws, size_t ws_size, hipStream_t stream) {
    static int grid = 0;
    if (grid == 0) {
        if (n_in != 14 || out_size != M * D || ws_size < WS_END) { fprintf(stderr, "kernel_launch: unexpected problem (n_in %d, out %d, ws %zu)\n", n_in, out_size, ws_size); grid = -1; return; }
        int dev = 0, cus = 0, per_cu = 0;
        if (hipGetDevice(&dev) != hipSuccess || hipDeviceGetAttribute(&cus, hipDeviceAttributeMultiprocessorCount, dev) != hipSuccess) { grid = -1; return; }
        if (hipFuncSetAttribute((const void*)hybrid_fwd, hipFuncAttributeMaxDynamicSharedMemorySize, LDS_BYTES) != hipSuccess) { fprintf(stderr, "kernel_launch: hipFuncSetAttribute failed\n"); grid = -1; return; }
        if (hipOccupancyMaxActiveBlocksPerMultiprocessor(&per_cu, (const void*)hybrid_fwd, NTHR, LDS_BYTES) != hipSuccess || per_cu < 1) { fprintf(stderr, "kernel_launch: occupancy query reports %d blocks per CU\n", per_cu); (void)hipGetLastError(); per_cu = 1; }
        grid = cus * 1;
    }
    if (grid < 0) return;
    if (hipMemsetAsync((char*)d_ws + WS_CTL, 0, CTL_BYTES, stream) != hipSuccess) { fprintf(stderr, "kernel_launch: memset of the barrier words failed\n"); return; }
    Args a{};
    for (int i = 0; i < 14; ++i) a.in[i] = (const float*)d_in[i];
    a.out = (float*)d_out; a.ws = (unsigned char*)d_ws; a.nsync = 0;
    for (int li = 0; li < MK_N_LAUNCHES; ++li) {
        if (MK_N_LAUNCHES == 1) { a.ph_lo = 0; a.ph_hi = N_PHASES; } else { a.ph_lo = li; a.ph_hi = li + 1; }
        void* kargs[] = {&a};
        const hipError_t e = hipLaunchCooperativeKernel((const void*)hybrid_fwd, dim3(grid), dim3(NTHR), kargs, LDS_BYTES, stream);
        if (e != hipSuccess) { fprintf(stderr, "kernel_launch: cooperative launch failed: %s (grid %d)\n", hipGetErrorString(e), grid); break; }
    }
}
```

```cpp
#include <hip/hip_runtime.h>
#include <hip/hip_cooperative_groups.h>
#include <cstdio>
#include <cstdint>
namespace cg = cooperative_groups;
namespace pg8 {
#define PG8_LAS __attribute__((address_space(3)))
typedef unsigned short bf16_t;
typedef short bf16x8 __attribute__((ext_vector_type(8)));
typedef float f32x4 __attribute__((ext_vector_type(4)));
typedef unsigned u32x4 __attribute__((ext_vector_type(4)));
constexpr int BM = 256, BK = 64, HALF = 128, HTB = HALF * BK * 2  , STAGE_BYTES = 8 * HTB, NXCD = 8, WGM = 8;

__host__ __device__ __forceinline__ int lds_byte(int r, int c) { const int st = (r >> 4) * 2 + (c >> 5), rr = r & 15, cc = c & 31, ob = rr * 64 + cc * 2; return st * 1024 + (ob ^ (((ob >> 9) & 1) << 5)); }
__host__ __device__ __forceinline__ void stage_rc(int b, int& R, int& C) { const int st = b / 1024, sb = b % 1024, swz = sb ^ (((sb >> 9) & 1) << 5); R = (st >> 1) * 16 + swz / 64; C = (st & 1) * 32 + (swz % 64) / 2; }
__host__ __device__ __forceinline__ int perm32(int rho) { const int n = rho >> 4, i = rho & 15; return 8 * (i >> 2) + 4 * n + (i & 3); }

struct Unit { int pm, pn; };
struct Gemm { const bf16_t* A; const bf16_t* Bt; int M, N, K; };

struct StaticOrder {
    int nM, nN, nwg, G, c, nrep;
    __host__ __device__ void init(int M, int N, int G_, int c_, int nrep_ = 1) { nM = M / BM; nN = N / BM; nwg = nM * nN; G = G_; c = c_; nrep = nrep_; }
    __host__ __device__ bool next(int i, Unit& u) const {
        const long L = (long)i * G + c; if (L >= (long)nwg * nrep) return false;
        int wgid = (int)(L % nwg); { const int q = nwg / NXCD, r = nwg % NXCD, xcd = wgid % NXCD, off = wgid / NXCD; wgid = (xcd < r ? xcd * (q + 1) : r * (q + 1) + (xcd - r) * q) + off; }
        const int nig = WGM * nN, gid = wgid / nig, fm = gid * WGM, gsz = (nM - fm) < WGM ? (nM - fm) : WGM;
        u.pm = fm + ((wgid % nig) % gsz); u.pn = (wgid % nig) / gsz; return true;
    }
    __device__ __forceinline__ void a_ready(const Unit&) const {}
    __device__ __forceinline__ void done(const Unit&) const {}
};

__device__ __forceinline__ unsigned cvt_pk_bf16(float lo, float hi) { unsigned r; asm volatile("v_cvt_pk_bf16_f32 %0, %1, %2" : "=v"(r) : "v"(lo), "v"(hi)); return r; }
struct EpiBf16 {
    static constexpr bool PERM = true, AFTER_DRAIN = false;
    bf16_t* O; int ldc;
    __device__ __forceinline__ void operator()(const f32x4 (&acc)[2][2][4][2], const Unit& u, int wr, int wc, int fr, int fq) const {
        const int row0 = u.pm * BM + wr * 64 + fr; const int col0 = u.pn * BM + wc * 32 + 8 * fq;
#pragma unroll
        for (int ai = 0; ai < 2; ++ai)
#pragma unroll
            for (int m = 0; m < 4; ++m) { bf16_t* rowp = O + (size_t)(row0 + ai * HALF + m * 16) * ldc + col0;
#pragma unroll
                for (int bj = 0; bj < 2; ++bj) { const f32x4 v0 = acc[ai][bj][m][0], v1 = acc[ai][bj][m][1];
                    u32x4 w; w.x = cvt_pk_bf16(v0[0], v0[1]); w.y = cvt_pk_bf16(v0[2], v0[3]); w.z = cvt_pk_bf16(v1[0], v1[1]); w.w = cvt_pk_bf16(v1[2], v1[3]);
                    *(u32x4*)(rowp + bj * HALF) = w; } }
    }
};
struct EpiZ {
    static constexpr bool PERM = false, AFTER_DRAIN = false;
    const float* x; const float* gate; float* out; float alpha;
    __device__ __forceinline__ void operator()(const f32x4 (&acc)[2][2][4][2], const Unit& u, int wr, int wc, int fr, int fq) const {
        const int col0 = u.pn * BM + wc * 32 + 4 * fq;
#pragma unroll
        for (int ai = 0; ai < 2; ++ai)
#pragma unroll
            for (int m = 0; m < 4; ++m) { const int r = u.pm * BM + ai * HALF + wr * 64 + m * 16 + fr; const size_t off = (size_t)r * 2048 + col0; const float* gb = gate + (size_t)(r >> 12) * 6144 + col0;
#pragma unroll
                for (int bj = 0; bj < 2; ++bj)
#pragma unroll
                    for (int n = 0; n < 2; ++n) { const f32x4 xv = *(const f32x4*)(x + off + bj * HALF + n * 16); const f32x4 gv = *(const f32x4*)(gb + bj * HALF + n * 16);
                        *(f32x4*)(out + off + bj * HALF + n * 16) = xv * alpha + gv * acc[ai][bj][m][n]; } }
    }
};
struct EpiZ16 {
    static constexpr bool PERM = true, AFTER_DRAIN = false;
    const float* x; const float* gate; bf16_t* z; float alpha;
    __device__ __forceinline__ void operator()(const f32x4 (&acc)[2][2][4][2], const Unit& u, int wr, int wc, int fr, int fq) const {
        const int col0 = u.pn * BM + wc * 32 + 8 * fq;
        const float* gb = gate + (size_t)((u.pm * BM) >> 12) * 6144 + col0;
        const f32x4 g00 = *(const f32x4*)(gb), g01 = *(const f32x4*)(gb + 4), g10 = *(const f32x4*)(gb + HALF), g11 = *(const f32x4*)(gb + HALF + 4);
#pragma unroll
        for (int ai = 0; ai < 2; ++ai)
#pragma unroll
            for (int m = 0; m < 4; ++m) { const int r = u.pm * BM + ai * HALF + wr * 64 + m * 16 + fr; const size_t off = (size_t)r * 2048 + col0;
#pragma unroll
                for (int bj = 0; bj < 2; ++bj) {
                    const f32x4 x0 = __builtin_nontemporal_load((const f32x4*)(x + off + bj * HALF)), x1 = __builtin_nontemporal_load((const f32x4*)(x + off + bj * HALF + 4));
                    const f32x4 v0 = x0 * alpha + (bj ? g10 : g00) * acc[ai][bj][m][0], v1 = x1 * alpha + (bj ? g11 : g01) * acc[ai][bj][m][1];
                    u32x4 w; w.x = cvt_pk_bf16(v0[0], v0[1]); w.y = cvt_pk_bf16(v0[2], v0[3]); w.z = cvt_pk_bf16(v1[0], v1[1]); w.w = cvt_pk_bf16(v1[2], v1[3]);
                    *(u32x4*)(z + off + bj * HALF) = w; } }
    }
};
template <class Epi, class Sched, bool ALIGN_EPI = false, bool SP2 = false>
__device__ __forceinline__ void gemm_phase(PG8_LAS unsigned char* lds, const Gemm g, const Sched& S, const Epi& E) {
    const int tid = threadIdx.x, wid = __builtin_amdgcn_readfirstlane(tid >> 6), lane = tid & 63, wr = wid >> 2, wc = wid & 3, fr = lane & 15, fq = lane >> 4;
    const int K = g.K, nt = K / BK;
    unsigned voffA[2], voffB[2];
#pragma unroll
    for (int i = 0; i < 2; ++i) { int R, C; stage_rc(tid * 16 + i * 8192, R, C); const int Rb = Epi::PERM ? ((R & ~31) + perm32(R & 31)) : R;
        voffA[i] = (unsigned)(R * K + C) * 2u; voffB[i] = (unsigned)(Rb * K + C) * 2u; }
    const size_t kstep = (size_t)(BK * 2);
    const size_t hstep = (size_t)HALF * K * 2;
    const size_t tstep = 2 * hstep;
    const unsigned ldsw = (unsigned)wid * 1024u;
    const int aoff = lds_byte(wr * 64 + fr, fq * 8), boff = lds_byte(wc * 32 + fr, fq * 8);
#define PG8_SA(b, h) (((b) * 2 + (h)) * HTB)
#define PG8_SB(b, h) ((4 + (b) * 2 + (h)) * HTB)
#define PG8_STAGE(bufoff, gbase, voff) do { _Pragma("unroll") for (int _i = 0; _i < 2; ++_i) \
        __builtin_amdgcn_global_load_lds((const unsigned*)((const char*)(gbase) + (voff)[_i]), (PG8_LAS unsigned*)(lds + (bufoff) + ldsw + _i * 8192), 16, 0, 0); } while (0)
#define PG8_LDA(dst, b, h) do { _Pragma("unroll") for (int m = 0; m < 4; ++m) _Pragma("unroll") for (int k = 0; k < 2; ++k) dst[m][k] = *(const PG8_LAS bf16x8*)(lds + PG8_SA(b, h) + aoff + m * 2048 + k * 1024); } while (0)
#define PG8_LDB(dst, b, h) do { _Pragma("unroll") for (int n = 0; n < 2; ++n) _Pragma("unroll") for (int k = 0; k < 2; ++k) dst[n][k] = *(const PG8_LAS bf16x8*)(lds + PG8_SB(b, h) + boff + n * 2048 + k * 1024); } while (0)
#define PG8_MMA(ai, bj, At, Bt) do { __builtin_amdgcn_s_setprio(1); _Pragma("unroll") for (int m = 0; m < 4; ++m) _Pragma("unroll") for (int n = 0; n < 2; ++n) _Pragma("unroll") for (int k = 0; k < 2; ++k) \
        acc[ai][bj][m][n] = __builtin_amdgcn_mfma_f32_16x16x32_bf16(Bt[n][k], At[m][k], acc[ai][bj][m][n], 0, 0, 0); __builtin_amdgcn_s_setprio(0); } while (0)
#define PG8_WAIT_V(n) asm volatile("s_waitcnt vmcnt(" #n ")" ::: "memory")
#define PG8_WAIT_L(n) asm volatile("s_waitcnt lgkmcnt(" #n ")" ::: "memory")
#define PG8_BAR __builtin_amdgcn_s_barrier()
#define PG8_SCHED __builtin_amdgcn_sched_barrier(0)
    Unit cur, nxt; int ui = 0;
    if (!S.next(0, cur)) return;
    f32x4 acc[2][2][4][2];
#pragma unroll
    for (int a = 0; a < 2; ++a)
#pragma unroll
        for (int b = 0; b < 2; ++b)
#pragma unroll
            for (int m = 0; m < 4; ++m)
#pragma unroll
                for (int n = 0; n < 2; ++n) acc[a][b][m][n] = (f32x4){0.f, 0.f, 0.f, 0.f};
    bf16x8 At[4][2], B0[2][2], B1[2][2];
    const char* cA = (const char*)g.A + (size_t)cur.pm * tstep; const char* cB = (const char*)g.Bt + (size_t)cur.pn * tstep;
    S.a_ready(cur);
    if constexpr (SP2) {
        PG8_STAGE(PG8_SB(0, 0), cB, voffB); PG8_STAGE(PG8_SB(0, 1), cB + hstep, voffB); PG8_STAGE(PG8_SA(0, 0), cA, voffA); PG8_STAGE(PG8_SA(0, 1), cA + hstep, voffA);
        if (wr == 1) PG8_BAR;
        PG8_WAIT_V(2); PG8_BAR;
        PG8_STAGE(PG8_SB(1, 0), cB + kstep, voffB); PG8_STAGE(PG8_SA(1, 0), cA + kstep, voffA); PG8_STAGE(PG8_SB(1, 1), cB + hstep + kstep, voffB);
        PG8_WAIT_V(6); PG8_BAR;
    } else {
        PG8_STAGE(PG8_SB(0, 0), cB, voffB); PG8_STAGE(PG8_SA(0, 0), cA, voffA); PG8_STAGE(PG8_SB(0, 1), cB + hstep, voffB); PG8_STAGE(PG8_SA(0, 1), cA + hstep, voffA);
        if (wr == 1) PG8_BAR;
        PG8_WAIT_V(4); PG8_BAR;
        PG8_STAGE(PG8_SB(1, 0), cB + kstep, voffB); PG8_STAGE(PG8_SA(1, 0), cA + kstep, voffA); PG8_STAGE(PG8_SB(1, 1), cB + hstep + kstep, voffB);
        PG8_WAIT_V(6); PG8_BAR;
    }
    for (;;) {
        const bool has_next = S.next(ui + 1, nxt);
        const char* nA = has_next ? (const char*)g.A + (size_t)nxt.pm * tstep : cA; const char* nB = has_next ? (const char*)g.Bt + (size_t)nxt.pn * tstep : cB;
        for (int t = 0; t < nt; t += 2) {
            const bool last = (t == nt - 2);
            const char* a1 = cA + (size_t)(t + 1) * kstep;
            const char* a2 = last ? nA : cA + (size_t)(t + 2) * kstep; const char* b2 = last ? nB : cB + (size_t)(t + 2) * kstep;
            const char* a3 = a2 + kstep; const char* b3 = b2 + kstep;
            if (last && has_next) S.a_ready(nxt);
            if constexpr (SP2) {
            PG8_LDB(B0, 0, 0); PG8_LDB(B1, 0, 1); PG8_SCHED; PG8_LDA(At, 0, 0); PG8_STAGE(PG8_SA(1, 1), a1 + hstep, voffA);
            PG8_WAIT_V(8); PG8_WAIT_L(0); PG8_BAR; PG8_MMA(0, 0, At, B0); PG8_MMA(0, 1, At, B1); PG8_BAR; PG8_SCHED;
            PG8_LDA(At, 0, 1); PG8_STAGE(PG8_SB(0, 0), b2, voffB); PG8_STAGE(PG8_SB(0, 1), b2 + hstep, voffB); PG8_STAGE(PG8_SA(0, 0), a2, voffA);
            PG8_WAIT_V(8); PG8_WAIT_L(0); PG8_BAR; PG8_MMA(1, 0, At, B0); PG8_MMA(1, 1, At, B1); PG8_BAR; PG8_SCHED;
            PG8_LDB(B0, 1, 0); PG8_LDB(B1, 1, 1); PG8_SCHED; PG8_LDA(At, 1, 0); PG8_STAGE(PG8_SA(0, 1), a2 + hstep, voffA);
            PG8_WAIT_V(8); PG8_WAIT_L(0); PG8_BAR; PG8_MMA(0, 0, At, B0); PG8_MMA(0, 1, At, B1); PG8_BAR; PG8_SCHED;
            PG8_LDA(At, 1, 1); PG8_STAGE(PG8_SB(1, 0), b3, voffB); PG8_STAGE(PG8_SB(1, 1), b3 + hstep, voffB); PG8_STAGE(PG8_SA(1, 0), a3, voffA);
            PG8_WAIT_V(8); PG8_WAIT_L(0); PG8_BAR; PG8_MMA(1, 0, At, B0); PG8_MMA(1, 1, At, B1); PG8_BAR; PG8_SCHED;
            } else {
            PG8_LDB(B0, 0, 0); PG8_SCHED; PG8_LDA(At, 0, 0); PG8_STAGE(PG8_SA(1, 1), a1 + hstep, voffA);
            PG8_WAIT_L(8); PG8_BAR; PG8_WAIT_L(0); PG8_MMA(0, 0, At, B0); PG8_BAR; PG8_SCHED;
            PG8_LDB(B1, 0, 1); PG8_STAGE(PG8_SB(0, 0), b2, voffB);
            PG8_BAR; PG8_WAIT_L(0); PG8_MMA(0, 1, At, B1); PG8_BAR;
            PG8_LDA(At, 0, 1); PG8_STAGE(PG8_SA(0, 0), a2, voffA);
            PG8_BAR; PG8_WAIT_L(0); PG8_MMA(1, 0, At, B0); PG8_BAR; PG8_SCHED;
            PG8_STAGE(PG8_SB(0, 1), b2 + hstep, voffB);
            PG8_WAIT_V(6); PG8_BAR; PG8_MMA(1, 1, At, B1); PG8_BAR;
            PG8_LDB(B0, 1, 0); PG8_SCHED; PG8_LDA(At, 1, 0); PG8_STAGE(PG8_SA(0, 1), a2 + hstep, voffA);
            PG8_WAIT_L(8); PG8_BAR; PG8_WAIT_L(0); PG8_MMA(0, 0, At, B0); PG8_BAR; PG8_SCHED;
            PG8_LDB(B1, 1, 1); PG8_STAGE(PG8_SB(1, 0), b3, voffB);
            PG8_BAR; PG8_WAIT_L(0); PG8_MMA(0, 1, At, B1); PG8_BAR;
            PG8_LDA(At, 1, 1); PG8_STAGE(PG8_SA(1, 0), a3, voffA);
            PG8_BAR; PG8_WAIT_L(0); PG8_MMA(1, 0, At, B0); PG8_BAR; PG8_SCHED;
            PG8_STAGE(PG8_SB(1, 1), b3 + hstep, voffB);
            PG8_WAIT_V(6); PG8_BAR; PG8_MMA(1, 1, At, B1); PG8_BAR;
            }
        }
        if constexpr (ALIGN_EPI) { if (wr == 0) PG8_BAR; }
        if constexpr (!Epi::AFTER_DRAIN) { E(acc, cur, wr, wc, fr, fq); S.done(cur); }
        if (!has_next) break;
#pragma unroll
        for (int a = 0; a < 2; ++a)
#pragma unroll
            for (int b = 0; b < 2; ++b)
#pragma unroll
                for (int m = 0; m < 4; ++m)
#pragma unroll
                    for (int n = 0; n < 2; ++n) acc[a][b][m][n] = (f32x4){0.f, 0.f, 0.f, 0.f};
        cur = nxt; cA = nA; cB = nB; ++ui;
        if constexpr (ALIGN_EPI) { if (wr == 1) PG8_BAR; }
    }
    PG8_WAIT_V(0);
    if constexpr (!ALIGN_EPI) { if (wr == 0) PG8_BAR; }
    PG8_BAR;
    if constexpr (Epi::AFTER_DRAIN) { E.fused(acc, cur, wr, wc, fr, fq, lds, wid, lane); S.done(cur); }
#undef PG8_SA
#undef PG8_SB
#undef PG8_STAGE
#undef PG8_LDA
#undef PG8_LDB
#undef PG8_MMA
#undef PG8_WAIT_V
#undef PG8_WAIT_L
#undef PG8_BAR
#undef PG8_SCHED
}
}

#define LAS __attribute__((address_space(3)))
typedef unsigned short bf16_t;
typedef short bf16x8 __attribute__((ext_vector_type(8)));
typedef float f32x4 __attribute__((ext_vector_type(4)));
typedef unsigned u32x4 __attribute__((ext_vector_type(4)));
typedef unsigned u32x2 __attribute__((ext_vector_type(2)));
constexpr int NWAVES = 8, NTHR = 512;
constexpr int NB = 8, T = 4096, D = 2048, M = NB * T;
constexpr int NC = 7168, INC = 7184;
constexpr int C_RQ = 0, C_RK = 512, C_RV = 1024, C_RG = 2048, C_GQ = 3072, C_GG = 6144;
constexpr size_t MiB = (size_t)1 << 20;
constexpr size_t WS_MOD = 0, WS_G = 1 * MiB, WS_BETA = 2 * MiB, WS_GL = 3 * MiB, WS_WOUT = 4 * MiB, WS_WIN = 12 * MiB, WS_HIN = 40 * MiB, WS_PROJ = 168 * MiB, WS_GPREP = 616 * MiB, WS_END = 904 * MiB;
constexpr int GP_W = 0, GP_QE = 16384, GP_KT = 32768, GP_AT = 49152, GP_UT = 57344, GP_BYTES = 73728;
constexpr int LDS_BYTES = 147456;
constexpr float QK_SCALE = 0.08838834764831845f;

typedef __bf16 bf16v2_t __attribute__((ext_vector_type(2)));
typedef float f32v2_t __attribute__((ext_vector_type(2)));
__device__ __forceinline__ unsigned pk2(float lo, float hi) { return __builtin_bit_cast(unsigned, __builtin_convertvector((f32v2_t){lo, hi}, bf16v2_t)); }
__device__ __forceinline__ unsigned f2bf(float f) { return (unsigned)__builtin_bit_cast(unsigned short, (__bf16)f); }
__device__ __forceinline__ float bf2f(unsigned h) { return __builtin_bit_cast(float, h << 16); }
__device__ __forceinline__ float bflo(unsigned w) { return __builtin_bit_cast(float, w << 16); }
__device__ __forceinline__ float bfhi(unsigned w) { return __builtin_bit_cast(float, w & 0xffff0000u); }
__device__ __forceinline__ float silu_f(float v) { return v * __builtin_amdgcn_rcpf(1.f + __expf(-v)); }
__device__ __forceinline__ void lds_barrier() { asm volatile("s_waitcnt lgkmcnt(0)\n\ts_barrier" ::: "memory"); }
__device__ __forceinline__ float wave_sum(float v) {
#pragma unroll
    for (int o = 1; o < 64; o <<= 1) v += __shfl_xor(v, o);
    return v;
}
__device__ __forceinline__ float sum16(float v) {
#pragma unroll
    for (int o = 1; o < 16; o <<= 1) v += __shfl_xor(v, o);
    return v;
}
template <int KS> __device__ __forceinline__ void mma_nt(f32x4& acc, const LAS bf16_t* A, int lda, const LAS bf16_t* Bt, int ldb, int lane) {
    const int r = lane & 15, g = lane >> 4;
    const LAS bf16_t* ap = A + r * lda + g * 8; const LAS bf16_t* bp = Bt + r * ldb + g * 8;
#pragma unroll
    for (int ks = 0; ks < KS; ++ks) {
        const bf16x8 a = *(const LAS bf16x8*)(ap + ks * 32); const bf16x8 b = *(const LAS bf16x8*)(bp + ks * 32);
        acc = __builtin_amdgcn_mfma_f32_16x16x32_bf16(a, b, acc, 0, 0, 0);
    }
}
__device__ __forceinline__ void unpack8(const u32x4 w, float* o) { o[0] = bflo(w.x); o[1] = bfhi(w.x); o[2] = bflo(w.y); o[3] = bfhi(w.y); o[4] = bflo(w.z); o[5] = bfhi(w.z); o[6] = bflo(w.w); o[7] = bfhi(w.w); }
__device__ __forceinline__ u32x4 pack8(const float* v) { u32x4 w; w.x = pk2(v[0], v[1]); w.y = pk2(v[2], v[3]); w.z = pk2(v[4], v[5]); w.w = pk2(v[6], v[7]); return w; }

__device__ __forceinline__ int kpos(int k) { const int kk = k & 31; return (k & ~31) + ((kk & 12) << 1) + (kk & 3) + ((kk & 16) >> 2); }
__device__ __forceinline__ bf16x8 pack_tiles(const f32x4 lo, const f32x4 hi) { u32x4 w; w.x = pk2(lo[0], lo[1]); w.y = pk2(lo[2], lo[3]); w.z = pk2(hi[0], hi[1]); w.w = pk2(hi[2], hi[3]); return __builtin_bit_cast(bf16x8, w); }

__device__ __forceinline__ void p0_transpose_item(const float* W, int ldw, int K, bf16_t* WT, LAS float* scr, int nblk, int item, int lane) {
    const int kb = item / nblk, nb = item % nblk, k0 = 64 * kb, n0 = 32 * nb;
#pragma unroll 8
    for (int i = 0; i < 32; ++i) { const int kk = 2 * i + (lane >> 5); scr[kk * 33 + (lane & 31)] = W[(size_t)(k0 + kk) * ldw + n0 + (lane & 31)]; }
    asm volatile("s_waitcnt lgkmcnt(0)" ::: "memory");
    const int c = lane & 7;
#pragma unroll
    for (int j = 0; j < 4; ++j) { const int n = (lane >> 3) + 8 * j; const LAS float* s = scr + (8 * c) * 33 + n;
        u32x4 o; o.x = pk2(s[0 * 33], s[1 * 33]); o.y = pk2(s[2 * 33], s[3 * 33]); o.z = pk2(s[4 * 33], s[5 * 33]); o.w = pk2(s[6 * 33], s[7 * 33]);
        *(u32x4*)(WT + (size_t)(n0 + n) * K + k0 + 8 * c) = o; }
    asm volatile("s_waitcnt lgkmcnt(0)" ::: "memory");
}
__device__ __forceinline__ void p0_phase(LAS unsigned char* lds, const float* cvec, const float* w_ada, const float* b_ada, const float* w_in, const float* w_out,
                                         float* mod, bf16_t* WinT, bf16_t* WoutT, int tid, int lane, int wave, int G, int nrep) {
    LAS float* sc = (LAS float*)lds;
    LAS float* part = (LAS float*)(lds + 65536);
    for (int blk_ = blockIdx.x; blk_ < 256 * nrep; blk_ += G) {
        const int blk = blk_ & 255; const int n0 = 24 * blk;
        for (int i = tid; i < 8 * 2048; i += NTHR) sc[i] = silu_f(cvec[i]);
        __syncthreads();
        const int kg = tid / 6, c4 = tid % 6;
        if (tid < 510) {
            float acc[8][4];
#pragma unroll
            for (int b = 0; b < 8; ++b)
#pragma unroll
                for (int j = 0; j < 4; ++j) acc[b][j] = 0.f;
            for (int k = kg; k < 2048; k += 85) {
                const f32x4 w = *(const f32x4*)(w_ada + (size_t)k * 6144 + n0 + 4 * c4);
#pragma unroll
                for (int b = 0; b < 8; ++b) { const float s = sc[b * 2048 + k]; acc[b][0] += s * w[0]; acc[b][1] += s * w[1]; acc[b][2] += s * w[2]; acc[b][3] += s * w[3]; }
            }
#pragma unroll
            for (int b = 0; b < 8; ++b)
#pragma unroll
                for (int j = 0; j < 4; ++j) part[kg * 192 + b * 24 + 4 * c4 + j] = acc[b][j];
        }
        __syncthreads();
        if (tid < 192) { float s = 0.f; for (int q = 0; q < 85; ++q) s += part[q * 192 + tid]; const int b = tid / 24, j = tid % 24; mod[b * 6144 + n0 + j] = s + b_ada[n0 + j]; }
        __syncthreads();
    }
    LAS float* scr = (LAS float*)(lds + wave * 16384);
    const int gw = blockIdx.x * NWAVES + wave, NGW = G * NWAVES;
    constexpr int I_IN = (D / 64) * (NC / 32), I_OUT = (D / 64) * (D / 32);
    for (int it_ = gw; it_ < (I_IN + I_OUT) * nrep; it_ += NGW) {
        const int it = it_ % (I_IN + I_OUT);
        if (it < I_IN) p0_transpose_item(w_in, INC, D, WinT, scr, NC / 32, it, lane);
        else p0_transpose_item(w_out, D, D, WoutT, scr, D / 32, it - I_IN, lane);
    }
}

__device__ __forceinline__ void p1_phase(LAS unsigned char* lds, const float* x, const float* w_in, const float* mod, const float* a_log, const float* dt_bias,
                                         bf16_t* hin, float* gdec, float* beta, int tid, int lane, int wave, int G, int nrep) {
    LAS float* wx = (LAS float*)lds;
    for (int k = tid; k < 2048; k += NTHR) {
        const f32x4* src = (const f32x4*)(w_in + (size_t)k * INC + NC);
#pragma unroll
        for (int q = 0; q < 4; ++q) { const f32x4 v = src[q]; wx[(4 * q + 0) * 2048 + k] = v[0]; wx[(4 * q + 1) * 2048 + k] = v[1]; wx[(4 * q + 2) * 2048 + k] = v[2]; wx[(4 * q + 3) * 2048 + k] = v[3]; }
    }
    __syncthreads();
    typedef float f32x2 __attribute__((ext_vector_type(2)));
    const int gw = blockIdx.x * NWAVES + wave, NGW = G * NWAVES;
    for (int pair_ = gw; pair_ < (M / 2) * nrep; pair_ += NGW) {
        const int pair = pair_ & (M / 2 - 1);
        const size_t m0 = (size_t)2 * pair; const int b = (int)(m0 >> 12);
        const float* modb = mod + b * 6144;
        float acc0[16], acc1[16];
#pragma unroll
        for (int o = 0; o < 16; ++o) { acc0[o] = 0.f; acc1[o] = 0.f; }
#pragma unroll 4
        for (int i = 0; i < 16; ++i) {
            const int k = 2 * lane + 128 * i;
            const f32x2 sh = *(const f32x2*)(modb + k), scl = *(const f32x2*)(modb + 2048 + k);
            const f32x2 x0 = __builtin_nontemporal_load((const f32x2*)(x + m0 * D + k)), x1 = __builtin_nontemporal_load((const f32x2*)(x + (m0 + 1) * D + k));
            const float h00 = x0[0] * (1.f + scl[0]) + sh[0], h01 = x0[1] * (1.f + scl[1]) + sh[1];
            const float h10 = x1[0] * (1.f + scl[0]) + sh[0], h11 = x1[1] * (1.f + scl[1]) + sh[1];
            *(unsigned*)(hin + m0 * D + k) = pk2(h00, h01);
            *(unsigned*)(hin + (m0 + 1) * D + k) = pk2(h10, h11);
#pragma unroll
            for (int o = 0; o < 16; ++o) { const f32x2 w = *(const LAS f32x2*)(wx + o * 2048 + k); acc0[o] += h00 * w[0] + h01 * w[1]; acc1[o] += h10 * w[0] + h11 * w[1]; }
        }
#pragma unroll
        for (int sft = 0; sft < 4; ++sft) {
            const bool hiLane = (lane >> sft) & 1;
#pragma unroll
            for (int t = 0; t < (8 >> sft); ++t) {
                const float k0 = hiLane ? acc0[2 * t + 1] : acc0[2 * t], s0 = hiLane ? acc0[2 * t] : acc0[2 * t + 1];
                const float k1 = hiLane ? acc1[2 * t + 1] : acc1[2 * t], s1 = hiLane ? acc1[2 * t] : acc1[2 * t + 1];
                acc0[t] = k0 + __shfl_xor(s0, 1 << sft); acc1[t] = k1 + __shfl_xor(s1, 1 << sft);
            }
        }
        float v0 = acc0[0], v1 = acc1[0];
        v0 += __shfl_xor(v0, 16); v0 += __shfl_xor(v0, 32); v1 += __shfl_xor(v1, 16); v1 += __shfl_xor(v1, 32);
        if (lane < 8) {
            const float al = -__expf(a_log[lane]), db = dt_bias[lane];
            const float y0 = v0 + db, y1 = v1 + db;
            const float sp0 = y0 > 20.f ? y0 : log1pf(__expf(y0)), sp1 = y1 > 20.f ? y1 : log1pf(__expf(y1));
            gdec[m0 * 8 + lane] = al * sp0; gdec[(m0 + 1) * 8 + lane] = al * sp1;
        } else if (lane < 16) {
            beta[m0 * 8 + lane - 8] = 1.f / (1.f + __expf(-v0)); beta[(m0 + 1) * 8 + lane - 8] = 1.f / (1.f + __expf(-v1));
        }
    }
}

__device__ __forceinline__ void rot16(float* lo, float* hi, int pos, int d0) {
#pragma unroll
    for (int e = 0; e < 16; ++e) {
        const float fturn = exp2f(-(float)(d0 + e) * (13.287712379549449f / 64.f)) * 0.15915494309189535f;
        const double r = (double)pos * (double)fturn; const float fr = (float)(r - floor(r));
        const float sn = __builtin_amdgcn_sinf(fr), cs = __builtin_amdgcn_cosf(fr);
        const float a = lo[e], b = hi[e];
        lo[e] = a * cs - b * sn; hi[e] = a * sn + b * cs;
    }
}

__device__ __forceinline__ void gdn_prep_block(LAS unsigned char* lds, int vb, const bf16_t* proj, const float* conv_w, const float* gdec, const float* beta,
                                               unsigned char* gprep, float* glv, int tid, int lane, int wave) {
    const int h = vb & 7, pq = vb >> 3;
    LAS float* GCB = (LAS float*)(lds + 116736);
    LAS float* CW = (LAS float*)(lds + 122880);
    for (int idx = tid; idx < 1536; idx += NTHR) { const int X = idx >> 9, r = idx & 511; CW[idx] = conv_w[(r >> 7) * 3072 + X * 1024 + h * 128 + (r & 127)]; }
    const int ti_ = tid >> 3, td0_ = (tid & 7) * 16;
    u32x4 pre[3][4][2];
#define GP_ITEM(k) (((((pq + 32 * (k)) >> 6) * 8 + h) << 6) + ((pq + 32 * (k)) & 63))
#define GP_STEP0(itm, GCp) do { const int n_ = (itm) & 63, b_ = (itm) >> 9; const long mm = (long)b_ * T + n_ * 64; \
        const float g_ = gdec[(mm + lane) * 8 + h], bt_ = beta[(mm + lane) * 8 + h]; float gc = g_; \
        _Pragma("unroll") for (int off = 1; off < 64; off <<= 1) { const float t_ = __shfl_up(gc, off); if (lane >= off) gc += t_; } \
        const float glast = __shfl(gc, 63); (GCp)[lane] = gc; (GCp)[64 + lane] = bt_; (GCp)[128 + lane] = __expf(gc); (GCp)[192 + lane] = __expf(glast - gc); \
        if (lane == 0) glv[itm] = __expf(glast); } while (0)
#define GP_LOADPRE(itm) do { const int n_ = (itm) & 63, b_ = (itm) >> 9; const long mm = (long)b_ * T + n_ * 64; \
        _Pragma("unroll") for (int X = 0; X < 3; ++X) _Pragma("unroll") for (int j = 0; j < 4; ++j) { \
            if (n_ * 64 + ti_ - 3 + j >= 0) { const u32x4* p_ = (const u32x4*)(proj + (size_t)(mm + ti_ - 3 + j) * NC + C_GQ + X * 1024 + h * 128 + td0_); pre[X][j][0] = p_[0]; pre[X][j][1] = p_[1]; } \
            else { pre[X][j][0] = (u32x4){0u, 0u, 0u, 0u}; pre[X][j][1] = (u32x4){0u, 0u, 0u, 0u}; } } } while (0)
    if (wave == 0) GP_STEP0(GP_ITEM(0), GCB);
    GP_LOADPRE(GP_ITEM(0));
    lds_barrier();
    for (int k = 0; k < 16; ++k) {
    const int item = GP_ITEM(k);
    { unsigned zoff = 0; asm volatile("" : "+s"(zoff)); lds += zoff; tid += zoff; lane += zoff; }
    const int n = item & 63, b = item >> 9; const int t0 = n * 64; const long m0 = (long)b * T + t0;
    LAS bf16_t* KN = (LAS bf16_t*)lds;
    LAS bf16_t* QN = (LAS bf16_t*)(lds + 17408);
    LAS bf16_t* KBGT = (LAS bf16_t*)(lds + 34816);
    LAS bf16_t* VBT = (LAS bf16_t*)(lds + 53248);
    LAS bf16_t* KTT = (LAS bf16_t*)(lds + 71680);
    LAS bf16_t* TM = (LAS bf16_t*)(lds + 90112);
    LAS float* AM = (LAS float*)(lds + 99328);
    LAS bf16_t* AB = (LAS bf16_t*)(lds + 117760);
    LAS bf16_t* T11T = (LAS bf16_t*)(lds + 120320);
    LAS float* GC = (LAS float*)(lds + ((k & 1) ? 129024 : 116736));
    LAS float* BT = GC + 64; LAS float* EG = GC + 128; LAS float* EK = GC + 192;
    unsigned char* gp = gprep + (size_t)item * GP_BYTES;
    {
        const int i = tid >> 3, d0 = (tid & 7) * 16;
        const float bti = BT[i], egi = EG[i], eki = EK[i];
#pragma unroll
        for (int X = 0; X < 3; ++X) {
            float val[16];
#pragma unroll
            for (int e = 0; e < 16; ++e) val[e] = 0.f;
#pragma unroll
            for (int j = 0; j < 4; ++j) {
                float in[16]; unpack8(pre[X][j][0], in); unpack8(pre[X][j][1], in + 8);
                const LAS f32x4* wp = (const LAS f32x4*)(CW + (X * 4 + j) * 128 + d0);
#pragma unroll
                for (int q = 0; q < 4; ++q) { const f32x4 w = wp[q]; val[4 * q + 0] += in[4 * q + 0] * w[0]; val[4 * q + 1] += in[4 * q + 1] * w[1]; val[4 * q + 2] += in[4 * q + 2] * w[2]; val[4 * q + 3] += in[4 * q + 3] * w[3]; }
            }
            float ss = 0.f;
#pragma unroll
            for (int e = 0; e < 16; ++e) { val[e] = silu_f(val[e]); ss += val[e] * val[e]; }
            if (X < 2) {
                ss += __shfl_xor(ss, 1); ss += __shfl_xor(ss, 2); ss += __shfl_xor(ss, 4);
                const float rn = rsqrtf(ss + 1e-6f) * (X == 0 ? QK_SCALE : 1.f);
#pragma unroll
                for (int e = 0; e < 16; ++e) val[e] *= rn;
            }
            if (X == 0) {
                *(LAS u32x4*)(QN + i * 136 + d0) = pack8(val); *(LAS u32x4*)(QN + i * 136 + d0 + 8) = pack8(val + 8);
                float qe[16];
#pragma unroll
                for (int e = 0; e < 16; ++e) qe[e] = val[e] * egi;
                bf16_t* qg = (bf16_t*)(gp + GP_QE) + i * 128 + (d0 & ~31) + ((d0 & 16) >> 2);
#pragma unroll
                for (int gq = 0; gq < 4; ++gq) { u32x2 w; w.x = pk2(qe[4 * gq], qe[4 * gq + 1]); w.y = pk2(qe[4 * gq + 2], qe[4 * gq + 3]); *(u32x2*)(qg + 8 * gq) = w; }
            } else if (X == 1) {
                *(LAS u32x4*)(KN + i * 136 + d0) = pack8(val); *(LAS u32x4*)(KN + i * 136 + d0 + 8) = pack8(val + 8);
#pragma unroll
                for (int e = 0; e < 16; ++e) { KBGT[(d0 + e) * 72 + i] = (bf16_t)f2bf(val[e] * bti * egi); KTT[(d0 + e) * 72 + kpos(i)] = (bf16_t)f2bf(val[e] * eki); }
            } else {
#pragma unroll
                for (int e = 0; e < 16; ++e) VBT[(d0 + e) * 72 + i] = (bf16_t)f2bf(val[e] * bti);
            }
        }
    }
    lds_barrier();
    {
        const int c = lane & 15, g = lane >> 4;
        bf16_t* at = (bf16_t*)(gp + GP_AT);
#pragma unroll
        for (int rep = 0; rep < 2; ++rep) {
            const int tt = wave + 8 * rep, ti = tt >> 2, tj = tt & 3;
            f32x4 a1 = {0.f, 0.f, 0.f, 0.f}, a2 = {0.f, 0.f, 0.f, 0.f};
            if (tj <= ti) { mma_nt<4>(a1, KN + 16 * ti * 136, 136, KN + 16 * tj * 136, 136, lane); mma_nt<4>(a2, QN + 16 * ti * 136, 136, KN + 16 * tj * 136, 136, lane); }
            const int j = 16 * tj + c; const float gcj = GC[j];
            const f32x4 gci = *(const LAS f32x4*)(GC + 16 * ti + 4 * g), bti4 = *(const LAS f32x4*)(BT + 16 * ti + 4 * g);
            f32x4 av;
#pragma unroll
            for (int rr = 0; rr < 4; ++rr) {
                const int i = 16 * ti + 4 * g + rr;
                const float dec = (i >= j) ? __expf(gci[rr] - gcj) : 0.f;
                const float aij = (i > j) ? a1[rr] * bti4[rr] * dec : 0.f;
                av[rr] = aij;
                if (ti >= 2 && tj < 2) AB[(i - 32) * 40 + j] = (bf16_t)f2bf(aij);
                at[i * 64 + kpos(j)] = (bf16_t)f2bf((i >= j) ? a2[rr] * dec : 0.f);
            }
            *(LAS f32x4*)(AM + j * 68 + 16 * ti + 4 * g) = av;
        }
    }
    lds_barrier();
    if (k + 1 < 16) {
        GP_LOADPRE(GP_ITEM(k + 1));
        if (wave == 1) { LAS float* GCn = (k & 1) ? GCB : (LAS float*)(lds + 129024); GP_STEP0(GP_ITEM(k + 1), GCn); }
    }
    if (wave == 0) {
        const int half = lane >> 5, cl = lane & 31, c = lane & 15, g = lane >> 4;
        const LAS float* Ab = AM + (32 * half) * 68 + 32 * half;
        float sv[32];
#pragma unroll
        for (int i = 0; i < 32; ++i) sv[i] = (cl == i) ? 1.f : 0.f;
        f32x4 ca[8], cb[8];
#define SV_LD(dst, j) do { _Pragma("unroll") for (int q = ((j) + 1) / 4; q < 8; ++q) dst[q] = *(const LAS f32x4*)(Ab + (j) * 68 + 4 * q); asm volatile("" ::: "memory"); } while (0)
#define SV_FM(src, j) do { const float tj = sv[j]; _Pragma("unroll") for (int q = ((j) + 1) / 4; q < 8; ++q) _Pragma("unroll") for (int e = 0; e < 4; ++e) if (4 * q + e > (j)) sv[4 * q + e] -= src[q][e] * tj; \
        asm volatile("" : "+v"(sv[0]), "+v"(sv[1]), "+v"(sv[2]), "+v"(sv[3]), "+v"(sv[4]), "+v"(sv[5]), "+v"(sv[6]), "+v"(sv[7]), "+v"(sv[8]), "+v"(sv[9]), "+v"(sv[10]), "+v"(sv[11]), "+v"(sv[12]), "+v"(sv[13]), "+v"(sv[14]), "+v"(sv[15]) :: "memory"); \
        asm volatile("" : "+v"(sv[16]), "+v"(sv[17]), "+v"(sv[18]), "+v"(sv[19]), "+v"(sv[20]), "+v"(sv[21]), "+v"(sv[22]), "+v"(sv[23]), "+v"(sv[24]), "+v"(sv[25]), "+v"(sv[26]), "+v"(sv[27]), "+v"(sv[28]), "+v"(sv[29]), "+v"(sv[30]), "+v"(sv[31]) :: "memory"); } while (0)
        SV_LD(ca, 0);
#pragma unroll
        for (int j = 0; j < 30; j += 2) {
            SV_LD(cb, j + 1); SV_FM(ca, j);
            SV_LD(ca, j + 2); SV_FM(cb, j + 1);
        }
        SV_FM(ca, 30);
#undef SV_LD
#undef SV_FM
#pragma unroll
        for (int i = 0; i < 32; ++i) TM[(32 * half + i) * 72 + 32 * half + cl] = (bf16_t)f2bf(sv[i]);
        if (half == 0) {
#pragma unroll
            for (int i = 0; i < 32; ++i) TM[i * 72 + 32 + cl] = (bf16_t)0;
#pragma unroll
            for (int q = 0; q < 4; ++q) { u32x4 w; w.x = pk2(sv[8 * q], sv[8 * q + 1]); w.y = pk2(sv[8 * q + 2], sv[8 * q + 3]); w.z = pk2(sv[8 * q + 4], sv[8 * q + 5]); w.w = pk2(sv[8 * q + 6], sv[8 * q + 7]); *(LAS u32x4*)(T11T + cl * 40 + 8 * q) = w; }
        }
        asm volatile("s_waitcnt lgkmcnt(0)" ::: "memory");
        f32x4 X[2][2];
#pragma unroll
        for (int t2 = 0; t2 < 2; ++t2)
#pragma unroll
            for (int tc = 0; tc < 2; ++tc) { X[t2][tc] = (f32x4){0.f, 0.f, 0.f, 0.f}; mma_nt<1>(X[t2][tc], AB + 16 * t2 * 40, 40, T11T + 16 * tc * 40, 40, lane); }
#pragma unroll
        for (int t2 = 0; t2 < 2; ++t2) {
            const LAS bf16_t* trow = TM + (32 + 16 * t2 + c) * 72 + 32 + 4 * g;
            const u32x2 lo = *(const LAS u32x2*)trow, hi = *(const LAS u32x2*)(trow + 16);
            const bf16x8 af = __builtin_bit_cast(bf16x8, (u32x4){lo.x, lo.y, hi.x, hi.y});
#pragma unroll
            for (int tc = 0; tc < 2; ++tc) {
                f32x4 acc = {0.f, 0.f, 0.f, 0.f};
                acc = __builtin_amdgcn_mfma_f32_16x16x32_bf16(af, pack_tiles(X[0][tc], X[1][tc]), acc, 0, 0, 0);
#pragma unroll
                for (int rr = 0; rr < 4; ++rr) TM[(32 + 16 * t2 + 4 * g + rr) * 72 + 16 * tc + c] = (bf16_t)f2bf(-acc[rr]);
            }
        }
    }
    lds_barrier();
    {
        const int c = lane & 15, g = lane >> 4;
#pragma unroll
        for (int rep = 0; rep < 8; ++rep) {
            const int tt = wave * 8 + rep;
            f32x4 acc = {0.f, 0.f, 0.f, 0.f};
            if (tt < 32) {
                const int ti = tt >> 3, te = tt & 7;
                mma_nt<2>(acc, TM + 16 * ti * 72, 72, VBT + 16 * te * 72, 72, lane);
                u32x2 w; w.x = pk2(acc[0], acc[1]); w.y = pk2(acc[2], acc[3]);
                *(u32x2*)((bf16_t*)(gp + GP_UT) + (16 * te + c) * 64 + 16 * ti + 4 * g) = w;
            } else {
                const int t2 = tt - 32, ti = t2 >> 3, td = t2 & 7;
                mma_nt<2>(acc, KBGT + 16 * td * 72, 72, TM + 16 * ti * 72, 72, lane);
                u32x2 w; w.x = pk2(acc[0], acc[1]); w.y = pk2(acc[2], acc[3]);
                *(u32x2*)((bf16_t*)(gp + GP_W) + (16 * ti + c) * 128 + kpos(16 * td + 4 * g)) = w;
            }
        }
#pragma unroll
        for (int u = 0; u < 2; ++u) { const int q = tid + NTHR * u, d = q >> 3, part = q & 7; *(u32x4*)(gp + GP_KT + (size_t)q * 16) = *(const LAS u32x4*)(KTT + d * 72 + part * 8); }
    }
    lds_barrier();
    }
#undef GP_ITEM
#undef GP_STEP0
#undef GP_LOADPRE
}

__device__ __forceinline__ void ret_kv_item(LAS unsigned char* lds, int item, const bf16_t* proj, float* KV, int tid, int lane, int wave) {
    const int n = item & 31, bh = item >> 5, h = bh & 3, b = bh >> 2;
    const int t0 = n * 128; const size_t m0 = (size_t)b * T + t0;
    LAS bf16_t* VT = (LAS bf16_t*)lds;
    LAS bf16_t* KDT = (LAS bf16_t*)(lds + 69632);
    const float lg = __logf(1.f - exp2f(-5.f - (float)h));
    {
        const int j = tid >> 2, part = tid & 3, d0 = 16 * part;
        const bf16_t* kp = proj + (m0 + j) * NC + C_RK + h * 128 + d0;
        float lo[16], hi[16];
        unpack8(((const u32x4*)kp)[0], lo); unpack8(((const u32x4*)kp)[1], lo + 8); unpack8(((const u32x4*)(kp + 64))[0], hi); unpack8(((const u32x4*)(kp + 64))[1], hi + 8);
        rot16(lo, hi, t0 + j, d0);
        const float kdec = __expf(lg * (float)(127 - j)) * QK_SCALE;
#pragma unroll
        for (int e = 0; e < 16; ++e) { KDT[(d0 + e) * 136 + j] = (bf16_t)f2bf(lo[e] * kdec); KDT[(64 + d0 + e) * 136 + j] = (bf16_t)f2bf(hi[e] * kdec); }
        const int e0 = 64 * part;
        const u32x4* vp = (const u32x4*)(proj + (m0 + j) * NC + C_RV + h * 256 + e0);
#pragma unroll
        for (int q = 0; q < 8; ++q) { const u32x4 w = vp[q]; const unsigned ww[4] = {w.x, w.y, w.z, w.w};
#pragma unroll
            for (int p = 0; p < 4; ++p) { VT[(e0 + 8 * q + 2 * p) * 136 + j] = (bf16_t)(ww[p] & 0xffffu); VT[(e0 + 8 * q + 2 * p + 1) * 136 + j] = (bf16_t)(ww[p] >> 16); } }
    }
    lds_barrier();
    {
        const int c = lane & 15, g = lane >> 4;
        bf16_t* kv = (bf16_t*)KV + (size_t)item * 32768;
#pragma unroll
        for (int r2 = 0; r2 < 2; ++r2) {
            const int te = 2 * wave + r2;
#pragma unroll
            for (int td = 0; td < 8; ++td) {
                f32x4 acc = {0.f, 0.f, 0.f, 0.f};
                mma_nt<4>(acc, KDT + 16 * td * 136, 136, VT + 16 * te * 136, 136, lane);
                u32x2 w; w.x = pk2(acc[0], acc[1]); w.y = pk2(acc[2], acc[3]);
                *(u32x2*)(kv + (16 * te + c) * 128 + 16 * td + 4 * g) = w;
            }
        }
    }
    lds_barrier();
}

constexpr int SC_UT = 62464, SC_GL = 67072, SC_BUF = 67088;
__device__ __forceinline__ void gdn_scan_task(LAS unsigned char* lds, int s, int slice, const unsigned char* gprep, const float* glv, bf16_t* mixed, float* KV, int rs_blk, int tid, int lane, int wave) {
    const int b = s >> 3, h = s & 7;
    const int c = lane & 15, g = lane >> 4, e0 = 32 * slice + 16 * (wave & 1);
    u32x4 SU[8]; bf16x8 Sb[4];
#pragma unroll
    for (int td = 0; td < 8; ++td) SU[td] = (u32x4){0u, 0u, 0u, 0u};
#pragma unroll
    for (int q = 0; q < 4; ++q) Sb[q] = (bf16x8){0, 0, 0, 0, 0, 0, 0, 0};
    u32x4 pf[8];
    const unsigned char* gp0 = gprep + (size_t)(s * 64) * GP_BYTES;
#define SC_LOAD(gq) do { _Pragma("unroll") for (int u = 0; u < 2; ++u) { pf[u] = *(const u32x4*)((gq) + GP_W + (size_t)(tid + NTHR * u) * 16); pf[2 + u] = *(const u32x4*)((gq) + GP_QE + (size_t)(tid + NTHR * u) * 16); \
        pf[5 + u] = *(const u32x4*)((gq) + GP_KT + (size_t)(tid + NTHR * u) * 16); } pf[4] = *(const u32x4*)((gq) + GP_AT + (size_t)tid * 16); \
        if (tid >= 256) pf[7] = *(const u32x4*)((gq) + GP_UT + (size_t)(32 * slice + ((tid - 256) >> 3)) * 128 + ((tid - 256) & 7) * 16); } while (0)
#define SC_STORE(bufp, itm) do { if (tid >= 256) *(LAS u32x4*)((bufp) + SC_UT + ((tid - 256) >> 3) * 144 + ((tid - 256) & 7) * 16) = pf[7]; if (tid == 255) *(LAS float*)((bufp) + SC_GL) = glv[itm]; \
        _Pragma("unroll") for (int u = 0; u < 2; ++u) { const int q = tid + NTHR * u; \
        *(LAS u32x4*)((LAS bf16_t*)(bufp) + (q >> 4) * 136 + (q & 15) * 8) = pf[u]; *(LAS u32x4*)((LAS bf16_t*)((bufp) + 17408) + (q >> 4) * 136 + (q & 15) * 8) = pf[2 + u]; \
        *(LAS u32x4*)((LAS bf16_t*)((bufp) + 44032) + (q >> 3) * 72 + (q & 7) * 8) = pf[5 + u]; } \
        *(LAS u32x4*)((LAS bf16_t*)((bufp) + 34816) + (tid >> 3) * 72 + (tid & 7) * 8) = pf[4]; } while (0)
    SC_LOAD(gp0); SC_STORE(lds, s * 64); SC_LOAD(gp0 + GP_BYTES);
    lds_barrier();
    for (int n = 0; n < 64; ++n) {
        LAS unsigned char* cur = lds + (n & 1) * SC_BUF; LAS unsigned char* nxt = lds + ((n + 1) & 1) * SC_BUF;
        const unsigned char* gp = gp0 + (size_t)n * GP_BYTES;
        if (n >= 1 && tid >= 128 && tid < 384) {
            const int u = tid - 128;
            const LAS bf16_t* OLp = (const LAS bf16_t*)(lds + 2 * SC_BUF + ((n - 1) & 1) * 5120);
            *(u32x4*)(mixed + ((size_t)b * T + (n - 1) * 64 + (u >> 2)) * D + 1024 + h * 128 + 32 * slice + (u & 3) * 8) = *(const LAS u32x4*)(OLp + (u >> 2) * 40 + (u & 3) * 8);
        }
        if (n + 1 < 64) SC_STORE(nxt, s * 64 + n + 1);
        if (n + 2 < 64) SC_LOAD(gp + 2 * GP_BYTES);
        if (wave >= 2 && rs_blk >= 0 && n < 7) {
            const int u = tid - 128;
            if (n >= 1 && (n - 1) * 384 + u < 2048) {
                const int cp = rs_blk * 2048 + (n - 1) * 384 + u, stream = cp >> 14;
                const float dec = __expf(128.f * __logf(1.f - exp2f(-5.f - (float)(stream & 3))));
                unsigned* p = (unsigned*)((bf16_t*)KV + (size_t)stream * 32 * 32768) + (cp & 16383);
                float st0 = 0.f, st1 = 0.f;
#pragma unroll
                for (int i = 0; i < 32; ++i) { const unsigned w = SU[i >> 2][i & 3]; p[(size_t)i * 16384] = pk2(st0, st1); st0 = st0 * dec + bflo(w); st1 = st1 * dec + bfhi(w); }
            }
            if (n < 6 && n * 384 + u < 2048) {
                const int cp = rs_blk * 2048 + n * 384 + u, stream = cp >> 14;
                const unsigned* p = (const unsigned*)((const bf16_t*)KV + (size_t)stream * 32 * 32768) + (cp & 16383);
#pragma unroll
                for (int i = 0; i < 32; ++i) SU[i >> 2][i & 3] = p[(size_t)i * 16384];
            }
        }
        if (wave < 2) {
            const LAS bf16_t* WL = (const LAS bf16_t*)cur; const LAS bf16_t* QE = (const LAS bf16_t*)(cur + 17408); const LAS bf16_t* AT = (const LAS bf16_t*)(cur + 34816); const LAS bf16_t* KT = (const LAS bf16_t*)(cur + 44032);
            const size_t m0 = (size_t)b * T + n * 64;
            const float gl = *(const LAS float*)(cur + SC_GL);
#define SC_SB __builtin_amdgcn_sched_barrier(0)
#define SC_LDP(dst, ti) do { _Pragma("unroll") for (int q = 0; q < 4; ++q) { dst[q] = *(const LAS bf16x8*)(WL + (16 * (ti) + c) * 136 + 32 * q + 8 * g); dst[4 + q] = *(const LAS bf16x8*)(QE + (16 * (ti) + c) * 136 + 32 * q + 8 * g); } } while (0)
#define SC_MMP(src, ti) do { _Pragma("unroll") for (int q = 0; q < 4; ++q) { P[ti] = __builtin_amdgcn_mfma_f32_16x16x32_bf16(src[q], Sb[q], P[ti], 0, 0, 0); O[ti] = __builtin_amdgcn_mfma_f32_16x16x32_bf16(src[4 + q], Sb[q], O[ti], 0, 0, 0); } } while (0)
#define SC_LDK(dst, t0) do { _Pragma("unroll") for (int t = 0; t < 4; ++t) _Pragma("unroll") for (int q = 0; q < 2; ++q) dst[2 * t + q] = *(const LAS bf16x8*)(KT + (16 * ((t0) + t) + c) * 72 + 32 * q + 8 * g); } while (0)
#define SC_MMK(src, t0) do { _Pragma("unroll") for (int t = 0; t < 4; ++t) { f32x4 a = __builtin_bit_cast(f32x4, SU[(t0) + t]) * gl; _Pragma("unroll") for (int q = 0; q < 2; ++q) a = __builtin_amdgcn_mfma_f32_16x16x32_bf16(src[2 * t + q], Vb[q], a, 0, 0, 0); SU[(t0) + t] = __builtin_bit_cast(u32x4, a); } } while (0)
            f32x4 P[4], O[4];
#pragma unroll
            for (int ti = 0; ti < 4; ++ti) { P[ti] = (f32x4){0.f, 0.f, 0.f, 0.f}; O[ti] = (f32x4){0.f, 0.f, 0.f, 0.f}; }
            bf16x8 fa[8], fb[8];
            SC_LDP(fa, 0);
            SC_LDP(fb, 1); SC_SB; SC_MMP(fa, 0); SC_SB;
            SC_LDP(fa, 2); SC_SB; SC_MMP(fb, 1); SC_SB;
            SC_LDP(fb, 3); SC_SB; SC_MMP(fa, 2); SC_SB;
#pragma unroll
            for (int ti = 0; ti < 4; ++ti)
#pragma unroll
                for (int q = 0; q < 2; ++q) fa[2 * ti + q] = *(const LAS bf16x8*)(AT + (16 * ti + c) * 72 + 32 * q + 8 * g);
            SC_SB; SC_MMP(fb, 3); SC_SB;
            u32x2 ut[4];
#pragma unroll
            for (int ti = 0; ti < 4; ++ti) ut[ti] = *(const LAS u32x2*)((const LAS bf16_t*)(cur + SC_UT) + (16 * (wave & 1) + c) * 72 + 16 * ti + 4 * g);
            f32x4 vn[4];
#pragma unroll
            for (int ti = 0; ti < 4; ++ti) vn[ti] = (f32x4){bflo(ut[ti].x) - P[ti][0], bfhi(ut[ti].x) - P[ti][1], bflo(ut[ti].y) - P[ti][2], bfhi(ut[ti].y) - P[ti][3]};
            bf16x8 Vb[2];
            Vb[0] = pack_tiles(vn[0], vn[1]); Vb[1] = pack_tiles(vn[2], vn[3]);
            SC_LDK(fb, 0); SC_SB;
#pragma unroll
            for (int ti = 0; ti < 4; ++ti)
#pragma unroll
                for (int q = 0; q < 2; ++q) O[ti] = __builtin_amdgcn_mfma_f32_16x16x32_bf16(fa[2 * ti + q], Vb[q], O[ti], 0, 0, 0);
            SC_SB;
            SC_LDK(fa, 4); SC_SB; SC_MMK(fb, 0); SC_SB;
            SC_MMK(fa, 4);
#undef SC_SB
#undef SC_LDP
#undef SC_MMP
#undef SC_LDK
#undef SC_MMK
#pragma unroll
            for (int q = 0; q < 4; ++q) Sb[q] = pack_tiles(__builtin_bit_cast(f32x4, SU[2 * q]), __builtin_bit_cast(f32x4, SU[2 * q + 1]));
            LAS bf16_t* OL = (LAS bf16_t*)(lds + 2 * SC_BUF + (n & 1) * 5120) + (4 * g) * 40 + 16 * (wave & 1) + c;
#pragma unroll
            for (int ti = 0; ti < 4; ++ti)
#pragma unroll
                for (int rr = 0; rr < 4; ++rr) OL[(16 * ti + rr) * 40] = (bf16_t)f2bf(O[ti][rr]);
        }
        lds_barrier();
    }
    if (tid >= 128 && tid < 384) {
        const int u = tid - 128;
        const LAS bf16_t* OLp = (const LAS bf16_t*)(lds + 2 * SC_BUF + 5120);
        *(u32x4*)(mixed + ((size_t)b * T + 63 * 64 + (u >> 2)) * D + 1024 + h * 128 + 32 * slice + (u & 3) * 8) = *(const LAS u32x4*)(OLp + (u >> 2) * 40 + (u & 3) * 8);
    }
    lds_barrier();
#undef SC_LOAD
#undef SC_STORE
}
__device__ __forceinline__ void gdn_norm_rows(const bf16_t* proj, const float* norm_w, bf16_t* mixed, int lane, int wave, int G) {
    const int gw = blockIdx.x * NWAVES + wave, NGW = G * NWAVES;
    float nw[16];
#pragma unroll
    for (int q = 0; q < 4; ++q) { const f32x4 w = *(const f32x4*)(norm_w + (lane & 7) * 16 + 4 * q); nw[4 * q] = w[0]; nw[4 * q + 1] = w[1]; nw[4 * q + 2] = w[2]; nw[4 * q + 3] = w[3]; }
    for (int m = gw; m < M; m += NGW) {
        bf16_t* op = mixed + (size_t)m * D + 1024 + lane * 16;
        const bf16_t* gq = proj + (size_t)m * NC + C_GG + lane * 16;
        float o[16], gg[16];
        unpack8(((const u32x4*)op)[0], o); unpack8(((const u32x4*)op)[1], o + 8); unpack8(__builtin_nontemporal_load((const u32x4*)gq), gg); unpack8(__builtin_nontemporal_load((const u32x4*)gq + 1), gg + 8);
        float ss = 0.f;
#pragma unroll
        for (int e = 0; e < 16; ++e) ss += o[e] * o[e];
        ss += __shfl_xor(ss, 1); ss += __shfl_xor(ss, 2); ss += __shfl_xor(ss, 4);
        const float rstd = rsqrtf(ss * (1.f / 128.f) + 1e-6f);
#pragma unroll
        for (int e = 0; e < 16; ++e) o[e] = o[e] * rstd * nw[e] * silu_f(gg[e]);
        ((u32x4*)op)[0] = pack8(o); ((u32x4*)op)[1] = pack8(o + 8);
    }
}

__device__ __forceinline__ void ret_scan(float* KV, float* KVdst, int tid, int first_blk, int G) {
    const long nthreads = (long)(G - first_blk) * NTHR, gid = (long)(blockIdx.x - first_blk) * NTHR + tid;
    for (long cp = gid; cp < 32L * 16384; cp += nthreads) {
        const int stream = (int)(cp >> 14), h = stream & 3;
        const float dec = __expf(128.f * __logf(1.f - exp2f(-5.f - (float)h)));
        const unsigned* p = (const unsigned*)((const bf16_t*)KV + (size_t)stream * 32 * 32768) + (cp & 16383);
        unsigned* pd = (unsigned*)((bf16_t*)KVdst + (size_t)stream * 32 * 32768) + (cp & 16383);
        unsigned kv[32];
#pragma unroll
        for (int n = 0; n < 32; ++n) kv[n] = p[(size_t)n * 16384];
        float st0 = 0.f, st1 = 0.f;
#pragma unroll
        for (int n = 0; n < 32; ++n) { pd[(size_t)n * 16384] = pk2(st0, st1); st0 = st0 * dec + bflo(kv[n]); st1 = st1 * dec + bfhi(kv[n]); }
    }
}

__device__ __forceinline__ void ret_out_item(LAS unsigned char* lds, int item, const bf16_t* proj, const float* KV, const float* gn_w, const float* gn_b, bf16_t* mixed, int tid, int lane, int wave) {
    const int n = item & 31, bh = item >> 5, h = bh & 3, b = bh >> 2;
    const int t0 = n * 128; const size_t m0 = (size_t)b * T + t0;
    LAS bf16_t* QS = (LAS bf16_t*)lds;
    LAS bf16_t* KD = (LAS bf16_t*)(lds + 34816);
    LAS bf16_t* VT = (LAS bf16_t*)(lds + 69632);
    LAS bf16_t* ST = (LAS bf16_t*)(lds + 104448);
    const float lg = __logf(1.f - exp2f(-5.f - (float)h));
    const int c = lane & 15, g = lane >> 4;
    {
        const int j = tid >> 2, part = tid & 3, d0 = 16 * part;
        float lo[16], hi[16];
        const bf16_t* qp = proj + (m0 + j) * NC + C_RQ + h * 128 + d0;
        unpack8(((const u32x4*)qp)[0], lo); unpack8(((const u32x4*)qp)[1], lo + 8); unpack8(((const u32x4*)(qp + 64))[0], hi); unpack8(((const u32x4*)(qp + 64))[1], hi + 8);
        rot16(lo, hi, t0 + j, d0);
        *(LAS u32x4*)(QS + j * 136 + d0) = pack8(lo); *(LAS u32x4*)(QS + j * 136 + d0 + 8) = pack8(lo + 8);
        *(LAS u32x4*)(QS + j * 136 + 64 + d0) = pack8(hi); *(LAS u32x4*)(QS + j * 136 + 64 + d0 + 8) = pack8(hi + 8);
        const bf16_t* kp = proj + (m0 + j) * NC + C_RK + h * 128 + d0;
        unpack8(((const u32x4*)kp)[0], lo); unpack8(((const u32x4*)kp)[1], lo + 8); unpack8(((const u32x4*)(kp + 64))[0], hi); unpack8(((const u32x4*)(kp + 64))[1], hi + 8);
        rot16(lo, hi, t0 + j, d0);
#pragma unroll
        for (int e = 0; e < 16; ++e) { lo[e] *= QK_SCALE; hi[e] *= QK_SCALE; }
        *(LAS u32x4*)(KD + j * 136 + d0) = pack8(lo); *(LAS u32x4*)(KD + j * 136 + d0 + 8) = pack8(lo + 8);
        *(LAS u32x4*)(KD + j * 136 + 64 + d0) = pack8(hi); *(LAS u32x4*)(KD + j * 136 + 64 + d0 + 8) = pack8(hi + 8);
    }
    lds_barrier();
    f32x4 sc[8];
#pragma unroll
    for (int tj = 0; tj < 8; ++tj) { sc[tj] = (f32x4){0.f, 0.f, 0.f, 0.f}; if (tj <= wave) mma_nt<4>(sc[tj], QS + 16 * wave * 136, 136, KD + 16 * tj * 136, 136, lane); }
    lds_barrier();
#pragma unroll
    for (int tj = 0; tj < 8; ++tj) {
        const int j = 16 * tj + c; const float gpw = __expf(-lg * (float)(j + 1));
#pragma unroll
        for (int rr = 0; rr < 4; ++rr) { const int i = 16 * wave + 4 * g + rr; KD[i * 136 + j] = (bf16_t)f2bf((i >= j) ? sc[tj][rr] * gpw : 0.f); }
    }
    f32x4 acc[16];
#pragma unroll
    for (int half = 0; half < 2; ++half) {
        if (half == 1) lds_barrier();
        {
            const int j = tid >> 2, part = tid & 3, e0 = 32 * part;
            const u32x4* vp = (const u32x4*)(proj + (m0 + j) * NC + C_RV + h * 256 + half * 128 + e0);
#pragma unroll
            for (int q = 0; q < 4; ++q) { const u32x4 w = vp[q]; const unsigned ww[4] = {w.x, w.y, w.z, w.w};
#pragma unroll
                for (int p = 0; p < 4; ++p) { VT[(e0 + 8 * q + 2 * p) * 136 + j] = (bf16_t)(ww[p] & 0xffffu); VT[(e0 + 8 * q + 2 * p + 1) * 136 + j] = (bf16_t)(ww[p] >> 16); } }
            const bf16_t* kv = (const bf16_t*)KV + (size_t)item * 32768 + (size_t)half * 128 * 128;
#pragma unroll
            for (int u = 0; u < 4; ++u) { const int q = tid + NTHR * u, e = q >> 4, part = q & 15; *(LAS u32x4*)(ST + e * 136 + part * 8) = *(const u32x4*)(kv + e * 128 + part * 8); }
        }
        lds_barrier();
#pragma unroll
        for (int te = 0; te < 8; ++te) {
            f32x4 a = {0.f, 0.f, 0.f, 0.f};
            mma_nt<4>(a, VT + 16 * te * 136, 136, KD + 16 * wave * 136, 136, lane);
            mma_nt<4>(a, ST + 16 * te * 136, 136, QS + 16 * wave * 136, 136, lane);
            acc[half * 8 + te] = a;
        }
    }
    {
        const int i = 16 * wave + c;
        const float qd = __expf(lg * (float)(i + 1));
        float sm = 0.f;
#pragma unroll
        for (int t = 0; t < 16; ++t) { acc[t] = acc[t] * qd; sm += (acc[t][0] + acc[t][1]) + (acc[t][2] + acc[t][3]); }
        sm += __shfl_xor(sm, 16); sm += __shfl_xor(sm, 32);
        const float mean = sm * (1.f / 256.f);
        float v = 0.f;
#pragma unroll
        for (int t = 0; t < 16; ++t) { acc[t] = acc[t] - mean; v += (acc[t][0] * acc[t][0] + acc[t][1] * acc[t][1]) + (acc[t][2] * acc[t][2] + acc[t][3] * acc[t][3]); }
        v += __shfl_xor(v, 16); v += __shfl_xor(v, 32);
        const float rstd = rsqrtf(v * (1.f / 256.f) + 1e-5f);
        const bf16_t* rg = proj + (m0 + i) * NC + C_RG + h * 256 + 4 * g;
        bf16_t* mo = mixed + (m0 + i) * D + h * 256 + 4 * g;
        const float* gw_ = gn_w + h * 256 + 4 * g; const float* gb_ = gn_b + h * 256 + 4 * g;
#pragma unroll
        for (int t = 0; t < 16; ++t) {
            const u32x2 rgv = *(const u32x2*)(rg + 16 * t);
            const f32x4 w4 = *(const f32x4*)(gw_ + 16 * t), b4 = *(const f32x4*)(gb_ + 16 * t);
            const f32x4 o = acc[t] * rstd * w4 + b4;
            u32x2 w; w.x = pk2(o[0] * silu_f(bflo(rgv.x)), o[1] * silu_f(bfhi(rgv.x))); w.y = pk2(o[2] * silu_f(bflo(rgv.y)), o[3] * silu_f(bfhi(rgv.y)));
            *(u32x2*)(mo + 16 * t) = w;
        }
    }
    lds_barrier();
}

__device__ __forceinline__ void ln_rows(const bf16_t* z, float* dst, const float* ln_w, const float* ln_b, int lane, int wave, int G) {
    const int gw = blockIdx.x * NWAVES + wave, NGW = G * NWAVES;
    for (int m = gw; m < M; m += NGW) {
        const u32x4* zr = (const u32x4*)(z + (size_t)m * D) + lane;
        float v[4][8]; float s = 0.f;
#pragma unroll
        for (int j = 0; j < 4; ++j) { unpack8(__builtin_nontemporal_load(zr + 64 * j), v[j]);
#pragma unroll
            for (int e = 0; e < 8; ++e) s += v[j][e]; }
        const float mean = wave_sum(s) * (1.f / D); float s2 = 0.f;
#pragma unroll
        for (int j = 0; j < 4; ++j)
#pragma unroll
            for (int e = 0; e < 8; ++e) { v[j][e] -= mean; s2 += v[j][e] * v[j][e]; }
        const float rstd = rsqrtf(wave_sum(s2) * (1.f / D) + 1e-5f);
        float* drow = dst + (size_t)m * D + 8 * lane;
#pragma unroll
        for (int j = 0; j < 4; ++j) {
            const f32x4 w0 = *(const f32x4*)(ln_w + 8 * lane + 512 * j), w1 = *(const f32x4*)(ln_w + 8 * lane + 512 * j + 4);
            const f32x4 b0 = *(const f32x4*)(ln_b + 8 * lane + 512 * j), b1 = *(const f32x4*)(ln_b + 8 * lane + 512 * j + 4);
            __builtin_nontemporal_store((f32x4){v[j][0], v[j][1], v[j][2], v[j][3]} * rstd * w0 + b0, (f32x4*)(drow + 512 * j));
            __builtin_nontemporal_store((f32x4){v[j][4], v[j][5], v[j][6], v[j][7]} * rstd * w1 + b1, (f32x4*)(drow + 512 * j + 4));
        }
    }
}

#ifndef MK_N_LAUNCHES
#define MK_N_LAUNCHES 1
#endif
constexpr int N_PHASES = 8;
constexpr size_t WS_CTL = 3 * MiB + 512 * 1024; constexpr int CTL_BYTES = 16384;
#define XB_TMO      128
#define XB_XCNT(j)  (256  + 64 * (j))
#define XB_XSUB(j)  (1280 + 64 * (j))
#define XB_XGEN(j)  (2304 + 64 * (j))
#define XB_TOP      3328
#define XB_TOPGEN   3392
#define XCD_BAR_WORDS 3456
#define XB_SPIN_CAP (1u << 18)

__device__ __forceinline__ unsigned xb_ld(unsigned* p)              { return __hip_atomic_load(p, __ATOMIC_RELAXED, __HIP_MEMORY_SCOPE_AGENT); }
__device__ __forceinline__ unsigned xb_add(unsigned* p, unsigned v) { return __hip_atomic_fetch_add(p, v, __ATOMIC_RELAXED, __HIP_MEMORY_SCOPE_AGENT); }
__device__ __forceinline__ unsigned xb_xcc_id() { return (unsigned)__builtin_amdgcn_s_getreg((3 << 11) | 20) & 0xFu; }
#define XB_SPIN(cond, bar) do { unsigned _sp = 0; while (cond) { __builtin_amdgcn_s_sleep(1); \
    if ((++_sp & 255u) == 0u) { if (xb_ld(&(bar)[XB_TMO])) break; if (_sp > XB_SPIN_CAP) { atomicAdd(&(bar)[XB_TMO], 1u); break; } } } } while (0)

struct XcdBarrier {
    unsigned* bar; unsigned x;
    volatile LAS unsigned* st;
};

__device__ __forceinline__ XcdBarrier xcd_barrier_post(unsigned* bar, volatile LAS unsigned* st) {
    XcdBarrier b; b.bar = bar; b.x = xb_xcc_id(); b.st = st;
    if (threadIdx.x == 0) (void)xb_add(&bar[XB_XCNT(b.x)], 1u);
    return b;
}
__device__ __forceinline__ void xcd_barrier_complete(unsigned* bar, unsigned x, unsigned& nloc, unsigned& nx) {
    const unsigned G = gridDim.x * gridDim.y * gridDim.z;
    unsigned sum, cnt, mine, sp = 0u;
    for (;;) {
        sum = 0u; cnt = 0u; mine = 0u;
#pragma unroll
        for (unsigned j = 0; j < 16; ++j) { const unsigned c = xb_ld(&bar[XB_XCNT(j)]); sum += c; cnt += (c > 0u) ? 1u : 0u; mine = (j == x) ? c : mine; }
        if (sum == G) break;
        __builtin_amdgcn_s_sleep(1);
        if ((++sp & 255u) == 0u) { if (xb_ld(&bar[XB_TMO])) break; if (sp > XB_SPIN_CAP) { atomicAdd(&bar[XB_TMO], 1u); break; } }
    }
    nloc = mine > 0u ? mine : 1u; nx = cnt > 0u ? cnt : 1u;
}

__device__ __forceinline__ void xcd_barrier(const XcdBarrier& b) {
    asm volatile("s_waitcnt vmcnt(0)" ::: "memory");
    __syncthreads();
    if (threadIdx.x == 0) {
        unsigned* bar = b.bar;
        __builtin_amdgcn_s_waitcnt(0);
        unsigned nloc = b.st[0], nx = b.st[1];
        if (nloc == 0u) { xcd_barrier_complete(bar, b.x, nloc, nx); b.st[0] = nloc; b.st[1] = nx; }
        const unsigned old = xb_add(&bar[XB_XSUB(b.x)], 1u);
        const unsigned gen = old / nloc;
        if (old + 1u == (gen + 1u) * nloc) {
            __builtin_amdgcn_fence(__ATOMIC_RELEASE, "agent");
            asm volatile("s_waitcnt vmcnt(0)" ::: "memory");
            const unsigned og = xb_add(&bar[XB_TOP], 1u);
            const unsigned tg = og / nx;
            if (og + 1u == (tg + 1u) * nx) xb_add(&bar[XB_TOPGEN], 1u);
            else XB_SPIN(xb_ld(&bar[XB_TOPGEN]) == tg, bar);
            __builtin_amdgcn_fence(__ATOMIC_ACQUIRE, "agent");
            xb_add(&bar[XB_XGEN(b.x)], 1u);
            asm volatile("s_waitcnt vmcnt(0)" ::: "memory");
        } else {
            XB_SPIN(xb_ld(&bar[XB_XGEN(b.x)]) == gen, bar);
            __builtin_amdgcn_fence(__ATOMIC_ACQUIRE, "agent");
            asm volatile("s_waitcnt vmcnt(0)" ::: "memory");
        }
    }
    __syncthreads();
}

struct Args { const float* in[14]; float* out; unsigned char* ws; int ph_lo, ph_hi, nsync, pad; };
__global__ void __launch_bounds__(NTHR) hybrid_fwd(Args args) {
    extern __shared__ __attribute__((aligned(16))) unsigned char lds_raw[];
    LAS unsigned char* lds = (LAS unsigned char*)lds_raw;
    cg::grid_group grid = cg::this_grid();
    const int tid = threadIdx.x, lane = tid & 63, wave = __builtin_amdgcn_readfirstlane(tid >> 6), G = gridDim.x;
    const float* x = args.in[0]; const float* cvec = args.in[1]; const float* w_ada = args.in[2]; const float* b_ada = args.in[3]; const float* w_in = args.in[4];
    const float* conv_w = args.in[5]; const float* a_log = args.in[6]; const float* dt_bias = args.in[7]; const float* gn_w = args.in[8]; const float* gn_b = args.in[9];
    const float* norm_w = args.in[10]; const float* w_out = args.in[11]; const float* ln_w = args.in[12]; const float* ln_b = args.in[13];
    unsigned char* ws = args.ws; float* out = args.out;
    float* mod = (float*)(ws + WS_MOD); float* gdec = (float*)(ws + WS_G); float* beta = (float*)(ws + WS_BETA); float* glv = (float*)(ws + WS_GL);
    bf16_t* WoutT = (bf16_t*)(ws + WS_WOUT); bf16_t* WinT = (bf16_t*)(ws + WS_WIN); bf16_t* hin = (bf16_t*)(ws + WS_HIN); bf16_t* mixed = hin;
    bf16_t* proj = (bf16_t*)(ws + WS_PROJ); unsigned char* gprep = ws + WS_GPREP; float* KV = out;
    const int lo = args.ph_lo, hi = args.ph_hi;
#define IN(k) (lo <= (k) && (k) < hi)
#define SEAM(k) do { if (IN(k) && IN((k) + 1)) xcd_barrier(bar); } while (0)

    volatile LAS unsigned* bst = (volatile LAS unsigned*)(lds + LDS_BYTES - 16);
    if (tid == 0) { bst[0] = 0u; bst[1] = 0u; }
    __syncthreads();
    XcdBarrier bar = xcd_barrier_post((unsigned*)(ws + WS_CTL), bst);
    for (int i = 0; i < args.nsync; ++i) grid.sync();
    if (IN(0)) p0_phase(lds, cvec, w_ada, b_ada, w_in, w_out, mod, WinT, WoutT, tid, lane, wave, G, 1);
    SEAM(0);
    if (IN(1)) p1_phase(lds, x, w_in, mod, a_log, dt_bias, hin, gdec, beta, tid, lane, wave, G, 1);
    SEAM(1);
    if (IN(2)) {
        pg8::Gemm g{hin, WinT, M, NC, D}; pg8::StaticOrder S; S.init(M, NC, G, (int)blockIdx.x, 1);
        pg8::EpiBf16 E{proj, NC};
        pg8::gemm_phase<pg8::EpiBf16, pg8::StaticOrder, true, true>(lds, g, S, E);
    }
    SEAM(2);
    if (IN(3)) {
        for (int v = blockIdx.x; v < 256; v += G) gdn_prep_block(lds, v & 255, proj, conv_w, gdec, beta, gprep, glv, tid, lane, wave);
        for (int it = blockIdx.x; it < 1024; it += G) ret_kv_item(lds, it & 1023, proj, KV, tid, lane, wave);
    }
    SEAM(3);
    if (IN(4)) {
        const bool fuse = (G == 256);
        for (int task = blockIdx.x; task < 256; task += G) { const int tk = task & 255, xcd = tk & 7, loc = tk >> 3; gdn_scan_task(lds, xcd * 8 + (loc >> 2), loc & 3, gprep, glv, mixed, KV, (fuse && task < 256) ? tk : -1, tid, lane, wave); }
        if (!fuse) ret_scan(KV, KV, tid, 0, G);
    }
    SEAM(4);
    if (IN(5)) { gdn_norm_rows(proj, norm_w, mixed, lane, wave, G);
        for (int it = blockIdx.x; it < 1024; it += G) ret_out_item(lds, it & 1023, proj, KV, gn_w, gn_b, mixed, tid, lane, wave); }
    SEAM(5);
    if (IN(6)) {
        pg8::Gemm g{mixed, WoutT, M, D, D}; pg8::StaticOrder S; S.init(M, D, G, (int)blockIdx.x, 1);
        pg8::EpiZ16 E{x, mod + 4096, (bf16_t*)(ws + WS_PROJ), 1.189207115002721f};
        pg8::gemm_phase<pg8::EpiZ16, pg8::StaticOrder, true, true>(lds, g, S, E);
    }
    SEAM(6);
    if (IN(7)) { ln_rows((const bf16_t*)(ws + WS_PROJ), out, ln_w, ln_b, lane, wave, G); }
#undef IN
#undef SEAM
}

extern "C" void kernel_launch(void* const* d_in, const int* in_sizes, int n_in, void* d_out, int out_size, void* d_ws, size_t ws_size, hipStream_t stream) {
    static int grid = 0;
    if (grid == 0) {
        if (n_in != 14 || out_size != M * D || ws_size < WS_END) { fprintf(stderr, "kernel_launch: unexpected problem (n_in %d, out %d, ws %zu)\n", n_in, out_size, ws_size); grid = -1; return; }
        int dev = 0, cus = 0, per_cu = 0;
        if (hipGetDevice(&dev) != hipSuccess || hipDeviceGetAttribute(&cus, hipDeviceAttributeMultiprocessorCount, dev) != hipSuccess) { grid = -1; return; }
        if (hipFuncSetAttribute((const void*)hybrid_fwd, hipFuncAttributeMaxDynamicSharedMemorySize, LDS_BYTES) != hipSuccess) { fprintf(stderr, "kernel_launch: hipFuncSetAttribute failed\n"); grid = -1; return; }
        if (hipOccupancyMaxActiveBlocksPerMultiprocessor(&per_cu, (const void*)hybrid_fwd, NTHR, LDS_BYTES) != hipSuccess || per_cu < 1) { fprintf(stderr, "kernel_launch: occupancy query reports %d blocks per CU\n", per_cu); (void)hipGetLastError(); per_cu = 1; }
        grid = cus * 1;
    }
    if (grid < 0) return;
    if (hipMemsetAsync((char*)d_ws + WS_CTL, 0, CTL_BYTES, stream) != hipSuccess) { fprintf(stderr, "kernel_launch: memset of the barrier words failed\n"); return; }
    Args a{};
    for (int i = 0; i < 14; ++i) a.in[i] = (const float*)d_in[i];
    a.out = (float*)d_out; a.ws = (unsigned char*)d_ws; a.nsync = 0;
    for (int li = 0; li < MK_N_LAUNCHES; ++li) {
        if (MK_N_LAUNCHES == 1) { a.ph_lo = 0; a.ph_hi = N_PHASES; } else { a.ph_lo = li; a.ph_hi = li + 1; }
        void* kargs[] = {&a};
        const hipError_t e = hipLaunchCooperativeKernel((const void*)hybrid_fwd, dim3(grid), dim3(NTHR), kargs, LDS_BYTES, stream);
        if (e != hipSuccess) { fprintf(stderr, "kernel_launch: cooperative launch failed: %s (grid %d)\n", hipGetErrorString(e), grid); break; }
    }
}
```

```cpp
#include <hip/hip_runtime.h>
#include <hip/hip_cooperative_groups.h>
#include <cstdio>
#include <cstdint>
namespace cg = cooperative_groups;
namespace pg8 {
#define PG8_LAS __attribute__((address_space(3)))
typedef unsigned short bf16_t;
typedef short bf16x8 __attribute__((ext_vector_type(8)));
typedef float f32x4 __attribute__((ext_vector_type(4)));
typedef unsigned u32x4 __attribute__((ext_vector_type(4)));
constexpr int BM = 256, BK = 64, HALF = 128, HTB = HALF * BK * 2  , STAGE_BYTES = 8 * HTB, NXCD = 8, WGM = 8;

__host__ __device__ __forceinline__ int lds_byte(int r, int c) { const int st = (r >> 4) * 2 + (c >> 5), rr = r & 15, cc = c & 31, ob = rr * 64 + cc * 2; return st * 1024 + (ob ^ (((ob >> 9) & 1) << 5)); }
__host__ __device__ __forceinline__ void stage_rc(int b, int& R, int& C) { const int st = b / 1024, sb = b % 1024, swz = sb ^ (((sb >> 9) & 1) << 5); R = (st >> 1) * 16 + swz / 64; C = (st & 1) * 32 + (swz % 64) / 2; }
__host__ __device__ __forceinline__ int perm32(int rho) { const int n = rho >> 4, i = rho & 15; return 8 * (i >> 2) + 4 * n + (i & 3); }

struct Unit { int pm, pn; };
struct Gemm { const bf16_t* A; const bf16_t* Bt; int M, N, K; };

struct StaticOrder {
    int nM, nN, nwg, G, c, nrep;
    __host__ __device__ void init(int M, int N, int G_, int c_, int nrep_ = 1) { nM = M / BM; nN = N / BM; nwg = nM * nN; G = G_; c = c_; nrep = nrep_; }
    __host__ __device__ bool next(int i, Unit& u) const {
        const long L = (long)i * G + c; if (L >= (long)nwg * nrep) return false;
        int wgid = (int)(L % nwg); { const int q = nwg / NXCD, r = nwg % NXCD, xcd = wgid % NXCD, off = wgid / NXCD; wgid = (xcd < r ? xcd * (q + 1) : r * (q + 1) + (xcd - r) * q) + off; }
        const int nig = WGM * nN, gid = wgid / nig, fm = gid * WGM, gsz = (nM - fm) < WGM ? (nM - fm) : WGM;
        u.pm = fm + ((wgid % nig) % gsz); u.pn = (wgid % nig) / gsz; return true;
    }
    __device__ __forceinline__ void a_ready(const Unit&) const {}
    __device__ __forceinline__ void done(const Unit&) const {}
};

__device__ __forceinline__ unsigned cvt_pk_bf16(float lo, float hi) { unsigned r; asm volatile("v_cvt_pk_bf16_f32 %0, %1, %2" : "=v"(r) : "v"(lo), "v"(hi)); return r; }
struct EpiBf16 {
    static constexpr bool PERM = true, AFTER_DRAIN = false;
    bf16_t* O; int ldc;
    __device__ __forceinline__ void operator()(const f32x4 (&acc)[2][2][4][2], const Unit& u, int wr, int wc, int fr, int fq) const {
        const int row0 = u.pm * BM + wr * 64 + fr; const int col0 = u.pn * BM + wc * 32 + 8 * fq;
#pragma unroll
        for (int ai = 0; ai < 2; ++ai)
#pragma unroll
            for (int m = 0; m < 4; ++m) { bf16_t* rowp = O + (size_t)(row0 + ai * HALF + m * 16) * ldc + col0;
#pragma unroll
                for (int bj = 0; bj < 2; ++bj) { const f32x4 v0 = acc[ai][bj][m][0], v1 = acc[ai][bj][m][1];
                    u32x4 w; w.x = cvt_pk_bf16(v0[0], v0[1]); w.y = cvt_pk_bf16(v0[2], v0[3]); w.z = cvt_pk_bf16(v1[0], v1[1]); w.w = cvt_pk_bf16(v1[2], v1[3]);
                    *(u32x4*)(rowp + bj * HALF) = w; } }
    }
};
struct EpiZ {
    static constexpr bool PERM = false, AFTER_DRAIN = false;
    const float* x; const float* gate; float* out; float alpha;
    __device__ __forceinline__ void operator()(const f32x4 (&acc)[2][2][4][2], const Unit& u, int wr, int wc, int fr, int fq) const {
        const int col0 = u.pn * BM + wc * 32 + 4 * fq;
#pragma unroll
        for (int ai = 0; ai < 2; ++ai)
#pragma unroll
            for (int m = 0; m < 4; ++m) { const int r = u.pm * BM + ai * HALF + wr * 64 + m * 16 + fr; const size_t off = (size_t)r * 2048 + col0; const float* gb = gate + (size_t)(r >> 12) * 6144 + col0;
#pragma unroll
                for (int bj = 0; bj < 2; ++bj)
#pragma unroll
                    for (int n = 0; n < 2; ++n) { const f32x4 xv = *(const f32x4*)(x + off + bj * HALF + n * 16); const f32x4 gv = *(const f32x4*)(gb + bj * HALF + n * 16);
                        *(f32x4*)(out + off + bj * HALF + n * 16) = xv * alpha + gv * acc[ai][bj][m][n]; } }
    }
};
struct EpiZ16 {
    static constexpr bool PERM = true, AFTER_DRAIN = false;
    const float* x; const float* gate; bf16_t* z; float alpha;
    __device__ __forceinline__ void operator()(const f32x4 (&acc)[2][2][4][2], const Unit& u, int wr, int wc, int fr, int fq) const {
        const int col0 = u.pn * BM + wc * 32 + 8 * fq;
        const float* gb = gate + (size_t)((u.pm * BM) >> 12) * 6144 + col0;
        const f32x4 g00 = *(const f32x4*)(gb), g01 = *(const f32x4*)(gb + 4), g10 = *(const f32x4*)(gb + HALF), g11 = *(const f32x4*)(gb + HALF + 4);
#pragma unroll
        for (int ai = 0; ai < 2; ++ai)
#pragma unroll
            for (int m = 0; m < 4; ++m) { const int r = u.pm * BM + ai * HALF + wr * 64 + m * 16 + fr; const size_t off = (size_t)r * 2048 + col0;
#pragma unroll
                for (int bj = 0; bj < 2; ++bj) {
                    const f32x4 x0 = __builtin_nontemporal_load((const f32x4*)(x + off + bj * HALF)), x1 = __builtin_nontemporal_load((const f32x4*)(x + off + bj * HALF + 4));
                    const f32x4 v0 = x0 * alpha + (bj ? g10 : g00) * acc[ai][bj][m][0], v1 = x1 * alpha + (bj ? g11 : g01) * acc[ai][bj][m][1];
                    u32x4 w; w.x = cvt_pk_bf16(v0[0], v0[1]); w.y = cvt_pk_bf16(v0[2], v0[3]); w.z = cvt_pk_bf16(v1[0], v1[1]); w.w = cvt_pk_bf16(v1[2], v1[3]);
                    *(u32x4*)(z + off + bj * HALF) = w; } }
    }
};
template <class Epi, class Sched, bool ALIGN_EPI = false, bool SP2 = false>
__device__ __forceinline__ void gemm_phase(PG8_LAS unsigned char* lds, const Gemm g, const Sched& S, const Epi& E) {
    const int tid = threadIdx.x, wid = __builtin_amdgcn_readfirstlane(tid >> 6), lane = tid & 63, wr = wid >> 2, wc = wid & 3, fr = lane & 15, fq = lane >> 4;
    const int K = g.K, nt = K / BK;
    unsigned voffA[2], voffB[2];
#pragma unroll
    for (int i = 0; i < 2; ++i) { int R, C; stage_rc(tid * 16 + i * 8192, R, C); const int Rb = Epi::PERM ? ((R & ~31) + perm32(R & 31)) : R;
        voffA[i] = (unsigned)(R * K + C) * 2u; voffB[i] = (unsigned)(Rb * K + C) * 2u; }
    const size_t kstep = (size_t)(BK * 2);
    const size_t hstep = (size_t)HALF * K * 2;
    const size_t tstep = 2 * hstep;
    const unsigned ldsw = (unsigned)wid * 1024u;
    const int aoff = lds_byte(wr * 64 + fr, fq * 8), boff = lds_byte(wc * 32 + fr, fq * 8);
#define PG8_SA(b, h) (((b) * 2 + (h)) * HTB)
#define PG8_SB(b, h) ((4 + (b) * 2 + (h)) * HTB)
#define PG8_STAGE(bufoff, gbase, voff) do { _Pragma("unroll") for (int _i = 0; _i < 2; ++_i) \
        __builtin_amdgcn_global_load_lds((const unsigned*)((const char*)(gbase) + (voff)[_i]), (PG8_LAS unsigned*)(lds + (bufoff) + ldsw + _i * 8192), 16, 0, 0); } while (0)
#define PG8_LDA(dst, b, h) do { _Pragma("unroll") for (int m = 0; m < 4; ++m) _Pragma("unroll") for (int k = 0; k < 2; ++k) dst[m][k] = *(const PG8_LAS bf16x8*)(lds + PG8_SA(b, h) + aoff + m * 2048 + k * 1024); } while (0)
#define PG8_LDB(dst, b, h) do { _Pragma("unroll") for (int n = 0; n < 2; ++n) _Pragma("unroll") for (int k = 0; k < 2; ++k) dst[n][k] = *(const PG8_LAS bf16x8*)(lds + PG8_SB(b, h) + boff + n * 2048 + k * 1024); } while (0)
#define PG8_MMA(ai, bj, At, Bt) do { __builtin_amdgcn_s_setprio(1); _Pragma("unroll") for (int m = 0; m < 4; ++m) _Pragma("unroll") for (int n = 0; n < 2; ++n) _Pragma("unroll") for (int k = 0; k < 2; ++k) \
        acc[ai][bj][m][n] = __builtin_amdgcn_mfma_f32_16x16x32_bf16(Bt[n][k], At[m][k], acc[ai][bj][m][n], 0, 0, 0); __builtin_amdgcn_s_setprio(0); } while (0)
#define PG8_WAIT_V(n) asm volatile("s_waitcnt vmcnt(" #n ")" ::: "memory")
#define PG8_WAIT_L(n) asm volatile("s_waitcnt lgkmcnt(" #n ")" ::: "memory")
#define PG8_BAR __builtin_amdgcn_s_barrier()
#define PG8_SCHED __builtin_amdgcn_sched_barrier(0)
    Unit cur, nxt; int ui = 0;
    if (!S.next(0, cur)) return;
    f32x4 acc[2][2][4][2];
#pragma unroll
    for (int a = 0; a < 2; ++a)
#pragma unroll
        for (int b = 0; b < 2; ++b)
#pragma unroll
            for (int m = 0; m < 4; ++m)
#pragma unroll
                for (int n = 0; n < 2; ++n) acc[a][b][m][n] = (f32x4){0.f, 0.f, 0.f, 0.f};
    bf16x8 At[4][2], B0[2][2], B1[2][2];
    const char* cA = (const char*)g.A + (size_t)cur.pm * tstep; const char* cB = (const char*)g.Bt + (size_t)cur.pn * tstep;
    S.a_ready(cur);
    if constexpr (SP2) {
        PG8_STAGE(PG8_SB(0, 0), cB, voffB); PG8_STAGE(PG8_SB(0, 1), cB + hstep, voffB); PG8_STAGE(PG8_SA(0, 0), cA, voffA); PG8_STAGE(PG8_SA(0, 1), cA + hstep, voffA);
        if (wr == 1) PG8_BAR;
        PG8_WAIT_V(2); PG8_BAR;
        PG8_STAGE(PG8_SB(1, 0), cB + kstep, voffB); PG8_STAGE(PG8_SA(1, 0), cA + kstep, voffA); PG8_STAGE(PG8_SB(1, 1), cB + hstep + kstep, voffB);
        PG8_WAIT_V(6); PG8_BAR;
    } else {
        PG8_STAGE(PG8_SB(0, 0), cB, voffB); PG8_STAGE(PG8_SA(0, 0), cA, voffA); PG8_STAGE(PG8_SB(0, 1), cB + hstep, voffB); PG8_STAGE(PG8_SA(0, 1), cA + hstep, voffA);
        if (wr == 1) PG8_BAR;
        PG8_WAIT_V(4); PG8_BAR;
        PG8_STAGE(PG8_SB(1, 0), cB + kstep, voffB); PG8_STAGE(PG8_SA(1, 0), cA + kstep, voffA); PG8_STAGE(PG8_SB(1, 1), cB + hstep + kstep, voffB);
        PG8_WAIT_V(6); PG8_BAR;
    }
    for (;;) {
        const bool has_next = S.next(ui + 1, nxt);
        const char* nA = has_next ? (const char*)g.A + (size_t)nxt.pm * tstep : cA; const char* nB = has_next ? (const char*)g.Bt + (size_t)nxt.pn * tstep : cB;
        for (int t = 0; t < nt; t += 2) {
            const bool last = (t == nt - 2);
            const char* a1 = cA + (size_t)(t + 1) * kstep;
            const char* a2 = last ? nA : cA + (size_t)(t + 2) * kstep; const char* b2 = last ? nB : cB + (size_t)(t + 2) * kstep;
            const char* a3 = a2 + kstep; const char* b3 = b2 + kstep;
            if (last && has_next) S.a_ready(nxt);
            if constexpr (SP2) {
            PG8_LDB(B0, 0, 0); PG8_LDB(B1, 0, 1); PG8_SCHED; PG8_LDA(At, 0, 0); PG8_STAGE(PG8_SA(1, 1), a1 + hstep, voffA);
            PG8_WAIT_V(8); PG8_WAIT_L(0); PG8_BAR; PG8_MMA(0, 0, At, B0); PG8_MMA(0, 1, At, B1); PG8_BAR; PG8_SCHED;
            PG8_LDA(At, 0, 1); PG8_STAGE(PG8_SB(0, 0), b2, voffB); PG8_STAGE(PG8_SB(0, 1), b2 + hstep, voffB); PG8_STAGE(PG8_SA(0, 0), a2, voffA);
            PG8_WAIT_V(8); PG8_WAIT_L(0); PG8_BAR; PG8_MMA(1, 0, At, B0); PG8_MMA(1, 1, At, B1); PG8_BAR; PG8_SCHED;
            PG8_LDB(B0, 1, 0); PG8_LDB(B1, 1, 1); PG8_SCHED; PG8_LDA(At, 1, 0); PG8_STAGE(PG8_SA(0, 1), a2 + hstep, voffA);
            PG8_WAIT_V(8); PG8_WAIT_L(0); PG8_BAR; PG8_MMA(0, 0, At, B0); PG8_MMA(0, 1, At, B1); PG8_BAR; PG8_SCHED;
            PG8_LDA(At, 1, 1); PG8_STAGE(PG8_SB(1, 0), b3, voffB); PG8_STAGE(PG8_SB(1, 1), b3 + hstep, voffB); PG8_STAGE(PG8_SA(1, 0), a3, voffA);
            PG8_WAIT_V(8); PG8_WAIT_L(0); PG8_BAR; PG8_MMA(1, 0, At, B0); PG8_MMA(1, 1, At, B1); PG8_BAR; PG8_SCHED;
            } else {
            PG8_LDB(B0, 0, 0); PG8_SCHED; PG8_LDA(At, 0, 0); PG8_STAGE(PG8_SA(1, 1), a1 + hstep, voffA);
            PG8_WAIT_L(8); PG8_BAR; PG8_WAIT_L(0); PG8_MMA(0, 0, At, B0); PG8_BAR; PG8_SCHED;
            PG8_LDB(B1, 0, 1); PG8_STAGE(PG8_SB(0, 0), b2, voffB);
            PG8_BAR; PG8_WAIT_L(0); PG8_MMA(0, 1, At, B1); PG8_BAR;
            PG8_LDA(At, 0, 1); PG8_STAGE(PG8_SA(0, 0), a2, voffA);
            PG8_BAR; PG8_WAIT_L(0); PG8_MMA(1, 0, At, B0); PG8_BAR; PG8_SCHED;
            PG8_STAGE(PG8_SB(0, 1), b2 + hstep, voffB);
            PG8_WAIT_V(6); PG8_BAR; PG8_MMA(1, 1, At, B1); PG8_BAR;
            PG8_LDB(B0, 1, 0); PG8_SCHED; PG8_LDA(At, 1, 0); PG8_STAGE(PG8_SA(0, 1), a2 + hstep, voffA);
            PG8_WAIT_L(8); PG8_BAR; PG8_WAIT_L(0); PG8_MMA(0, 0, At, B0); PG8_BAR; PG8_SCHED;
            PG8_LDB(B1, 1, 1); PG8_STAGE(PG8_SB(1, 0), b3, voffB);
            PG8_BAR; PG8_WAIT_L(0); PG8_MMA(0, 1, At, B1); PG8_BAR;
            PG8_LDA(At, 1, 1); PG8_STAGE(PG8_SA(1, 0), a3, voffA);
            PG8_BAR; PG8_WAIT_L(0); PG8_MMA(1, 0, At, B0); PG8_BAR; PG8_SCHED;
            PG8_STAGE(PG8_SB(1, 1), b3 + hstep, voffB);
            PG8_WAIT_V(6); PG8_BAR; PG8_MMA(1, 1, At, B1); PG8_BAR;
            }
        }
        if constexpr (ALIGN_EPI) { if (wr == 0) PG8_BAR; }
        if constexpr (!Epi::AFTER_DRAIN) { E(acc, cur, wr, wc, fr, fq); S.done(cur); }
        if (!has_next) break;
#pragma unroll
        for (int a = 0; a < 2; ++a)
#pragma unroll
            for (int b = 0; b < 2; ++b)
#pragma unroll
                for (int m = 0; m < 4; ++m)
#pragma unroll
                    for (int n = 0; n < 2; ++n) acc[a][b][m][n] = (f32x4){0.f, 0.f, 0.f, 0.f};
        cur = nxt; cA = nA; cB = nB; ++ui;
        if constexpr (ALIGN_EPI) { if (wr == 1) PG8_BAR; }
    }
    PG8_WAIT_V(0);
    if constexpr (!ALIGN_EPI) { if (wr == 0) PG8_BAR; }
    PG8_BAR;
    if constexpr (Epi::AFTER_DRAIN) { E.fused(acc, cur, wr, wc, fr, fq, lds, wid, lane); S.done(cur); }
#undef PG8_SA
#undef PG8_SB
#undef PG8_STAGE
#undef PG8_LDA
#undef PG8_LDB
#undef PG8_MMA
#undef PG8_WAIT_V
#undef PG8_WAIT_L
#undef PG8_BAR
#undef PG8_SCHED
}
}

#define LAS __attribute__((address_space(3)))
typedef unsigned short bf16_t;
typedef short bf16x8 __attribute__((ext_vector_type(8)));
typedef float f32x4 __attribute__((ext_vector_type(4)));
typedef unsigned u32x4 __attribute__((ext_vector_type(4)));
typedef unsigned u32x2 __attribute__((ext_vector_type(2)));
constexpr int NWAVES = 8, NTHR = 512;
constexpr int NB = 8, T = 4096, D = 2048, M = NB * T;
constexpr int NC = 7168, INC = 7184;
constexpr int C_RQ = 0, C_RK = 512, C_RV = 1024, C_RG = 2048, C_GQ = 3072, C_GG = 6144;
constexpr size_t MiB = (size_t)1 << 20;
constexpr size_t WS_MOD = 0, WS_G = 1 * MiB, WS_BETA = 2 * MiB, WS_GL = 3 * MiB, WS_WOUT = 4 * MiB, WS_WIN = 12 * MiB, WS_HIN = 40 * MiB, WS_PROJ = 168 * MiB, WS_GPREP = 616 * MiB, WS_END = 904 * MiB;
constexpr int GP_W = 0, GP_QE = 16384, GP_KT = 32768, GP_AT = 49152, GP_UT = 57344, GP_BYTES = 73728;
constexpr int LDS_BYTES = 147456;
constexpr float QK_SCALE = 0.08838834764831845f;

typedef __bf16 bf16v2_t __attribute__((ext_vector_type(2)));
typedef float f32v2_t __attribute__((ext_vector_type(2)));
__device__ __forceinline__ unsigned pk2(float lo, float hi) { return __builtin_bit_cast(unsigned, __builtin_convertvector((f32v2_t){lo, hi}, bf16v2_t)); }
__device__ __forceinline__ unsigned f2bf(float f) { return (unsigned)__builtin_bit_cast(unsigned short, (__bf16)f); }
__device__ __forceinline__ float bf2f(unsigned h) { return __builtin_bit_cast(float, h << 16); }
__device__ __forceinline__ float bflo(unsigned w) { return __builtin_bit_cast(float, w << 16); }
__device__ __forceinline__ float bfhi(unsigned w) { return __builtin_bit_cast(float, w & 0xffff0000u); }
__device__ __forceinline__ float silu_f(float v) { return v * __builtin_amdgcn_rcpf(1.f + __expf(-v)); }
__device__ __forceinline__ void lds_barrier() { asm volatile("s_waitcnt lgkmcnt(0)\n\ts_barrier" ::: "memory"); }
__device__ __forceinline__ float wave_sum(float v) {
#pragma unroll
    for (int o = 1; o < 64; o <<= 1) v += __shfl_xor(v, o);
    return v;
}
__device__ __forceinline__ float sum16(float v) {
#pragma unroll
    for (int o = 1; o < 16; o <<= 1) v += __shfl_xor(v, o);
    return v;
}
template <int KS> __device__ __forceinline__ void mma_nt(f32x4& acc, const LAS bf16_t* A, int lda, const LAS bf16_t* Bt, int ldb, int lane) {
    const int r = lane & 15, g = lane >> 4;
    const LAS bf16_t* ap = A + r * lda + g * 8; const LAS bf16_t* bp = Bt + r * ldb + g * 8;
#pragma unroll
    for (int ks = 0; ks < KS; ++ks) {
        const bf16x8 a = *(const LAS bf16x8*)(ap + ks * 32); const bf16x8 b = *(const LAS bf16x8*)(bp + ks * 32);
        acc = __builtin_amdgcn_mfma_f32_16x16x32_bf16(a, b, acc, 0, 0, 0);
    }
}
__device__ __forceinline__ void unpack8(const u32x4 w, float* o) { o[0] = bflo(w.x); o[1] = bfhi(w.x); o[2] = bflo(w.y); o[3] = bfhi(w.y); o[4] = bflo(w.z); o[5] = bfhi(w.z); o[6] = bflo(w.w); o[7] = bfhi(w.w); }
__device__ __forceinline__ u32x4 pack8(const float* v) { u32x4 w; w.x = pk2(v[0], v[1]); w.y = pk2(v[2], v[3]); w.z = pk2(v[4], v[5]); w.w = pk2(v[6], v[7]); return w; }

__device__ __forceinline__ int kpos(int k) { const int kk = k & 31; return (k & ~31) + ((kk & 12) << 1) + (kk & 3) + ((kk & 16) >> 2); }
__device__ __forceinline__ bf16x8 pack_tiles(const f32x4 lo, const f32x4 hi) { u32x4 w; w.x = pk2(lo[0], lo[1]); w.y = pk2(lo[2], lo[3]); w.z = pk2(hi[0], hi[1]); w.w = pk2(hi[2], hi[3]); return __builtin_bit_cast(bf16x8, w); }

__device__ __forceinline__ void p0_transpose_item(const float* W, int ldw, int K, bf16_t* WT, LAS float* scr, int nblk, int item, int lane) {
    const int kb = item / nblk, nb = item % nblk, k0 = 64 * kb, n0 = 32 * nb;
#pragma unroll 8
    for (int i = 0; i < 32; ++i) { const int kk = 2 * i + (lane >> 5); scr[kk * 33 + (lane & 31)] = W[(size_t)(k0 + kk) * ldw + n0 + (lane & 31)]; }
    asm volatile("s_waitcnt lgkmcnt(0)" ::: "memory");
    const int c = lane & 7;
#pragma unroll
    for (int j = 0; j < 4; ++j) { const int n = (lane >> 3) + 8 * j; const LAS float* s = scr + (8 * c) * 33 + n;
        u32x4 o; o.x = pk2(s[0 * 33], s[1 * 33]); o.y = pk2(s[2 * 33], s[3 * 33]); o.z = pk2(s[4 * 33], s[5 * 33]); o.w = pk2(s[6 * 33], s[7 * 33]);
        *(u32x4*)(WT + (size_t)(n0 + n) * K + k0 + 8 * c) = o; }
    asm volatile("s_waitcnt lgkmcnt(0)" ::: "memory");
}
__device__ __forceinline__ void p0_phase(LAS unsigned char* lds, const float* cvec, const float* w_ada, const float* b_ada, const float* w_in, const float* w_out,
                                         float* mod, bf16_t* WinT, bf16_t* WoutT, int tid, int lane, int wave, int G, int nrep) {
    LAS float* sc = (LAS float*)lds;
    LAS float* part = (LAS float*)(lds + 65536);
    for (int blk_ = blockIdx.x; blk_ < 256 * nrep; blk_ += G) {
        const int blk = blk_ & 255; const int n0 = 24 * blk;
        for (int i = tid; i < 8 * 2048; i += NTHR) sc[i] = silu_f(cvec[i]);
        __syncthreads();
        const int kg = tid / 6, c4 = tid % 6;
        if (tid < 510) {
            float acc[8][4];
#pragma unroll
            for (int b = 0; b < 8; ++b)
#pragma unroll
                for (int j = 0; j < 4; ++j) acc[b][j] = 0.f;
            for (int k = kg; k < 2048; k += 85) {
                const f32x4 w = *(const f32x4*)(w_ada + (size_t)k * 6144 + n0 + 4 * c4);
#pragma unroll
                for (int b = 0; b < 8; ++b) { const float s = sc[b * 2048 + k]; acc[b][0] += s * w[0]; acc[b][1] += s * w[1]; acc[b][2] += s * w[2]; acc[b][3] += s * w[3]; }
            }
#pragma unroll
            for (int b = 0; b < 8; ++b)
#pragma unroll
                for (int j = 0; j < 4; ++j) part[kg * 192 + b * 24 + 4 * c4 + j] = acc[b][j];
        }
        __syncthreads();
        if (tid < 192) { float s = 0.f; for (int q = 0; q < 85; ++q) s += part[q * 192 + tid]; const int b = tid / 24, j = tid % 24; mod[b * 6144 + n0 + j] = s + b_ada[n0 + j]; }
        __syncthreads();
    }
    LAS float* scr = (LAS float*)(lds + wave * 16384);
    const int gw = blockIdx.x * NWAVES + wave, NGW = G * NWAVES;
    constexpr int I_IN = (D / 64) * (NC / 32), I_OUT = (D / 64) * (D / 32);
    for (int it_ = gw; it_ < (I_IN + I_OUT) * nrep; it_ += NGW) {
        const int it = it_ % (I_IN + I_OUT);
        if (it < I_IN) p0_transpose_item(w_in, INC, D, WinT, scr, NC / 32, it, lane);
        else p0_transpose_item(w_out, D, D, WoutT, scr, D / 32, it - I_IN, lane);
    }
}

__device__ __forceinline__ void p1_phase(LAS unsigned char* lds, const float* x, const float* w_in, const float* mod, const float* a_log, const float* dt_bias,
                                         bf16_t* hin, float* gdec, float* beta, int tid, int lane, int wave, int G, int nrep) {
    LAS float* wx = (LAS float*)lds;
    for (int k = tid; k < 2048; k += NTHR) {
        const f32x4* src = (const f32x4*)(w_in + (size_t)k * INC + NC);
#pragma unroll
        for (int q = 0; q < 4; ++q) { const f32x4 v = src[q]; wx[(4 * q + 0) * 2048 + k] = v[0]; wx[(4 * q + 1) * 2048 + k] = v[1]; wx[(4 * q + 2) * 2048 + k] = v[2]; wx[(4 * q + 3) * 2048 + k] = v[3]; }
    }
    __syncthreads();
    typedef float f32x2 __attribute__((ext_vector_type(2)));
    const int gw = blockIdx.x * NWAVES + wave, NGW = G * NWAVES;
    for (int pair_ = gw; pair_ < (M / 2) * nrep; pair_ += NGW) {
        const int pair = pair_ & (M / 2 - 1);
        const size_t m0 = (size_t)2 * pair; const int b = (int)(m0 >> 12);
        const float* modb = mod + b * 6144;
        float acc0[16], acc1[16];
#pragma unroll
        for (int o = 0; o < 16; ++o) { acc0[o] = 0.f; acc1[o] = 0.f; }
#pragma unroll 2
        for (int i = 0; i < 16; ++i) {
            const int k = 2 * lane + 128 * i;
            const f32x2 sh = *(const f32x2*)(modb + k), scl = *(const f32x2*)(modb + 2048 + k);
            const f32x2 x0 = __builtin_nontemporal_load((const f32x2*)(x + m0 * D + k)), x1 = __builtin_nontemporal_load((const f32x2*)(x + (m0 + 1) * D + k));
            const float h00 = x0[0] * (1.f + scl[0]) + sh[0], h01 = x0[1] * (1.f + scl[1]) + sh[1];
            const float h10 = x1[0] * (1.f + scl[0]) + sh[0], h11 = x1[1] * (1.f + scl[1]) + sh[1];
            *(unsigned*)(hin + m0 * D + k) = pk2(h00, h01);
            *(unsigned*)(hin + (m0 + 1) * D + k) = pk2(h10, h11);
#pragma unroll
            for (int o = 0; o < 16; ++o) { const f32x2 w = *(const LAS f32x2*)(wx + o * 2048 + k); acc0[o] += h00 * w[0] + h01 * w[1]; acc1[o] += h10 * w[0] + h11 * w[1]; }
        }
#pragma unroll
        for (int sft = 0; sft < 4; ++sft) {
            const bool hiLane = (lane >> sft) & 1;
#pragma unroll
            for (int t = 0; t < (8 >> sft); ++t) {
                const float k0 = hiLane ? acc0[2 * t + 1] : acc0[2 * t], s0 = hiLane ? acc0[2 * t] : acc0[2 * t + 1];
                const float k1 = hiLane ? acc1[2 * t + 1] : acc1[2 * t], s1 = hiLane ? acc1[2 * t] : acc1[2 * t + 1];
                acc0[t] = k0 + __shfl_xor(s0, 1 << sft); acc1[t] = k1 + __shfl_xor(s1, 1 << sft);
            }
        }
        float v0 = acc0[0], v1 = acc1[0];
        v0 += __shfl_xor(v0, 16); v0 += __shfl_xor(v0, 32); v1 += __shfl_xor(v1, 16); v1 += __shfl_xor(v1, 32);
        if (lane < 8) {
            const float al = -__expf(a_log[lane]), db = dt_bias[lane];
            const float y0 = v0 + db, y1 = v1 + db;
            const float sp0 = y0 > 20.f ? y0 : log1pf(__expf(y0)), sp1 = y1 > 20.f ? y1 : log1pf(__expf(y1));
            gdec[m0 * 8 + lane] = al * sp0; gdec[(m0 + 1) * 8 + lane] = al * sp1;
        } else if (lane < 16) {
            beta[m0 * 8 + lane - 8] = 1.f / (1.f + __expf(-v0)); beta[(m0 + 1) * 8 + lane - 8] = 1.f / (1.f + __expf(-v1));
        }
    }
}

__device__ __forceinline__ void rot16(float* lo, float* hi, int pos, int d0) {
#pragma unroll
    for (int e = 0; e < 16; ++e) {
        const float fturn = exp2f(-(float)(d0 + e) * (13.287712379549449f / 64.f)) * 0.15915494309189535f;
        const double r = (double)pos * (double)fturn; const float fr = (float)(r - floor(r));
        const float sn = __builtin_amdgcn_sinf(fr), cs = __builtin_amdgcn_cosf(fr);
        const float a = lo[e], b = hi[e];
        lo[e] = a * cs - b * sn; hi[e] = a * sn + b * cs;
    }
}

__device__ __forceinline__ void gdn_prep_block(LAS unsigned char* lds, int vb, const bf16_t* proj, const float* conv_w, const float* gdec, const float* beta,
                                               unsigned char* gprep, float* glv, int tid, int lane, int wave) {
    const int h = vb & 7, pq = vb >> 3;
    LAS float* GCB = (LAS float*)(lds + 116736);
    LAS float* CW = (LAS float*)(lds + 122880);
    for (int idx = tid; idx < 1536; idx += NTHR) { const int X = idx >> 9, r = idx & 511; CW[idx] = conv_w[(r >> 7) * 3072 + X * 1024 + h * 128 + (r & 127)]; }
    const int ti_ = tid >> 3, td0_ = (tid & 7) * 16;
    u32x4 pre[3][4][2];
#define GP_ITEM(k) (((((pq + 32 * (k)) >> 6) * 8 + h) << 6) + ((pq + 32 * (k)) & 63))
#define GP_STEP0(itm, GCp) do { const int n_ = (itm) & 63, b_ = (itm) >> 9; const long mm = (long)b_ * T + n_ * 64; \
        const float g_ = gdec[(mm + lane) * 8 + h], bt_ = beta[(mm + lane) * 8 + h]; float gc = g_; \
        _Pragma("unroll") for (int off = 1; off < 64; off <<= 1) { const float t_ = __shfl_up(gc, off); if (lane >= off) gc += t_; } \
        const float glast = __shfl(gc, 63); (GCp)[lane] = gc; (GCp)[64 + lane] = bt_; (GCp)[128 + lane] = __expf(gc); (GCp)[192 + lane] = __expf(glast - gc); \
        if (lane == 0) glv[itm] = __expf(glast); } while (0)
#define GP_LOADPRE(itm) do { const int n_ = (itm) & 63, b_ = (itm) >> 9; const long mm = (long)b_ * T + n_ * 64; \
        _Pragma("unroll") for (int X = 0; X < 3; ++X) _Pragma("unroll") for (int j = 0; j < 4; ++j) { \
            if (n_ * 64 + ti_ - 3 + j >= 0) { const u32x4* p_ = (const u32x4*)(proj + (size_t)(mm + ti_ - 3 + j) * NC + C_GQ + X * 1024 + h * 128 + td0_); pre[X][j][0] = p_[0]; pre[X][j][1] = p_[1]; } \
            else { pre[X][j][0] = (u32x4){0u, 0u, 0u, 0u}; pre[X][j][1] = (u32x4){0u, 0u, 0u, 0u}; } } } while (0)
    if (wave == 0) GP_STEP0(GP_ITEM(0), GCB);
    GP_LOADPRE(GP_ITEM(0));
    lds_barrier();
    for (int k = 0; k < 16; ++k) {
    const int item = GP_ITEM(k);
    { unsigned zoff = 0; asm volatile("" : "+s"(zoff)); lds += zoff; tid += zoff; lane += zoff; }
    const int n = item & 63, b = item >> 9; const int t0 = n * 64; const long m0 = (long)b * T + t0;
    LAS bf16_t* KN = (LAS bf16_t*)lds;
    LAS bf16_t* QN = (LAS bf16_t*)(lds + 17408);
    LAS bf16_t* KBGT = (LAS bf16_t*)(lds + 34816);
    LAS bf16_t* VBT = (LAS bf16_t*)(lds + 53248);
    LAS bf16_t* KTT = (LAS bf16_t*)(lds + 71680);
    LAS bf16_t* TM = (LAS bf16_t*)(lds + 90112);
    LAS float* AM = (LAS float*)(lds + 99328);
    LAS bf16_t* AB = (LAS bf16_t*)(lds + 117760);
    LAS bf16_t* T11T = (LAS bf16_t*)(lds + 120320);
    LAS float* GC = (LAS float*)(lds + ((k & 1) ? 129024 : 116736));
    LAS float* BT = GC + 64; LAS float* EG = GC + 128; LAS float* EK = GC + 192;
    unsigned char* gp = gprep + (size_t)item * GP_BYTES;
    {
        const int i = tid >> 3, d0 = (tid & 7) * 16;
        const float bti = BT[i], egi = EG[i], eki = EK[i];
#pragma unroll
        for (int X = 0; X < 3; ++X) {
            float val[16];
#pragma unroll
            for (int e = 0; e < 16; ++e) val[e] = 0.f;
#pragma unroll
            for (int j = 0; j < 4; ++j) {
                float in[16]; unpack8(pre[X][j][0], in); unpack8(pre[X][j][1], in + 8);
                const LAS f32x4* wp = (const LAS f32x4*)(CW + (X * 4 + j) * 128 + d0);
#pragma unroll
                for (int q = 0; q < 4; ++q) { const f32x4 w = wp[q]; val[4 * q + 0] += in[4 * q + 0] * w[0]; val[4 * q + 1] += in[4 * q + 1] * w[1]; val[4 * q + 2] += in[4 * q + 2] * w[2]; val[4 * q + 3] += in[4 * q + 3] * w[3]; }
            }
            float ss = 0.f;
#pragma unroll
            for (int e = 0; e < 16; ++e) { val[e] = silu_f(val[e]); ss += val[e] * val[e]; }
            if (X < 2) {
                ss += __shfl_xor(ss, 1); ss += __shfl_xor(ss, 2); ss += __shfl_xor(ss, 4);
                const float rn = rsqrtf(ss + 1e-6f) * (X == 0 ? QK_SCALE : 1.f);
#pragma unroll
                for (int e = 0; e < 16; ++e) val[e] *= rn;
            }
            if (X == 0) {
                *(LAS u32x4*)(QN + i * 136 + d0) = pack8(val); *(LAS u32x4*)(QN + i * 136 + d0 + 8) = pack8(val + 8);
                float qe[16];
#pragma unroll
                for (int e = 0; e < 16; ++e) qe[e] = val[e] * egi;
                bf16_t* qg = (bf16_t*)(gp + GP_QE) + i * 128 + (d0 & ~31) + ((d0 & 16) >> 2);
#pragma unroll
                for (int gq = 0; gq < 4; ++gq) { u32x2 w; w.x = pk2(qe[4 * gq], qe[4 * gq + 1]); w.y = pk2(qe[4 * gq + 2], qe[4 * gq + 3]); *(u32x2*)(qg + 8 * gq) = w; }
            } else if (X == 1) {
                *(LAS u32x4*)(KN + i * 136 + d0) = pack8(val); *(LAS u32x4*)(KN + i * 136 + d0 + 8) = pack8(val + 8);
#pragma unroll
                for (int e = 0; e < 16; ++e) { KBGT[(d0 + e) * 72 + i] = (bf16_t)f2bf(val[e] * bti * egi); KTT[(d0 + e) * 72 + kpos(i)] = (bf16_t)f2bf(val[e] * eki); }
            } else {
#pragma unroll
                for (int e = 0; e < 16; ++e) VBT[(d0 + e) * 72 + i] = (bf16_t)f2bf(val[e] * bti);
            }
        }
    }
    lds_barrier();
    {
        const int c = lane & 15, g = lane >> 4;
        bf16_t* at = (bf16_t*)(gp + GP_AT);
#pragma unroll
        for (int rep = 0; rep < 2; ++rep) {
            const int tt = wave + 8 * rep, ti = tt >> 2, tj = tt & 3;
            f32x4 a1 = {0.f, 0.f, 0.f, 0.f}, a2 = {0.f, 0.f, 0.f, 0.f};
            if (tj <= ti) { mma_nt<4>(a1, KN + 16 * ti * 136, 136, KN + 16 * tj * 136, 136, lane); mma_nt<4>(a2, QN + 16 * ti * 136, 136, KN + 16 * tj * 136, 136, lane); }
            const int j = 16 * tj + c; const float gcj = GC[j];
            const f32x4 gci = *(const LAS f32x4*)(GC + 16 * ti + 4 * g), bti4 = *(const LAS f32x4*)(BT + 16 * ti + 4 * g);
            f32x4 av;
#pragma unroll
            for (int rr = 0; rr < 4; ++rr) {
                const int i = 16 * ti + 4 * g + rr;
                const float dec = (i >= j) ? __expf(gci[rr] - gcj) : 0.f;
                const float aij = (i > j) ? a1[rr] * bti4[rr] * dec : 0.f;
                av[rr] = aij;
                if (ti >= 2 && tj < 2) AB[(i - 32) * 40 + j] = (bf16_t)f2bf(aij);
                at[i * 64 + kpos(j)] = (bf16_t)f2bf((i >= j) ? a2[rr] * dec : 0.f);
            }
            *(LAS f32x4*)(AM + j * 68 + 16 * ti + 4 * g) = av;
        }
    }
    lds_barrier();
    if (k + 1 < 16) {
        GP_LOADPRE(GP_ITEM(k + 1));
        if (wave == 1) { LAS float* GCn = (k & 1) ? GCB : (LAS float*)(lds + 129024); GP_STEP0(GP_ITEM(k + 1), GCn); }
    }
    if (wave == 0) {
        const int half = lane >> 5, cl = lane & 31, c = lane & 15, g = lane >> 4;
        const LAS float* Ab = AM + (32 * half) * 68 + 32 * half;
        float sv[32];
#pragma unroll
        for (int i = 0; i < 32; ++i) sv[i] = (cl == i) ? 1.f : 0.f;
        f32x4 ca[8], cb[8];
#define SV_LD(dst, j) do { _Pragma("unroll") for (int q = ((j) + 1) / 4; q < 8; ++q) dst[q] = *(const LAS f32x4*)(Ab + (j) * 68 + 4 * q); asm volatile("" ::: "memory"); } while (0)
#define SV_FM(src, j) do { const float tj = sv[j]; _Pragma("unroll") for (int q = ((j) + 1) / 4; q < 8; ++q) _Pragma("unroll") for (int e = 0; e < 4; ++e) if (4 * q + e > (j)) sv[4 * q + e] -= src[q][e] * tj; \
        asm volatile("" : "+v"(sv[0]), "+v"(sv[1]), "+v"(sv[2]), "+v"(sv[3]), "+v"(sv[4]), "+v"(sv[5]), "+v"(sv[6]), "+v"(sv[7]), "+v"(sv[8]), "+v"(sv[9]), "+v"(sv[10]), "+v"(sv[11]), "+v"(sv[12]), "+v"(sv[13]), "+v"(sv[14]), "+v"(sv[15]) :: "memory"); \
        asm volatile("" : "+v"(sv[16]), "+v"(sv[17]), "+v"(sv[18]), "+v"(sv[19]), "+v"(sv[20]), "+v"(sv[21]), "+v"(sv[22]), "+v"(sv[23]), "+v"(sv[24]), "+v"(sv[25]), "+v"(sv[26]), "+v"(sv[27]), "+v"(sv[28]), "+v"(sv[29]), "+v"(sv[30]), "+v"(sv[31]) :: "memory"); } while (0)
        SV_LD(ca, 0);
#pragma unroll
        for (int j = 0; j < 30; j += 2) {
            SV_LD(cb, j + 1); SV_FM(ca, j);
            SV_LD(ca, j + 2); SV_FM(cb, j + 1);
        }
        SV_FM(ca, 30);
#undef SV_LD
#undef SV_FM
#pragma unroll
        for (int i = 0; i < 32; ++i) TM[(32 * half + i) * 72 + 32 * half + cl] = (bf16_t)f2bf(sv[i]);
        if (half == 0) {
#pragma unroll
            for (int i = 0; i < 32; ++i) TM[i * 72 + 32 + cl] = (bf16_t)0;
#pragma unroll
            for (int q = 0; q < 4; ++q) { u32x4 w; w.x = pk2(sv[8 * q], sv[8 * q + 1]); w.y = pk2(sv[8 * q + 2], sv[8 * q + 3]); w.z = pk2(sv[8 * q + 4], sv[8 * q + 5]); w.w = pk2(sv[8 * q + 6], sv[8 * q + 7]); *(LAS u32x4*)(T11T + cl * 40 + 8 * q) = w; }
        }
        asm volatile("s_waitcnt lgkmcnt(0)" ::: "memory");
        f32x4 X[2][2];
#pragma unroll
        for (int t2 = 0; t2 < 2; ++t2)
#pragma unroll
            for (int tc = 0; tc < 2; ++tc) { X[t2][tc] = (f32x4){0.f, 0.f, 0.f, 0.f}; mma_nt<1>(X[t2][tc], AB + 16 * t2 * 40, 40, T11T + 16 * tc * 40, 40, lane); }
#pragma unroll
        for (int t2 = 0; t2 < 2; ++t2) {
            const LAS bf16_t* trow = TM + (32 + 16 * t2 + c) * 72 + 32 + 4 * g;
            const u32x2 lo = *(const LAS u32x2*)trow, hi = *(const LAS u32x2*)(trow + 16);
            const bf16x8 af = __builtin_bit_cast(bf16x8, (u32x4){lo.x, lo.y, hi.x, hi.y});
#pragma unroll
            for (int tc = 0; tc < 2; ++tc) {
                f32x4 acc = {0.f, 0.f, 0.f, 0.f};
                acc = __builtin_amdgcn_mfma_f32_16x16x32_bf16(af, pack_tiles(X[0][tc], X[1][tc]), acc, 0, 0, 0);
#pragma unroll
                for (int rr = 0; rr < 4; ++rr) TM[(32 + 16 * t2 + 4 * g + rr) * 72 + 16 * tc + c] = (bf16_t)f2bf(-acc[rr]);
            }
        }
    }
    lds_barrier();
    {
        const int c = lane & 15, g = lane >> 4;
#pragma unroll
        for (int rep = 0; rep < 8; ++rep) {
            const int tt = wave * 8 + rep;
            f32x4 acc = {0.f, 0.f, 0.f, 0.f};
            if (tt < 32) {
                const int ti = tt >> 3, te = tt & 7;
                mma_nt<2>(acc, TM + 16 * ti * 72, 72, VBT + 16 * te * 72, 72, lane);
                u32x2 w; w.x = pk2(acc[0], acc[1]); w.y = pk2(acc[2], acc[3]);
                *(u32x2*)((bf16_t*)(gp + GP_UT) + (16 * te + c) * 64 + 16 * ti + 4 * g) = w;
            } else {
                const int t2 = tt - 32, ti = t2 >> 3, td = t2 & 7;
                mma_nt<2>(acc, KBGT + 16 * td * 72, 72, TM + 16 * ti * 72, 72, lane);
                u32x2 w; w.x = pk2(acc[0], acc[1]); w.y = pk2(acc[2], acc[3]);
                *(u32x2*)((bf16_t*)(gp + GP_W) + (16 * ti + c) * 128 + kpos(16 * td + 4 * g)) = w;
            }
        }
#pragma unroll
        for (int u = 0; u < 2; ++u) { const int q = tid + NTHR * u, d = q >> 3, part = q & 7; *(u32x4*)(gp + GP_KT + (size_t)q * 16) = *(const LAS u32x4*)(KTT + d * 72 + part * 8); }
    }
    lds_barrier();
    }
#undef GP_ITEM
#undef GP_STEP0
#undef GP_LOADPRE
}

__device__ __forceinline__ void ret_kv_item(LAS unsigned char* lds, int item, const bf16_t* proj, float* KV, int tid, int lane, int wave) {
    const int n = item & 31, bh = item >> 5, h = bh & 3, b = bh >> 2;
    const int t0 = n * 128; const size_t m0 = (size_t)b * T + t0;
    LAS bf16_t* VT = (LAS bf16_t*)lds;
    LAS bf16_t* KDT = (LAS bf16_t*)(lds + 69632);
    const float lg = __logf(1.f - exp2f(-5.f - (float)h));
    {
        const int j = tid >> 2, part = tid & 3, d0 = 16 * part;
        const bf16_t* kp = proj + (m0 + j) * NC + C_RK + h * 128 + d0;
        float lo[16], hi[16];
        unpack8(((const u32x4*)kp)[0], lo); unpack8(((const u32x4*)kp)[1], lo + 8); unpack8(((const u32x4*)(kp + 64))[0], hi); unpack8(((const u32x4*)(kp + 64))[1], hi + 8);
        rot16(lo, hi, t0 + j, d0);
        const float kdec = __expf(lg * (float)(127 - j)) * QK_SCALE;
#pragma unroll
        for (int e = 0; e < 16; ++e) { KDT[(d0 + e) * 136 + j] = (bf16_t)f2bf(lo[e] * kdec); KDT[(64 + d0 + e) * 136 + j] = (bf16_t)f2bf(hi[e] * kdec); }
        const int e0 = 64 * part;
        const u32x4* vp = (const u32x4*)(proj + (m0 + j) * NC + C_RV + h * 256 + e0);
#pragma unroll
        for (int q = 0; q < 8; ++q) { const u32x4 w = vp[q]; const unsigned ww[4] = {w.x, w.y, w.z, w.w};
#pragma unroll
            for (int p = 0; p < 4; ++p) { VT[(e0 + 8 * q + 2 * p) * 136 + j] = (bf16_t)(ww[p] & 0xffffu); VT[(e0 + 8 * q + 2 * p + 1) * 136 + j] = (bf16_t)(ww[p] >> 16); } }
    }
    lds_barrier();
    {
        const int c = lane & 15, g = lane >> 4;
        bf16_t* kv = (bf16_t*)KV + (size_t)item * 32768;
#pragma unroll
        for (int r2 = 0; r2 < 2; ++r2) {
            const int te = 2 * wave + r2;
#pragma unroll
            for (int td = 0; td < 8; ++td) {
                f32x4 acc = {0.f, 0.f, 0.f, 0.f};
                mma_nt<4>(acc, KDT + 16 * td * 136, 136, VT + 16 * te * 136, 136, lane);
                u32x2 w; w.x = pk2(acc[0], acc[1]); w.y = pk2(acc[2], acc[3]);
                *(u32x2*)(kv + (16 * te + c) * 128 + 16 * td + 4 * g) = w;
            }
        }
    }
    lds_barrier();
}

constexpr int SC_UT = 62464, SC_GL = 67072, SC_BUF = 67088;
__device__ __forceinline__ void gdn_scan_task(LAS unsigned char* lds, int s, int slice, const unsigned char* gprep, const float* glv, bf16_t* mixed, float* KV, int rs_blk, int tid, int lane, int wave) {
    const int b = s >> 3, h = s & 7;
    const int c = lane & 15, g = lane >> 4, e0 = 32 * slice + 16 * (wave & 1);
    u32x4 SU[8]; bf16x8 Sb[4];
#pragma unroll
    for (int td = 0; td < 8; ++td) SU[td] = (u32x4){0u, 0u, 0u, 0u};
#pragma unroll
    for (int q = 0; q < 4; ++q) Sb[q] = (bf16x8){0, 0, 0, 0, 0, 0, 0, 0};
    u32x4 pf[8];
    const unsigned char* gp0 = gprep + (size_t)(s * 64) * GP_BYTES;
#define SC_LOAD(gq) do { _Pragma("unroll") for (int u = 0; u < 2; ++u) { pf[u] = *(const u32x4*)((gq) + GP_W + (size_t)(tid + NTHR * u) * 16); pf[2 + u] = *(const u32x4*)((gq) + GP_QE + (size_t)(tid + NTHR * u) * 16); \
        pf[5 + u] = *(const u32x4*)((gq) + GP_KT + (size_t)(tid + NTHR * u) * 16); } pf[4] = *(const u32x4*)((gq) + GP_AT + (size_t)tid * 16); \
        if (tid >= 256) pf[7] = *(const u32x4*)((gq) + GP_UT + (size_t)(32 * slice + ((tid - 256) >> 3)) * 128 + ((tid - 256) & 7) * 16); } while (0)
#define SC_STORE(bufp, itm) do { if (tid >= 256) *(LAS u32x4*)((bufp) + SC_UT + ((tid - 256) >> 3) * 144 + ((tid - 256) & 7) * 16) = pf[7]; if (tid == 255) *(LAS float*)((bufp) + SC_GL) = glv[itm]; \
        _Pragma("unroll") for (int u = 0; u < 2; ++u) { const int q = tid + NTHR * u; \
        *(LAS u32x4*)((LAS bf16_t*)(bufp) + (q >> 4) * 136 + (q & 15) * 8) = pf[u]; *(LAS u32x4*)((LAS bf16_t*)((bufp) + 17408) + (q >> 4) * 136 + (q & 15) * 8) = pf[2 + u]; \
        *(LAS u32x4*)((LAS bf16_t*)((bufp) + 44032) + (q >> 3) * 72 + (q & 7) * 8) = pf[5 + u]; } \
        *(LAS u32x4*)((LAS bf16_t*)((bufp) + 34816) + (tid >> 3) * 72 + (tid & 7) * 8) = pf[4]; } while (0)
    SC_LOAD(gp0); SC_STORE(lds, s * 64); SC_LOAD(gp0 + GP_BYTES);
    lds_barrier();
    for (int n = 0; n < 64; ++n) {
        LAS unsigned char* cur = lds + (n & 1) * SC_BUF; LAS unsigned char* nxt = lds + ((n + 1) & 1) * SC_BUF;
        const unsigned char* gp = gp0 + (size_t)n * GP_BYTES;
        if (n >= 1 && tid >= 128 && tid < 384) {
            const int u = tid - 128;
            const LAS bf16_t* OLp = (const LAS bf16_t*)(lds + 2 * SC_BUF + ((n - 1) & 1) * 5120);
            *(u32x4*)(mixed + ((size_t)b * T + (n - 1) * 64 + (u >> 2)) * D + 1024 + h * 128 + 32 * slice + (u & 3) * 8) = *(const LAS u32x4*)(OLp + (u >> 2) * 40 + (u & 3) * 8);
        }
        if (n + 1 < 64) SC_STORE(nxt, s * 64 + n + 1);
        if (n + 2 < 64) SC_LOAD(gp + 2 * GP_BYTES);
        if (wave >= 2 && rs_blk >= 0 && n < 7) {
            const int u = tid - 128;
            if (n >= 1 && (n - 1) * 384 + u < 2048) {
                const int cp = rs_blk * 2048 + (n - 1) * 384 + u, stream = cp >> 14;
                const float dec = __expf(128.f * __logf(1.f - exp2f(-5.f - (float)(stream & 3))));
                unsigned* p = (unsigned*)((bf16_t*)KV + (size_t)stream * 32 * 32768) + (cp & 16383);
                float st0 = 0.f, st1 = 0.f;
#pragma unroll
                for (int i = 0; i < 32; ++i) { const unsigned w = SU[i >> 2][i & 3]; p[(size_t)i * 16384] = pk2(st0, st1); st0 = st0 * dec + bflo(w); st1 = st1 * dec + bfhi(w); }
            }
            if (n < 6 && n * 384 + u < 2048) {
                const int cp = rs_blk * 2048 + n * 384 + u, stream = cp >> 14;
                const unsigned* p = (const unsigned*)((const bf16_t*)KV + (size_t)stream * 32 * 32768) + (cp & 16383);
#pragma unroll
                for (int i = 0; i < 32; ++i) SU[i >> 2][i & 3] = p[(size_t)i * 16384];
            }
        }
        if (wave < 2) {
            const LAS bf16_t* WL = (const LAS bf16_t*)cur; const LAS bf16_t* QE = (const LAS bf16_t*)(cur + 17408); const LAS bf16_t* AT = (const LAS bf16_t*)(cur + 34816); const LAS bf16_t* KT = (const LAS bf16_t*)(cur + 44032);
            const size_t m0 = (size_t)b * T + n * 64;
            const float gl = *(const LAS float*)(cur + SC_GL);
#define SC_SB __builtin_amdgcn_sched_barrier(0)
#define SC_LDP(dst, ti) do { _Pragma("unroll") for (int q = 0; q < 4; ++q) { dst[q] = *(const LAS bf16x8*)(WL + (16 * (ti) + c) * 136 + 32 * q + 8 * g); dst[4 + q] = *(const LAS bf16x8*)(QE + (16 * (ti) + c) * 136 + 32 * q + 8 * g); } } while (0)
#define SC_MMP(src, ti) do { _Pragma("unroll") for (int q = 0; q < 4; ++q) { P[ti] = __builtin_amdgcn_mfma_f32_16x16x32_bf16(src[q], Sb[q], P[ti], 0, 0, 0); O[ti] = __builtin_amdgcn_mfma_f32_16x16x32_bf16(src[4 + q], Sb[q], O[ti], 0, 0, 0); } } while (0)
#define SC_LDK(dst, t0) do { _Pragma("unroll") for (int t = 0; t < 4; ++t) _Pragma("unroll") for (int q = 0; q < 2; ++q) dst[2 * t + q] = *(const LAS bf16x8*)(KT + (16 * ((t0) + t) + c) * 72 + 32 * q + 8 * g); } while (0)
#define SC_MMK(src, t0) do { _Pragma("unroll") for (int t = 0; t < 4; ++t) { f32x4 a = __builtin_bit_cast(f32x4, SU[(t0) + t]) * gl; _Pragma("unroll") for (int q = 0; q < 2; ++q) a = __builtin_amdgcn_mfma_f32_16x16x32_bf16(src[2 * t + q], Vb[q], a, 0, 0, 0); SU[(t0) + t] = __builtin_bit_cast(u32x4, a); } } while (0)
            f32x4 P[4], O[4];
#pragma unroll
            for (int ti = 0; ti < 4; ++ti) { P[ti] = (f32x4){0.f, 0.f, 0.f, 0.f}; O[ti] = (f32x4){0.f, 0.f, 0.f, 0.f}; }
            bf16x8 fa[8], fb[8];
            SC_LDP(fa, 0);
            SC_LDP(fb, 1); SC_SB; SC_MMP(fa, 0); SC_SB;
            SC_LDP(fa, 2); SC_SB; SC_MMP(fb, 1); SC_SB;
            SC_LDP(fb, 3); SC_SB; SC_MMP(fa, 2); SC_SB;
#pragma unroll
            for (int ti = 0; ti < 4; ++ti)
#pragma unroll
                for (int q = 0; q < 2; ++q) fa[2 * ti + q] = *(const LAS bf16x8*)(AT + (16 * ti + c) * 72 + 32 * q + 8 * g);
            SC_SB; SC_MMP(fb, 3); SC_SB;
            u32x2 ut[4];
#pragma unroll
            for (int ti = 0; ti < 4; ++ti) ut[ti] = *(const LAS u32x2*)((const LAS bf16_t*)(cur + SC_UT) + (16 * (wave & 1) + c) * 72 + 16 * ti + 4 * g);
            f32x4 vn[4];
#pragma unroll
            for (int ti = 0; ti < 4; ++ti) vn[ti] = (f32x4){bflo(ut[ti].x) - P[ti][0], bfhi(ut[ti].x) - P[ti][1], bflo(ut[ti].y) - P[ti][2], bfhi(ut[ti].y) - P[ti][3]};
            bf16x8 Vb[2];
            Vb[0] = pack_tiles(vn[0], vn[1]); Vb[1] = pack_tiles(vn[2], vn[3]);
            SC_LDK(fb, 0); SC_SB;
#pragma unroll
            for (int ti = 0; ti < 4; ++ti)
#pragma unroll
                for (int q = 0; q < 2; ++q) O[ti] = __builtin_amdgcn_mfma_f32_16x16x32_bf16(fa[2 * ti + q], Vb[q], O[ti], 0, 0, 0);
            SC_SB;
            SC_LDK(fa, 4); SC_SB; SC_MMK(fb, 0); SC_SB;
            SC_MMK(fa, 4);
#undef SC_SB
#undef SC_LDP
#undef SC_MMP
#undef SC_LDK
#undef SC_MMK
#pragma unroll
            for (int q = 0; q < 4; ++q) Sb[q] = pack_tiles(__builtin_bit_cast(f32x4, SU[2 * q]), __builtin_bit_cast(f32x4, SU[2 * q + 1]));
            LAS bf16_t* OL = (LAS bf16_t*)(lds + 2 * SC_BUF + (n & 1) * 5120) + (4 * g) * 40 + 16 * (wave & 1) + c;
#pragma unroll
            for (int ti = 0; ti < 4; ++ti)
#pragma unroll
                for (int rr = 0; rr < 4; ++rr) OL[(16 * ti + rr) * 40] = (bf16_t)f2bf(O[ti][rr]);
        }
        lds_barrier();
    }
    if (tid >= 128 && tid < 384) {
        const int u = tid - 128;
        const LAS bf16_t* OLp = (const LAS bf16_t*)(lds + 2 * SC_BUF + 5120);
        *(u32x4*)(mixed + ((size_t)b * T + 63 * 64 + (u >> 2)) * D + 1024 + h * 128 + 32 * slice + (u & 3) * 8) = *(const LAS u32x4*)(OLp + (u >> 2) * 40 + (u & 3) * 8);
    }
    lds_barrier();
#undef SC_LOAD
#undef SC_STORE
}
__device__ __forceinline__ void gdn_norm_rows(const bf16_t* proj, const float* norm_w, bf16_t* mixed, int lane, int wave, int G) {
    const int gw = blockIdx.x * NWAVES + wave, NGW = G * NWAVES;
    float nw[16];
#pragma unroll
    for (int q = 0; q < 4; ++q) { const f32x4 w = *(const f32x4*)(norm_w + (lane & 7) * 16 + 4 * q); nw[4 * q] = w[0]; nw[4 * q + 1] = w[1]; nw[4 * q + 2] = w[2]; nw[4 * q + 3] = w[3]; }
    for (int m = gw; m < M; m += NGW) {
        bf16_t* op = mixed + (size_t)m * D + 1024 + lane * 16;
        const bf16_t* gq = proj + (size_t)m * NC + C_GG + lane * 16;
        float o[16], gg[16];
        unpack8(((const u32x4*)op)[0], o); unpack8(((const u32x4*)op)[1], o + 8); unpack8(__builtin_nontemporal_load((const u32x4*)gq), gg); unpack8(__builtin_nontemporal_load((const u32x4*)gq + 1), gg + 8);
        float ss = 0.f;
#pragma unroll
        for (int e = 0; e < 16; ++e) ss += o[e] * o[e];
        ss += __shfl_xor(ss, 1); ss += __shfl_xor(ss, 2); ss += __shfl_xor(ss, 4);
        const float rstd = rsqrtf(ss * (1.f / 128.f) + 1e-6f);
#pragma unroll
        for (int e = 0; e < 16; ++e) o[e] = o[e] * rstd * nw[e] * silu_f(gg[e]);
        ((u32x4*)op)[0] = pack8(o); ((u32x4*)op)[1] = pack8(o + 8);
    }
}

__device__ __forceinline__ void ret_scan(float* KV, float* KVdst, int tid, int first_blk, int G) {
    const long nthreads = (long)(G - first_blk) * NTHR, gid = (long)(blockIdx.x - first_blk) * NTHR + tid;
    for (long cp = gid; cp < 32L * 16384; cp += nthreads) {
        const int stream = (int)(cp >> 14), h = stream & 3;
        const float dec = __expf(128.f * __logf(1.f - exp2f(-5.f - (float)h)));
        const unsigned* p = (const unsigned*)((const bf16_t*)KV + (size_t)stream * 32 * 32768) + (cp & 16383);
        unsigned* pd = (unsigned*)((bf16_t*)KVdst + (size_t)stream * 32 * 32768) + (cp & 16383);
        unsigned kv[32];
#pragma unroll
        for (int n = 0; n < 32; ++n) kv[n] = p[(size_t)n * 16384];
        float st0 = 0.f, st1 = 0.f;
#pragma unroll
        for (int n = 0; n < 32; ++n) { pd[(size_t)n * 16384] = pk2(st0, st1); st0 = st0 * dec + bflo(kv[n]); st1 = st1 * dec + bfhi(kv[n]); }
    }
}

__device__ __forceinline__ void ret_out_item(LAS unsigned char* lds, int item, const bf16_t* proj, const float* KV, const float* gn_w, const float* gn_b, bf16_t* mixed, int tid, int lane, int wave) {
    const int n = item & 31, bh = item >> 5, h = bh & 3, b = bh >> 2;
    const int t0 = n * 128; const size_t m0 = (size_t)b * T + t0;
    LAS bf16_t* QS = (LAS bf16_t*)lds;
    LAS bf16_t* KD = (LAS bf16_t*)(lds + 34816);
    LAS bf16_t* VT = (LAS bf16_t*)(lds + 69632);
    LAS bf16_t* ST = (LAS bf16_t*)(lds + 104448);
    const float lg = __logf(1.f - exp2f(-5.f - (float)h));
    const int c = lane & 15, g = lane >> 4;
    {
        const int j = tid >> 2, part = tid & 3, d0 = 16 * part;
        float lo[16], hi[16];
        const bf16_t* qp = proj + (m0 + j) * NC + C_RQ + h * 128 + d0;
        unpack8(((const u32x4*)qp)[0], lo); unpack8(((const u32x4*)qp)[1], lo + 8); unpack8(((const u32x4*)(qp + 64))[0], hi); unpack8(((const u32x4*)(qp + 64))[1], hi + 8);
        rot16(lo, hi, t0 + j, d0);
        *(LAS u32x4*)(QS + j * 136 + d0) = pack8(lo); *(LAS u32x4*)(QS + j * 136 + d0 + 8) = pack8(lo + 8);
        *(LAS u32x4*)(QS + j * 136 + 64 + d0) = pack8(hi); *(LAS u32x4*)(QS + j * 136 + 64 + d0 + 8) = pack8(hi + 8);
        const bf16_t* kp = proj + (m0 + j) * NC + C_RK + h * 128 + d0;
        unpack8(((const u32x4*)kp)[0], lo); unpack8(((const u32x4*)kp)[1], lo + 8); unpack8(((const u32x4*)(kp + 64))[0], hi); unpack8(((const u32x4*)(kp + 64))[1], hi + 8);
        rot16(lo, hi, t0 + j, d0);
#pragma unroll
        for (int e = 0; e < 16; ++e) { lo[e] *= QK_SCALE; hi[e] *= QK_SCALE; }
        *(LAS u32x4*)(KD + j * 136 + d0) = pack8(lo); *(LAS u32x4*)(KD + j * 136 + d0 + 8) = pack8(lo + 8);
        *(LAS u32x4*)(KD + j * 136 + 64 + d0) = pack8(hi); *(LAS u32x4*)(KD + j * 136 + 64 + d0 + 8) = pack8(hi + 8);
    }
    lds_barrier();
    f32x4 sc[8];
#pragma unroll
    for (int tj = 0; tj < 8; ++tj) { sc[tj] = (f32x4){0.f, 0.f, 0.f, 0.f}; if (tj <= wave) mma_nt<4>(sc[tj], QS + 16 * wave * 136, 136, KD + 16 * tj * 136, 136, lane); }
    lds_barrier();
#pragma unroll
    for (int tj = 0; tj < 8; ++tj) {
        const int j = 16 * tj + c; const float gpw = __expf(-lg * (float)(j + 1));
#pragma unroll
        for (int rr = 0; rr < 4; ++rr) { const int i = 16 * wave + 4 * g + rr; KD[i * 136 + j] = (bf16_t)f2bf((i >= j) ? sc[tj][rr] * gpw : 0.f); }
    }
    f32x4 acc[16];
#pragma unroll
    for (int half = 0; half < 2; ++half) {
        if (half == 1) lds_barrier();
        {
            const int j = tid >> 2, part = tid & 3, e0 = 32 * part;
            const u32x4* vp = (const u32x4*)(proj + (m0 + j) * NC + C_RV + h * 256 + half * 128 + e0);
#pragma unroll
            for (int q = 0; q < 4; ++q) { const u32x4 w = vp[q]; const unsigned ww[4] = {w.x, w.y, w.z, w.w};
#pragma unroll
                for (int p = 0; p < 4; ++p) { VT[(e0 + 8 * q + 2 * p) * 136 + j] = (bf16_t)(ww[p] & 0xffffu); VT[(e0 + 8 * q + 2 * p + 1) * 136 + j] = (bf16_t)(ww[p] >> 16); } }
            const bf16_t* kv = (const bf16_t*)KV + (size_t)item * 32768 + (size_t)half * 128 * 128;
#pragma unroll
            for (int u = 0; u < 4; ++u) { const int q = tid + NTHR * u, e = q >> 4, part = q & 15; *(LAS u32x4*)(ST + e * 136 + part * 8) = *(const u32x4*)(kv + e * 128 + part * 8); }
        }
        lds_barrier();
#pragma unroll
        for (int te = 0; te < 8; ++te) {
            f32x4 a = {0.f, 0.f, 0.f, 0.f};
            mma_nt<4>(a, VT + 16 * te * 136, 136, KD + 16 * wave * 136, 136, lane);
            mma_nt<4>(a, ST + 16 * te * 136, 136, QS + 16 * wave * 136, 136, lane);
            acc[half * 8 + te] = a;
        }
    }
    {
        const int i = 16 * wave + c;
        const float qd = __expf(lg * (float)(i + 1));
        float sm = 0.f;
#pragma unroll
        for (int t = 0; t < 16; ++t) { acc[t] = acc[t] * qd; sm += (acc[t][0] + acc[t][1]) + (acc[t][2] + acc[t][3]); }
        sm += __shfl_xor(sm, 16); sm += __shfl_xor(sm, 32);
        const float mean = sm * (1.f / 256.f);
        float v = 0.f;
#pragma unroll
        for (int t = 0; t < 16; ++t) { acc[t] = acc[t] - mean; v += (acc[t][0] * acc[t][0] + acc[t][1] * acc[t][1]) + (acc[t][2] * acc[t][2] + acc[t][3] * acc[t][3]); }
        v += __shfl_xor(v, 16); v += __shfl_xor(v, 32);
        const float rstd = rsqrtf(v * (1.f / 256.f) + 1e-5f);
        const bf16_t* rg = proj + (m0 + i) * NC + C_RG + h * 256 + 4 * g;
        bf16_t* mo = mixed + (m0 + i) * D + h * 256 + 4 * g;
        const float* gw_ = gn_w + h * 256 + 4 * g; const float* gb_ = gn_b + h * 256 + 4 * g;
#pragma unroll
        for (int t = 0; t < 16; ++t) {
            const u32x2 rgv = *(const u32x2*)(rg + 16 * t);
            const f32x4 w4 = *(const f32x4*)(gw_ + 16 * t), b4 = *(const f32x4*)(gb_ + 16 * t);
            const f32x4 o = acc[t] * rstd * w4 + b4;
            u32x2 w; w.x = pk2(o[0] * silu_f(bflo(rgv.x)), o[1] * silu_f(bfhi(rgv.x))); w.y = pk2(o[2] * silu_f(bflo(rgv.y)), o[3] * silu_f(bfhi(rgv.y)));
            *(u32x2*)(mo + 16 * t) = w;
        }
    }
    lds_barrier();
}

__device__ __forceinline__ void ln_rows(const bf16_t* z, float* dst, const float* ln_w, const float* ln_b, int lane, int wave, int G) {
    const int gw = blockIdx.x * NWAVES + wave, NGW = G * NWAVES;
    for (int m = gw; m < M; m += NGW) {
        const u32x4* zr = (const u32x4*)(z + (size_t)m * D) + lane;
        float v[4][8]; float s = 0.f;
#pragma unroll
        for (int j = 0; j < 4; ++j) { unpack8(__builtin_nontemporal_load(zr + 64 * j), v[j]);
#pragma unroll
            for (int e = 0; e < 8; ++e) s += v[j][e]; }
        const float mean = wave_sum(s) * (1.f / D); float s2 = 0.f;
#pragma unroll
        for (int j = 0; j < 4; ++j)
#pragma unroll
            for (int e = 0; e < 8; ++e) { v[j][e] -= mean; s2 += v[j][e] * v[j][e]; }
        const float rstd = rsqrtf(wave_sum(s2) * (1.f / D) + 1e-5f);
        float* drow = dst + (size_t)m * D + 8 * lane;
#pragma unroll
        for (int j = 0; j < 4; ++j) {
            const f32x4 w0 = *(const f32x4*)(ln_w + 8 * lane + 512 * j), w1 = *(const f32x4*)(ln_w + 8 * lane + 512 * j + 4);
            const f32x4 b0 = *(const f32x4*)(ln_b + 8 * lane + 512 * j), b1 = *(const f32x4*)(ln_b + 8 * lane + 512 * j + 4);
            __builtin_nontemporal_store((f32x4){v[j][0], v[j][1], v[j][2], v[j][3]} * rstd * w0 + b0, (f32x4*)(drow + 512 * j));
            __builtin_nontemporal_store((f32x4){v[j][4], v[j][5], v[j][6], v[j][7]} * rstd * w1 + b1, (f32x4*)(drow + 512 * j + 4));
        }
    }
}

#ifndef MK_N_LAUNCHES
#define MK_N_LAUNCHES 1
#endif
constexpr int N_PHASES = 8;
constexpr size_t WS_CTL = 3 * MiB + 512 * 1024; constexpr int CTL_BYTES = 16384;
#define XB_TMO      128
#define XB_XCNT(j)  (256  + 64 * (j))
#define XB_XSUB(j)  (1280 + 64 * (j))
#define XB_XGEN(j)  (2304 + 64 * (j))
#define XB_TOP      3328
#define XB_TOPGEN   3392
#define XCD_BAR_WORDS 3456
#define XB_SPIN_CAP (1u << 18)

__device__ __forceinline__ unsigned xb_ld(unsigned* p)              { return __hip_atomic_load(p, __ATOMIC_RELAXED, __HIP_MEMORY_SCOPE_AGENT); }
__device__ __forceinline__ unsigned xb_add(unsigned* p, unsigned v) { return __hip_atomic_fetch_add(p, v, __ATOMIC_RELAXED, __HIP_MEMORY_SCOPE_AGENT); }
__device__ __forceinline__ unsigned xb_xcc_id() { return (unsigned)__builtin_amdgcn_s_getreg((3 << 11) | 20) & 0xFu; }
#define XB_SPIN(cond, bar) do { unsigned _sp = 0; while (cond) { __builtin_amdgcn_s_sleep(1); \
    if ((++_sp & 255u) == 0u) { if (xb_ld(&(bar)[XB_TMO])) break; if (_sp > XB_SPIN_CAP) { atomicAdd(&(bar)[XB_TMO], 1u); break; } } } } while (0)

struct XcdBarrier {
    unsigned* bar; unsigned x;
    volatile LAS unsigned* st;
};

__device__ __forceinline__ XcdBarrier xcd_barrier_post(unsigned* bar, volatile LAS unsigned* st) {
    XcdBarrier b; b.bar = bar; b.x = xb_xcc_id(); b.st = st;
    if (threadIdx.x == 0) (void)xb_add(&bar[XB_XCNT(b.x)], 1u);
    return b;
}
__device__ __forceinline__ void xcd_barrier_complete(unsigned* bar, unsigned x, unsigned& nloc, unsigned& nx) {
    const unsigned G = gridDim.x * gridDim.y * gridDim.z;
    unsigned sum, cnt, mine, sp = 0u;
    for (;;) {
        sum = 0u; cnt = 0u; mine = 0u;
#pragma unroll
        for (unsigned j = 0; j < 16; ++j) { const unsigned c = xb_ld(&bar[XB_XCNT(j)]); sum += c; cnt += (c > 0u) ? 1u : 0u; mine = (j == x) ? c : mine; }
        if (sum == G) break;
        __builtin_amdgcn_s_sleep(1);
        if ((++sp & 255u) == 0u) { if (xb_ld(&bar[XB_TMO])) break; if (sp > XB_SPIN_CAP) { atomicAdd(&bar[XB_TMO], 1u); break; } }
    }
    nloc = mine > 0u ? mine : 1u; nx = cnt > 0u ? cnt : 1u;
}

__device__ __forceinline__ void xcd_barrier(const XcdBarrier& b) {
    asm volatile("s_waitcnt vmcnt(0)" ::: "memory");
    __syncthreads();
    if (threadIdx.x == 0) {
        unsigned* bar = b.bar;
        __builtin_amdgcn_s_waitcnt(0);
        unsigned nloc = b.st[0], nx = b.st[1];
        if (nloc == 0u) { xcd_barrier_complete(bar, b.x, nloc, nx); b.st[0] = nloc; b.st[1] = nx; }
        const unsigned old = xb_add(&bar[XB_XSUB(b.x)], 1u);
        const unsigned gen = old / nloc;
        if (old + 1u == (gen + 1u) * nloc) {
            __builtin_amdgcn_fence(__ATOMIC_RELEASE, "agent");
            asm volatile("s_waitcnt vmcnt(0)" ::: "memory");
            const unsigned og = xb_add(&bar[XB_TOP], 1u);
            const unsigned tg = og / nx;
            if (og + 1u == (tg + 1u) * nx) xb_add(&bar[XB_TOPGEN], 1u);
            else XB_SPIN(xb_ld(&bar[XB_TOPGEN]) == tg, bar);
            __builtin_amdgcn_fence(__ATOMIC_ACQUIRE, "agent");
            xb_add(&bar[XB_XGEN(b.x)], 1u);
            asm volatile("s_waitcnt vmcnt(0)" ::: "memory");
        } else {
            XB_SPIN(xb_ld(&bar[XB_XGEN(b.x)]) == gen, bar);
            __builtin_amdgcn_fence(__ATOMIC_ACQUIRE, "agent");
            asm volatile("s_waitcnt vmcnt(0)" ::: "memory");
        }
    }
    __syncthreads();
}

struct Args { const float* in[14]; float* out; unsigned char* ws; int ph_lo, ph_hi, nsync, pad; };
__global__ void __launch_bounds__(NTHR) hybrid_fwd(Args args) {
    extern __shared__ __attribute__((aligned(16))) unsigned char lds_raw[];
    LAS unsigned char* lds = (LAS unsigned char*)lds_raw;
    cg::grid_group grid = cg::this_grid();
    const int tid = threadIdx.x, lane = tid & 63, wave = __builtin_amdgcn_readfirstlane(tid >> 6), G = gridDim.x;
    const float* x = args.in[0]; const float* cvec = args.in[1]; const float* w_ada = args.in[2]; const float* b_ada = args.in[3]; const float* w_in = args.in[4];
    const float* conv_w = args.in[5]; const float* a_log = args.in[6]; const float* dt_bias = args.in[7]; const float* gn_w = args.in[8]; const float* gn_b = args.in[9];
    const float* norm_w = args.in[10]; const float* w_out = args.in[11]; const float* ln_w = args.in[12]; const float* ln_b = args.in[13];
    unsigned char* ws = args.ws; float* out = args.out;
    float* mod = (float*)(ws + WS_MOD); float* gdec = (float*)(ws + WS_G); float* beta = (float*)(ws + WS_BETA); float* glv = (float*)(ws + WS_GL);
    bf16_t* WoutT = (bf16_t*)(ws + WS_WOUT); bf16_t* WinT = (bf16_t*)(ws + WS_WIN); bf16_t* hin = (bf16_t*)(ws + WS_HIN); bf16_t* mixed = hin;
    bf16_t* proj = (bf16_t*)(ws + WS_PROJ); unsigned char* gprep = ws + WS_GPREP; float* KV = out;
    const int lo = args.ph_lo, hi = args.ph_hi;
#define IN(k) (lo <= (k) && (k) < hi)
#define SEAM(k) do { if (IN(k) && IN((k) + 1)) xcd_barrier(bar); } while (0)

    volatile LAS unsigned* bst = (volatile LAS unsigned*)(lds + LDS_BYTES - 16);
    if (tid == 0) { bst[0] = 0u; bst[1] = 0u; }
    __syncthreads();
    XcdBarrier bar = xcd_barrier_post((unsigned*)(ws + WS_CTL), bst);
    for (int i = 0; i < args.nsync; ++i) grid.sync();
    if (IN(0)) p0_phase(lds, cvec, w_ada, b_ada, w_in, w_out, mod, WinT, WoutT, tid, lane, wave, G, 1);
    SEAM(0);
    if (IN(1)) p1_phase(lds, x, w_in, mod, a_log, dt_bias, hin, gdec, beta, tid, lane, wave, G, 1);
    SEAM(1);
    if (IN(2)) {
        pg8::Gemm g{hin, WinT, M, NC, D}; pg8::StaticOrder S; S.init(M, NC, G, (int)blockIdx.x, 1);
        pg8::EpiBf16 E{proj, NC};
        pg8::gemm_phase<pg8::EpiBf16, pg8::StaticOrder, true, true>(lds, g, S, E);
    }
    SEAM(2);
    if (IN(3)) {
        for (int v = blockIdx.x; v < 256; v += G) gdn_prep_block(lds, v & 255, proj, conv_w, gdec, beta, gprep, glv, tid, lane, wave);
        for (int it = blockIdx.x; it < 1024; it += G) ret_kv_item(lds, it & 1023, proj, KV, tid, lane, wave);
    }
    SEAM(3);
    if (IN(4)) {
        const bool fuse = (G == 256);
        for (int task = blockIdx.x; task < 256; task += G) { const int tk = task & 255, xcd = tk & 7, loc = tk >> 3; gdn_scan_task(lds, xcd * 8 + (loc >> 2), loc & 3, gprep, glv, mixed, KV, (fuse && task < 256) ? tk : -1, tid, lane, wave); }
        if (!fuse) ret_scan(KV, KV, tid, 0, G);
    }
    SEAM(4);
    if (IN(5)) { gdn_norm_rows(proj, norm_w, mixed, lane, wave, G);
        for (int it = blockIdx.x; it < 1024; it += G) ret_out_item(lds, it & 1023, proj, KV, gn_w, gn_b, mixed, tid, lane, wave); }
    SEAM(5);
    if (IN(6)) {
        pg8::Gemm g{mixed, WoutT, M, D, D}; pg8::StaticOrder S; S.init(M, D, G, (int)blockIdx.x, 1);
        pg8::EpiZ16 E{x, mod + 4096, (bf16_t*)(ws + WS_PROJ), 1.189207115002721f};
        pg8::gemm_phase<pg8::EpiZ16, pg8::StaticOrder, true, true>(lds, g, S, E);
    }
    SEAM(6);
    if (IN(7)) { ln_rows((const bf16_t*)(ws + WS_PROJ), out, ln_w, ln_b, lane, wave, G); }
#undef IN
#undef SEAM
}

extern "C" void kernel_launch(void* const* d_in, const int* in_sizes, int n_in, void* d_out, int out_size, void* d_ws, size_t ws_size, hipStream_t stream) {
    static int grid = 0;
    if (grid == 0) {
        if (n_in != 14 || out_size != M * D || ws_size < WS_END) { fprintf(stderr, "kernel_launch: unexpected problem (n_in %d, out %d, ws %zu)\n", n_in, out_size, ws_size); grid = -1; return; }
        int dev = 0, cus = 0, per_cu = 0;
        if (hipGetDevice(&dev) != hipSuccess || hipDeviceGetAttribute(&cus, hipDeviceAttributeMultiprocessorCount, dev) != hipSuccess) { grid = -1; return; }
        if (hipFuncSetAttribute((const void*)hybrid_fwd, hipFuncAttributeMaxDynamicSharedMemorySize, LDS_BYTES) != hipSuccess) { fprintf(stderr, "kernel_launch: hipFuncSetAttribute failed\n"); grid = -1; return; }
        if (hipOccupancyMaxActiveBlocksPerMultiprocessor(&per_cu, (const void*)hybrid_fwd, NTHR, LDS_BYTES) != hipSuccess || per_cu < 1) { fprintf(stderr, "kernel_launch: occupancy query reports %d blocks per CU\n", per_cu); (void)hipGetLastError(); per_cu = 1; }
        grid = cus * 1;
    }
    if (grid < 0) return;
    if (hipMemsetAsync((char*)d_ws + WS_CTL, 0, CTL_BYTES, stream) != hipSuccess) { fprintf(stderr, "kernel_launch: memset of the barrier words failed\n"); return; }
    Args a{};
    for (int i = 0; i < 14; ++i) a.in[i] = (const float*)d_in[i];
    a.out = (float*)d_out; a.ws = (unsigned char*)d_ws; a.nsync = 0;
    for (int li = 0; li < MK_N_LAUNCHES; ++li) {
        if (MK_N_LAUNCHES == 1) { a.ph_lo = 0; a.ph_hi = N_PHASES; } else { a.ph_lo = li; a.ph_hi = li + 1; }
        void* kargs[] = {&a};
        const hipError_t e = hipLaunchCooperativeKernel((const void*)hybrid_fwd, dim3(grid), dim3(NTHR), kargs, LDS_BYTES, stream);
        if (e != hipSuccess) { fprintf(stderr, "kernel_launch: cooperative launch failed: %s (grid %d)\n", hipGetErrorString(e), grid); break; }
    }
}
```

```cpp
#include <hip/hip_runtime.h>
#include <hip/hip_cooperative_groups.h>
#include <cstdio>
#include <cstdint>
namespace cg = cooperative_groups;
namespace pg8 {
#define PG8_LAS __attribute__((address_space(3)))
typedef unsigned short bf16_t;
typedef short bf16x8 __attribute__((ext_vector_type(8)));
typedef float f32x4 __attribute__((ext_vector_type(4)));
typedef unsigned u32x4 __attribute__((ext_vector_type(4)));
constexpr int BM = 256, BK = 64, HALF = 128, HTB = HALF * BK * 2  , STAGE_BYTES = 8 * HTB, NXCD = 8, WGM = 8;

__host__ __device__ __forceinline__ int lds_byte(int r, int c) { const int st = (r >> 4) * 2 + (c >> 5), rr = r & 15, cc = c & 31, ob = rr * 64 + cc * 2; return st * 1024 + (ob ^ (((ob >> 9) & 1) << 5)); }
__host__ __device__ __forceinline__ void stage_rc(int b, int& R, int& C) { const int st = b / 1024, sb = b % 1024, swz = sb ^ (((sb >> 9) & 1) << 5); R = (st >> 1) * 16 + swz / 64; C = (st & 1) * 32 + (swz % 64) / 2; }
__host__ __device__ __forceinline__ int perm32(int rho) { const int n = rho >> 4, i = rho & 15; return 8 * (i >> 2) + 4 * n + (i & 3); }

struct Unit { int pm, pn; };
struct Gemm { const bf16_t* A; const bf16_t* Bt; int M, N, K; };

struct StaticOrder {
    int nM, nN, nwg, G, c, nrep;
    __host__ __device__ void init(int M, int N, int G_, int c_, int nrep_ = 1) { nM = M / BM; nN = N / BM; nwg = nM * nN; G = G_; c = c_; nrep = nrep_; }
    __host__ __device__ bool next(int i, Unit& u) const {
        const long L = (long)i * G + c; if (L >= (long)nwg * nrep) return false;
        int wgid = (int)(L % nwg); { const int q = nwg / NXCD, r = nwg % NXCD, xcd = wgid % NXCD, off = wgid / NXCD; wgid = (xcd < r ? xcd * (q + 1) : r * (q + 1) + (xcd - r) * q) + off; }
        const int nig = WGM * nN, gid = wgid / nig, fm = gid * WGM, gsz = (nM - fm) < WGM ? (nM - fm) : WGM;
        u.pm = fm + ((wgid % nig) % gsz); u.pn = (wgid % nig) / gsz; return true;
    }
    __device__ __forceinline__ void a_ready(const Unit&) const {}
    __device__ __forceinline__ void done(const Unit&) const {}
};

__device__ __forceinline__ unsigned cvt_pk_bf16(float lo, float hi) { unsigned r; asm volatile("v_cvt_pk_bf16_f32 %0, %1, %2" : "=v"(r) : "v"(lo), "v"(hi)); return r; }
struct EpiBf16 {
    static constexpr bool PERM = true, AFTER_DRAIN = false;
    bf16_t* O; int ldc;
    __device__ __forceinline__ void operator()(const f32x4 (&acc)[2][2][4][2], const Unit& u, int wr, int wc, int fr, int fq) const {
        const int row0 = u.pm * BM + wr * 64 + fr; const int col0 = u.pn * BM + wc * 32 + 8 * fq;
#pragma unroll
        for (int ai = 0; ai < 2; ++ai)
#pragma unroll
            for (int m = 0; m < 4; ++m) { bf16_t* rowp = O + (size_t)(row0 + ai * HALF + m * 16) * ldc + col0;
#pragma unroll
                for (int bj = 0; bj < 2; ++bj) { const f32x4 v0 = acc[ai][bj][m][0], v1 = acc[ai][bj][m][1];
                    u32x4 w; w.x = cvt_pk_bf16(v0[0], v0[1]); w.y = cvt_pk_bf16(v0[2], v0[3]); w.z = cvt_pk_bf16(v1[0], v1[1]); w.w = cvt_pk_bf16(v1[2], v1[3]);
                    *(u32x4*)(rowp + bj * HALF) = w; } }
    }
};
struct EpiZ {
    static constexpr bool PERM = false, AFTER_DRAIN = false;
    const float* x; const float* gate; float* out; float alpha;
    __device__ __forceinline__ void operator()(const f32x4 (&acc)[2][2][4][2], const Unit& u, int wr, int wc, int fr, int fq) const {
        const int col0 = u.pn * BM + wc * 32 + 4 * fq;
#pragma unroll
        for (int ai = 0; ai < 2; ++ai)
#pragma unroll
            for (int m = 0; m < 4; ++m) { const int r = u.pm * BM + ai * HALF + wr * 64 + m * 16 + fr; const size_t off = (size_t)r * 2048 + col0; const float* gb = gate + (size_t)(r >> 12) * 6144 + col0;
#pragma unroll
                for (int bj = 0; bj < 2; ++bj)
#pragma unroll
                    for (int n = 0; n < 2; ++n) { const f32x4 xv = *(const f32x4*)(x + off + bj * HALF + n * 16); const f32x4 gv = *(const f32x4*)(gb + bj * HALF + n * 16);
                        *(f32x4*)(out + off + bj * HALF + n * 16) = xv * alpha + gv * acc[ai][bj][m][n]; } }
    }
};
struct EpiZ16 {
    static constexpr bool PERM = true, AFTER_DRAIN = false;
    const float* x; const float* gate; bf16_t* z; float alpha;
    __device__ __forceinline__ void operator()(const f32x4 (&acc)[2][2][4][2], const Unit& u, int wr, int wc, int fr, int fq) const {
        const int col0 = u.pn * BM + wc * 32 + 8 * fq;
        const float* gb = gate + (size_t)((u.pm * BM) >> 12) * 6144 + col0;
        const f32x4 g00 = *(const f32x4*)(gb), g01 = *(const f32x4*)(gb + 4), g10 = *(const f32x4*)(gb + HALF), g11 = *(const f32x4*)(gb + HALF + 4);
#pragma unroll
        for (int ai = 0; ai < 2; ++ai)
#pragma unroll
            for (int m = 0; m < 4; ++m) { const int r = u.pm * BM + ai * HALF + wr * 64 + m * 16 + fr; const size_t off = (size_t)r * 2048 + col0;
#pragma unroll
                for (int bj = 0; bj < 2; ++bj) {
                    const f32x4 x0 = __builtin_nontemporal_load((const f32x4*)(x + off + bj * HALF)), x1 = __builtin_nontemporal_load((const f32x4*)(x + off + bj * HALF + 4));
                    const f32x4 v0 = x0 * alpha + (bj ? g10 : g00) * acc[ai][bj][m][0], v1 = x1 * alpha + (bj ? g11 : g01) * acc[ai][bj][m][1];
                    u32x4 w; w.x = cvt_pk_bf16(v0[0], v0[1]); w.y = cvt_pk_bf16(v0[2], v0[3]); w.z = cvt_pk_bf16(v1[0], v1[1]); w.w = cvt_pk_bf16(v1[2], v1[3]);
                    *(u32x4*)(z + off + bj * HALF) = w; } }
    }
};
template <class Epi, class Sched, bool ALIGN_EPI = false, bool SP2 = false>
__device__ __forceinline__ void gemm_phase(PG8_LAS unsigned char* lds, const Gemm g, const Sched& S, const Epi& E) {
    const int tid = threadIdx.x, wid = __builtin_amdgcn_readfirstlane(tid >> 6), lane = tid & 63, wr = wid >> 2, wc = wid & 3, fr = lane & 15, fq = lane >> 4;
    const int K = g.K, nt = K / BK;
    unsigned voffA[2], voffB[2];
#pragma unroll
    for (int i = 0; i < 2; ++i) { int R, C; stage_rc(tid * 16 + i * 8192, R, C); const int Rb = Epi::PERM ? ((R & ~31) + perm32(R & 31)) : R;
        voffA[i] = (unsigned)(R * K + C) * 2u; voffB[i] = (unsigned)(Rb * K + C) * 2u; }
    const size_t kstep = (size_t)(BK * 2);
    const size_t hstep = (size_t)HALF * K * 2;
    const size_t tstep = 2 * hstep;
    const unsigned ldsw = (unsigned)wid * 1024u;
    const int aoff = lds_byte(wr * 64 + fr, fq * 8), boff = lds_byte(wc * 32 + fr, fq * 8);
#define PG8_SA(b, h) (((b) * 2 + (h)) * HTB)
#define PG8_SB(b, h) ((4 + (b) * 2 + (h)) * HTB)
#define PG8_STAGE(bufoff, gbase, voff) do { _Pragma("unroll") for (int _i = 0; _i < 2; ++_i) \
        __builtin_amdgcn_global_load_lds((const unsigned*)((const char*)(gbase) + (voff)[_i]), (PG8_LAS unsigned*)(lds + (bufoff) + ldsw + _i * 8192), 16, 0, 0); } while (0)
#define PG8_LDA(dst, b, h) do { _Pragma("unroll") for (int m = 0; m < 4; ++m) _Pragma("unroll") for (int k = 0; k < 2; ++k) dst[m][k] = *(const PG8_LAS bf16x8*)(lds + PG8_SA(b, h) + aoff + m * 2048 + k * 1024); } while (0)
#define PG8_LDB(dst, b, h) do { _Pragma("unroll") for (int n = 0; n < 2; ++n) _Pragma("unroll") for (int k = 0; k < 2; ++k) dst[n][k] = *(const PG8_LAS bf16x8*)(lds + PG8_SB(b, h) + boff + n * 2048 + k * 1024); } while (0)
#define PG8_MMA(ai, bj, At, Bt) do { __builtin_amdgcn_s_setprio(1); _Pragma("unroll") for (int m = 0; m < 4; ++m) _Pragma("unroll") for (int n = 0; n < 2; ++n) _Pragma("unroll") for (int k = 0; k < 2; ++k) \
        acc[ai][bj][m][n] = __builtin_amdgcn_mfma_f32_16x16x32_bf16(Bt[n][k], At[m][k], acc[ai][bj][m][n], 0, 0, 0); __builtin_amdgcn_s_setprio(0); } while (0)
#define PG8_WAIT_V(n) asm volatile("s_waitcnt vmcnt(" #n ")" ::: "memory")
#define PG8_WAIT_L(n) asm volatile("s_waitcnt lgkmcnt(" #n ")" ::: "memory")
#define PG8_BAR __builtin_amdgcn_s_barrier()
#define PG8_SCHED __builtin_amdgcn_sched_barrier(0)
    Unit cur, nxt; int ui = 0;
    if (!S.next(0, cur)) return;
    f32x4 acc[2][2][4][2];
#pragma unroll
    for (int a = 0; a < 2; ++a)
#pragma unroll
        for (int b = 0; b < 2; ++b)
#pragma unroll
            for (int m = 0; m < 4; ++m)
#pragma unroll
                for (int n = 0; n < 2; ++n) acc[a][b][m][n] = (f32x4){0.f, 0.f, 0.f, 0.f};
    bf16x8 At[4][2], B0[2][2], B1[2][2];
    const char* cA = (const char*)g.A + (size_t)cur.pm * tstep; const char* cB = (const char*)g.Bt + (size_t)cur.pn * tstep;
    S.a_ready(cur);
    if constexpr (SP2) {
        PG8_STAGE(PG8_SB(0, 0), cB, voffB); PG8_STAGE(PG8_SB(0, 1), cB + hstep, voffB); PG8_STAGE(PG8_SA(0, 0), cA, voffA); PG8_STAGE(PG8_SA(0, 1), cA + hstep, voffA);
        if (wr == 1) PG8_BAR;
        PG8_WAIT_V(2); PG8_BAR;
        PG8_STAGE(PG8_SB(1, 0), cB + kstep, voffB); PG8_STAGE(PG8_SA(1, 0), cA + kstep, voffA); PG8_STAGE(PG8_SB(1, 1), cB + hstep + kstep, voffB);
        PG8_WAIT_V(6); PG8_BAR;
    } else {
        PG8_STAGE(PG8_SB(0, 0), cB, voffB); PG8_STAGE(PG8_SA(0, 0), cA, voffA); PG8_STAGE(PG8_SB(0, 1), cB + hstep, voffB); PG8_STAGE(PG8_SA(0, 1), cA + hstep, voffA);
        if (wr == 1) PG8_BAR;
        PG8_WAIT_V(4); PG8_BAR;
        PG8_STAGE(PG8_SB(1, 0), cB + kstep, voffB); PG8_STAGE(PG8_SA(1, 0), cA + kstep, voffA); PG8_STAGE(PG8_SB(1, 1), cB + hstep + kstep, voffB);
        PG8_WAIT_V(6); PG8_BAR;
    }
    for (;;) {
        const bool has_next = S.next(ui + 1, nxt);
        const char* nA = has_next ? (const char*)g.A + (size_t)nxt.pm * tstep : cA; const char* nB = has_next ? (const char*)g.Bt + (size_t)nxt.pn * tstep : cB;
        for (int t = 0; t < nt; t += 2) {
            const bool last = (t == nt - 2);
            const char* a1 = cA + (size_t)(t + 1) * kstep;
            const char* a2 = last ? nA : cA + (size_t)(t + 2) * kstep; const char* b2 = last ? nB : cB + (size_t)(t + 2) * kstep;
            const char* a3 = a2 + kstep; const char* b3 = b2 + kstep;
            if (last && has_next) S.a_ready(nxt);
            if constexpr (SP2) {
            PG8_LDB(B0, 0, 0); PG8_LDB(B1, 0, 1); PG8_SCHED; PG8_LDA(At, 0, 0); PG8_STAGE(PG8_SA(1, 1), a1 + hstep, voffA);
            PG8_WAIT_V(8); PG8_WAIT_L(0); PG8_BAR; PG8_MMA(0, 0, At, B0); PG8_MMA(0, 1, At, B1); PG8_BAR; PG8_SCHED;
            PG8_LDA(At, 0, 1); PG8_STAGE(PG8_SB(0, 0), b2, voffB); PG8_STAGE(PG8_SB(0, 1), b2 + hstep, voffB); PG8_STAGE(PG8_SA(0, 0), a2, voffA);
            PG8_WAIT_V(8); PG8_WAIT_L(0); PG8_BAR; PG8_MMA(1, 0, At, B0); PG8_MMA(1, 1, At, B1); PG8_BAR; PG8_SCHED;
            PG8_LDB(B0, 1, 0); PG8_LDB(B1, 1, 1); PG8_SCHED; PG8_LDA(At, 1, 0); PG8_STAGE(PG8_SA(0, 1), a2 + hstep, voffA);
            PG8_WAIT_V(8); PG8_WAIT_L(0); PG8_BAR; PG8_MMA(0, 0, At, B0); PG8_MMA(0, 1, At, B1); PG8_BAR; PG8_SCHED;
            PG8_LDA(At, 1, 1); PG8_STAGE(PG8_SB(1, 0), b3, voffB); PG8_STAGE(PG8_SB(1, 1), b3 + hstep, voffB); PG8_STAGE(PG8_SA(1, 0), a3, voffA);
            PG8_WAIT_V(8); PG8_WAIT_L(0); PG8_BAR; PG8_MMA(1, 0, At, B0); PG8_MMA(1, 1, At, B1); PG8_BAR; PG8_SCHED;
            } else {
            PG8_LDB(B0, 0, 0); PG8_SCHED; PG8_LDA(At, 0, 0); PG8_STAGE(PG8_SA(1, 1), a1 + hstep, voffA);
            PG8_WAIT_L(8); PG8_BAR; PG8_WAIT_L(0); PG8_MMA(0, 0, At, B0); PG8_BAR; PG8_SCHED;
            PG8_LDB(B1, 0, 1); PG8_STAGE(PG8_SB(0, 0), b2, voffB);
            PG8_BAR; PG8_WAIT_L(0); PG8_MMA(0, 1, At, B1); PG8_BAR;
            PG8_LDA(At, 0, 1); PG8_STAGE(PG8_SA(0, 0), a2, voffA);
            PG8_BAR; PG8_WAIT_L(0); PG8_MMA(1, 0, At, B0); PG8_BAR; PG8_SCHED;
            PG8_STAGE(PG8_SB(0, 1), b2 + hstep, voffB);
            PG8_WAIT_V(6); PG8_BAR; PG8_MMA(1, 1, At, B1); PG8_BAR;
            PG8_LDB(B0, 1, 0); PG8_SCHED; PG8_LDA(At, 1, 0); PG8_STAGE(PG8_SA(0, 1), a2 + hstep, voffA);
            PG8_WAIT_L(8); PG8_BAR; PG8_WAIT_L(0); PG8_MMA(0, 0, At, B0); PG8_BAR; PG8_SCHED;
            PG8_LDB(B1, 1, 1); PG8_STAGE(PG8_SB(1, 0), b3, voffB);
            PG8_BAR; PG8_WAIT_L(0); PG8_MMA(0, 1, At, B1); PG8_BAR;
            PG8_LDA(At, 1, 1); PG8_STAGE(PG8_SA(1, 0), a3, voffA);
            PG8_BAR; PG8_WAIT_L(0); PG8_MMA(1, 0, At, B0); PG8_BAR; PG8_SCHED;
            PG8_STAGE(PG8_SB(1, 1), b3 + hstep, voffB);
            PG8_WAIT_V(6); PG8_BAR; PG8_MMA(1, 1, At, B1); PG8_BAR;
            }
        }
        if constexpr (ALIGN_EPI) { if (wr == 0) PG8_BAR; }
        if constexpr (!Epi::AFTER_DRAIN) { E(acc, cur, wr, wc, fr, fq); S.done(cur); }
        if (!has_next) break;
#pragma unroll
        for (int a = 0; a < 2; ++a)
#pragma unroll
            for (int b = 0; b < 2; ++b)
#pragma unroll
                for (int m = 0; m < 4; ++m)
#pragma unroll
                    for (int n = 0; n < 2; ++n) acc[a][b][m][n] = (f32x4){0.f, 0.f, 0.f, 0.f};
        cur = nxt; cA = nA; cB = nB; ++ui;
        if constexpr (ALIGN_EPI) { if (wr == 1) PG8_BAR; }
    }
    PG8_WAIT_V(0);
    if constexpr (!ALIGN_EPI) { if (wr == 0) PG8_BAR; }
    PG8_BAR;
    if constexpr (Epi::AFTER_DRAIN) { E.fused(acc, cur, wr, wc, fr, fq, lds, wid, lane); S.done(cur); }
#undef PG8_SA
#undef PG8_SB
#undef PG8_STAGE
#undef PG8_LDA
#undef PG8_LDB
#undef PG8_MMA
#undef PG8_WAIT_V
#undef PG8_WAIT_L
#undef PG8_BAR
#undef PG8_SCHED
}
}

#define LAS __attribute__((address_space(3)))
typedef unsigned short bf16_t;
typedef short bf16x8 __attribute__((ext_vector_type(8)));
typedef float f32x4 __attribute__((ext_vector_type(4)));
typedef unsigned u32x4 __attribute__((ext_vector_type(4)));
typedef unsigned u32x2 __attribute__((ext_vector_type(2)));
constexpr int NWAVES = 8, NTHR = 512;
constexpr int NB = 8, T = 4096, D = 2048, M = NB * T;
constexpr int NC = 7168, INC = 7184;
constexpr int C_RQ = 0, C_RK = 512, C_RV = 1024, C_RG = 2048, C_GQ = 3072, C_GG = 6144;
constexpr size_t MiB = (size_t)1 << 20;
constexpr size_t WS_MOD = 0, WS_G = 1 * MiB, WS_BETA = 2 * MiB, WS_GL = 3 * MiB, WS_WOUT = 4 * MiB, WS_WIN = 12 * MiB, WS_HIN = 40 * MiB, WS_PROJ = 168 * MiB, WS_GPREP = 616 * MiB, WS_END = 904 * MiB;
constexpr int GP_W = 0, GP_QE = 16384, GP_KT = 32768, GP_AT = 49152, GP_UT = 57344, GP_BYTES = 73728;
constexpr int LDS_BYTES = 147456;
constexpr float QK_SCALE = 0.08838834764831845f;

typedef __bf16 bf16v2_t __attribute__((ext_vector_type(2)));
typedef float f32v2_t __attribute__((ext_vector_type(2)));
__device__ __forceinline__ unsigned pk2(float lo, float hi) { return __builtin_bit_cast(unsigned, __builtin_convertvector((f32v2_t){lo, hi}, bf16v2_t)); }
__device__ __forceinline__ unsigned f2bf(float f) { return (unsigned)__builtin_bit_cast(unsigned short, (__bf16)f); }
__device__ __forceinline__ float bf2f(unsigned h) { return __builtin_bit_cast(float, h << 16); }
__device__ __forceinline__ float bflo(unsigned w) { return __builtin_bit_cast(float, w << 16); }
__device__ __forceinline__ float bfhi(unsigned w) { return __builtin_bit_cast(float, w & 0xffff0000u); }
__device__ __forceinline__ float silu_f(float v) { return v * __builtin_amdgcn_rcpf(1.f + __expf(-v)); }
__device__ __forceinline__ void lds_barrier() { asm volatile("s_waitcnt lgkmcnt(0)\n\ts_barrier" ::: "memory"); }
__device__ __forceinline__ float wave_sum(float v) {
#pragma unroll
    for (int o = 1; o < 64; o <<= 1) v += __shfl_xor(v, o);
    return v;
}
__device__ __forceinline__ float sum16(float v) {
#pragma unroll
    for (int o = 1; o < 16; o <<= 1) v += __shfl_xor(v, o);
    return v;
}
template <int KS> __device__ __forceinline__ void mma_nt(f32x4& acc, const LAS bf16_t* A, int lda, const LAS bf16_t* Bt, int ldb, int lane) {
    const int r = lane & 15, g = lane >> 4;
    const LAS bf16_t* ap = A + r * lda + g * 8; const LAS bf16_t* bp = Bt + r * ldb + g * 8;
#pragma unroll
    for (int ks = 0; ks < KS; ++ks) {
        const bf16x8 a = *(const LAS bf16x8*)(ap + ks * 32); const bf16x8 b = *(const LAS bf16x8*)(bp + ks * 32);
        acc = __builtin_amdgcn_mfma_f32_16x16x32_bf16(a, b, acc, 0, 0, 0);
    }
}
__device__ __forceinline__ void unpack8(const u32x4 w, float* o) { o[0] = bflo(w.x); o[1] = bfhi(w.x); o[2] = bflo(w.y); o[3] = bfhi(w.y); o[4] = bflo(w.z); o[5] = bfhi(w.z); o[6] = bflo(w.w); o[7] = bfhi(w.w); }
__device__ __forceinline__ u32x4 pack8(const float* v) { u32x4 w; w.x = pk2(v[0], v[1]); w.y = pk2(v[2], v[3]); w.z = pk2(v[4], v[5]); w.w = pk2(v[6], v[7]); return w; }

__device__ __forceinline__ int kpos(int k) { const int kk = k & 31; return (k & ~31) + ((kk & 12) << 1) + (kk & 3) + ((kk & 16) >> 2); }
__device__ __forceinline__ bf16x8 pack_tiles(const f32x4 lo, const f32x4 hi) { u32x4 w; w.x = pk2(lo[0], lo[1]); w.y = pk2(lo[2], lo[3]); w.z = pk2(hi[0], hi[1]); w.w = pk2(hi[2], hi[3]); return __builtin_bit_cast(bf16x8, w); }

__device__ __forceinline__ void p0_transpose_item(const float* W, int ldw, int K, bf16_t* WT, LAS float* scr, int nblk, int item, int lane) {
    const int kb = item / nblk, nb = item % nblk, k0 = 64 * kb, n0 = 32 * nb;
#pragma unroll 8
    for (int i = 0; i < 32; ++i) { const int kk = 2 * i + (lane >> 5); scr[kk * 33 + (lane & 31)] = W[(size_t)(k0 + kk) * ldw + n0 + (lane & 31)]; }
    asm volatile("s_waitcnt lgkmcnt(0)" ::: "memory");
    const int c = lane & 7;
#pragma unroll
    for (int j = 0; j < 4; ++j) { const int n = (lane >> 3) + 8 * j; const LAS float* s = scr + (8 * c) * 33 + n;
        u32x4 o; o.x = pk2(s[0 * 33], s[1 * 33]); o.y = pk2(s[2 * 33], s[3 * 33]); o.z = pk2(s[4 * 33], s[5 * 33]); o.w = pk2(s[6 * 33], s[7 * 33]);
        *(u32x4*)(WT + (size_t)(n0 + n) * K + k0 + 8 * c) = o; }
    asm volatile("s_waitcnt lgkmcnt(0)" ::: "memory");
}
__device__ __forceinline__ void p0_phase(LAS unsigned char* lds, const float* cvec, const float* w_ada, const float* b_ada, const float* w_in, const float* w_out,
                                         float* mod, bf16_t* WinT, bf16_t* WoutT, int tid, int lane, int wave, int G, int nrep) {
    LAS float* sc = (LAS float*)lds;
    LAS float* part = (LAS float*)(lds + 65536);
    for (int blk_ = blockIdx.x; blk_ < 256 * nrep; blk_ += G) {
        const int blk = blk_ & 255; const int n0 = 24 * blk;
        for (int i = tid; i < 8 * 2048; i += NTHR) sc[i] = silu_f(cvec[i]);
        __syncthreads();
        const int kg = tid / 6, c4 = tid % 6;
        if (tid < 510) {
            float acc[8][4];
#pragma unroll
            for (int b = 0; b < 8; ++b)
#pragma unroll
                for (int j = 0; j < 4; ++j) acc[b][j] = 0.f;
            for (int k = kg; k < 2048; k += 85) {
                const f32x4 w = *(const f32x4*)(w_ada + (size_t)k * 6144 + n0 + 4 * c4);
#pragma unroll
                for (int b = 0; b < 8; ++b) { const float s = sc[b * 2048 + k]; acc[b][0] += s * w[0]; acc[b][1] += s * w[1]; acc[b][2] += s * w[2]; acc[b][3] += s * w[3]; }
            }
#pragma unroll
            for (int b = 0; b < 8; ++b)
#pragma unroll
                for (int j = 0; j < 4; ++j) part[kg * 192 + b * 24 + 4 * c4 + j] = acc[b][j];
        }
        __syncthreads();
        if (tid < 192) { float s = 0.f; for (int q = 0; q < 85; ++q) s += part[q * 192 + tid]; const int b = tid / 24, j = tid % 24; mod[b * 6144 + n0 + j] = s + b_ada[n0 + j]; }
        __syncthreads();
    }
    LAS float* scr = (LAS float*)(lds + wave * 16384);
    const int gw = blockIdx.x * NWAVES + wave, NGW = G * NWAVES;
    constexpr int I_IN = (D / 64) * (NC / 32), I_OUT = (D / 64) * (D / 32);
    for (int it_ = gw; it_ < (I_IN + I_OUT) * nrep; it_ += NGW) {
        const int it = it_ % (I_IN + I_OUT);
        if (it < I_IN) p0_transpose_item(w_in, INC, D, WinT, scr, NC / 32, it, lane);
        else p0_transpose_item(w_out, D, D, WoutT, scr, D / 32, it - I_IN, lane);
    }
}

__device__ __forceinline__ void p1_phase(LAS unsigned char* lds, const float* x, const float* w_in, const float* mod, const float* a_log, const float* dt_bias,
                                         bf16_t* hin, float* gdec, float* beta, int tid, int lane, int wave, int G, int nrep) {
    LAS float* wx = (LAS float*)lds;
    for (int k = tid; k < 2048; k += NTHR) {
        const f32x4* src = (const f32x4*)(w_in + (size_t)k * INC + NC);
#pragma unroll
        for (int q = 0; q < 4; ++q) { const f32x4 v = src[q]; wx[(4 * q + 0) * 2048 + k] = v[0]; wx[(4 * q + 1) * 2048 + k] = v[1]; wx[(4 * q + 2) * 2048 + k] = v[2]; wx[(4 * q + 3) * 2048 + k] = v[3]; }
    }
    __syncthreads();
    typedef float f32x2 __attribute__((ext_vector_type(2)));
    const int gw = blockIdx.x * NWAVES + wave, NGW = G * NWAVES;
    for (int pb_ = gw * 8; pb_ < (M / 2) * nrep; pb_ += NGW * 8)
    for (int it_ = 0; it_ < 8; ++it_) {
        const int pair = (pb_ + it_) & (M / 2 - 1);
        const size_t m0 = (size_t)2 * pair; const int b = (int)(m0 >> 12);
        const float* modb = mod + b * 6144;
        float acc0[16], acc1[16];
#pragma unroll
        for (int o = 0; o < 16; ++o) { acc0[o] = 0.f; acc1[o] = 0.f; }
#pragma unroll 2
        for (int i = 0; i < 16; ++i) {
            const int k = 2 * lane + 128 * i;
            const f32x2 sh = *(const f32x2*)(modb + k), scl = *(const f32x2*)(modb + 2048 + k);
            const f32x2 x0 = __builtin_nontemporal_load((const f32x2*)(x + m0 * D + k)), x1 = __builtin_nontemporal_load((const f32x2*)(x + (m0 + 1) * D + k));
            const float h00 = x0[0] * (1.f + scl[0]) + sh[0], h01 = x0[1] * (1.f + scl[1]) + sh[1];
            const float h10 = x1[0] * (1.f + scl[0]) + sh[0], h11 = x1[1] * (1.f + scl[1]) + sh[1];
            *(unsigned*)(hin + m0 * D + k) = pk2(h00, h01);
            *(unsigned*)(hin + (m0 + 1) * D + k) = pk2(h10, h11);
#pragma unroll
            for (int o = 0; o < 16; ++o) { const f32x2 w = *(const LAS f32x2*)(wx + o * 2048 + k); acc0[o] += h00 * w[0] + h01 * w[1]; acc1[o] += h10 * w[0] + h11 * w[1]; }
        }
#pragma unroll
        for (int sft = 0; sft < 4; ++sft) {
            const bool hiLane = (lane >> sft) & 1;
#pragma unroll
            for (int t = 0; t < (8 >> sft); ++t) {
                const float k0 = hiLane ? acc0[2 * t + 1] : acc0[2 * t], s0 = hiLane ? acc0[2 * t] : acc0[2 * t + 1];
                const float k1 = hiLane ? acc1[2 * t + 1] : acc1[2 * t], s1 = hiLane ? acc1[2 * t] : acc1[2 * t + 1];
                acc0[t] = k0 + __shfl_xor(s0, 1 << sft); acc1[t] = k1 + __shfl_xor(s1, 1 << sft);
            }
        }
        float v0 = acc0[0], v1 = acc1[0];
        v0 += __shfl_xor(v0, 16); v0 += __shfl_xor(v0, 32); v1 += __shfl_xor(v1, 16); v1 += __shfl_xor(v1, 32);
        if (lane < 8) {
            const float al = -__expf(a_log[lane]), db = dt_bias[lane];
            const float y0 = v0 + db, y1 = v1 + db;
            const float sp0 = y0 > 20.f ? y0 : log1pf(__expf(y0)), sp1 = y1 > 20.f ? y1 : log1pf(__expf(y1));
            gdec[m0 * 8 + lane] = al * sp0; gdec[(m0 + 1) * 8 + lane] = al * sp1;
        } else if (lane < 16) {
            beta[m0 * 8 + lane - 8] = 1.f / (1.f + __expf(-v0)); beta[(m0 + 1) * 8 + lane - 8] = 1.f / (1.f + __expf(-v1));
        }
    }
}

__device__ __forceinline__ void rot16(float* lo, float* hi, int pos, int d0) {
#pragma unroll
    for (int e = 0; e < 16; ++e) {
        const float fturn = exp2f(-(float)(d0 + e) * (13.287712379549449f / 64.f)) * 0.15915494309189535f;
        const double r = (double)pos * (double)fturn; const float fr = (float)(r - floor(r));
        const float sn = __builtin_amdgcn_sinf(fr), cs = __builtin_amdgcn_cosf(fr);
        const float a = lo[e], b = hi[e];
        lo[e] = a * cs - b * sn; hi[e] = a * sn + b * cs;
    }
}

__device__ __forceinline__ void gdn_prep_block(LAS unsigned char* lds, int vb, const bf16_t* proj, const float* conv_w, const float* gdec, const float* beta,
                                               unsigned char* gprep, float* glv, int tid, int lane, int wave) {
    const int h = vb & 7, pq = vb >> 3;
    LAS float* GCB = (LAS float*)(lds + 116736);
    LAS float* CW = (LAS float*)(lds + 122880);
    for (int idx = tid; idx < 1536; idx += NTHR) { const int X = idx >> 9, r = idx & 511; CW[idx] = conv_w[(r >> 7) * 3072 + X * 1024 + h * 128 + (r & 127)]; }
    const int ti_ = tid >> 3, td0_ = (tid & 7) * 16;
    u32x4 pre[3][4][2];
#define GP_ITEM(k) (((((pq + 32 * (k)) >> 6) * 8 + h) << 6) + ((pq + 32 * (k)) & 63))
#define GP_STEP0(itm, GCp) do { const int n_ = (itm) & 63, b_ = (itm) >> 9; const long mm = (long)b_ * T + n_ * 64; \
        const float g_ = gdec[(mm + lane) * 8 + h], bt_ = beta[(mm + lane) * 8 + h]; float gc = g_; \
        _Pragma("unroll") for (int off = 1; off < 64; off <<= 1) { const float t_ = __shfl_up(gc, off); if (lane >= off) gc += t_; } \
        const float glast = __shfl(gc, 63); (GCp)[lane] = gc; (GCp)[64 + lane] = bt_; (GCp)[128 + lane] = __expf(gc); (GCp)[192 + lane] = __expf(glast - gc); \
        if (lane == 0) glv[itm] = __expf(glast); } while (0)
#define GP_LOADPRE(itm) do { const int n_ = (itm) & 63, b_ = (itm) >> 9; const long mm = (long)b_ * T + n_ * 64; \
        _Pragma("unroll") for (int X = 0; X < 3; ++X) _Pragma("unroll") for (int j = 0; j < 4; ++j) { \
            if (n_ * 64 + ti_ - 3 + j >= 0) { const u32x4* p_ = (const u32x4*)(proj + (size_t)(mm + ti_ - 3 + j) * NC + C_GQ + X * 1024 + h * 128 + td0_); pre[X][j][0] = p_[0]; pre[X][j][1] = p_[1]; } \
            else { pre[X][j][0] = (u32x4){0u, 0u, 0u, 0u}; pre[X][j][1] = (u32x4){0u, 0u, 0u, 0u}; } } } while (0)
    if (wave == 0) GP_STEP0(GP_ITEM(0), GCB);
    GP_LOADPRE(GP_ITEM(0));
    lds_barrier();
    for (int k = 0; k < 16; ++k) {
    const int item = GP_ITEM(k);
    { unsigned zoff = 0; asm volatile("" : "+s"(zoff)); lds += zoff; tid += zoff; lane += zoff; }
    const int n = item & 63, b = item >> 9; const int t0 = n * 64; const long m0 = (long)b * T + t0;
    LAS bf16_t* KN = (LAS bf16_t*)lds;
    LAS bf16_t* QN = (LAS bf16_t*)(lds + 17408);
    LAS bf16_t* KBGT = (LAS bf16_t*)(lds + 34816);
    LAS bf16_t* VBT = (LAS bf16_t*)(lds + 53248);
    LAS bf16_t* KTT = (LAS bf16_t*)(lds + 71680);
    LAS bf16_t* TM = (LAS bf16_t*)(lds + 90112);
    LAS float* AM = (LAS float*)(lds + 99328);
    LAS bf16_t* AB = (LAS bf16_t*)(lds + 117760);
    LAS bf16_t* T11T = (LAS bf16_t*)(lds + 120320);
    LAS float* GC = (LAS float*)(lds + ((k & 1) ? 129024 : 116736));
    LAS float* BT = GC + 64; LAS float* EG = GC + 128; LAS float* EK = GC + 192;
    unsigned char* gp = gprep + (size_t)item * GP_BYTES;
    {
        const int i = tid >> 3, d0 = (tid & 7) * 16;
        const float bti = BT[i], egi = EG[i], eki = EK[i];
#pragma unroll
        for (int X = 0; X < 3; ++X) {
            float val[16];
#pragma unroll
            for (int e = 0; e < 16; ++e) val[e] = 0.f;
#pragma unroll
            for (int j = 0; j < 4; ++j) {
                float in[16]; unpack8(pre[X][j][0], in); unpack8(pre[X][j][1], in + 8);
                const LAS f32x4* wp = (const LAS f32x4*)(CW + (X * 4 + j) * 128 + d0);
#pragma unroll
                for (int q = 0; q < 4; ++q) { const f32x4 w = wp[q]; val[4 * q + 0] += in[4 * q + 0] * w[0]; val[4 * q + 1] += in[4 * q + 1] * w[1]; val[4 * q + 2] += in[4 * q + 2] * w[2]; val[4 * q + 3] += in[4 * q + 3] * w[3]; }
            }
            float ss = 0.f;
#pragma unroll
            for (int e = 0; e < 16; ++e) { val[e] = silu_f(val[e]); ss += val[e] * val[e]; }
            if (X < 2) {
                ss += __shfl_xor(ss, 1); ss += __shfl_xor(ss, 2); ss += __shfl_xor(ss, 4);
                const float rn = rsqrtf(ss + 1e-6f) * (X == 0 ? QK_SCALE : 1.f);
#pragma unroll
                for (int e = 0; e < 16; ++e) val[e] *= rn;
            }
            if (X == 0) {
                *(LAS u32x4*)(QN + i * 136 + d0) = pack8(val); *(LAS u32x4*)(QN + i * 136 + d0 + 8) = pack8(val + 8);
                float qe[16];
#pragma unroll
                for (int e = 0; e < 16; ++e) qe[e] = val[e] * egi;
                bf16_t* qg = (bf16_t*)(gp + GP_QE) + i * 128 + (d0 & ~31) + ((d0 & 16) >> 2);
#pragma unroll
                for (int gq = 0; gq < 4; ++gq) { u32x2 w; w.x = pk2(qe[4 * gq], qe[4 * gq + 1]); w.y = pk2(qe[4 * gq + 2], qe[4 * gq + 3]); *(u32x2*)(qg + 8 * gq) = w; }
            } else if (X == 1) {
                *(LAS u32x4*)(KN + i * 136 + d0) = pack8(val); *(LAS u32x4*)(KN + i * 136 + d0 + 8) = pack8(val + 8);
#pragma unroll
                for (int e = 0; e < 16; ++e) { KBGT[(d0 + e) * 72 + i] = (bf16_t)f2bf(val[e] * bti * egi); KTT[(d0 + e) * 72 + kpos(i)] = (bf16_t)f2bf(val[e] * eki); }
            } else {
#pragma unroll
                for (int e = 0; e < 16; ++e) VBT[(d0 + e) * 72 + i] = (bf16_t)f2bf(val[e] * bti);
            }
        }
    }
    lds_barrier();
    {
        const int c = lane & 15, g = lane >> 4;
        bf16_t* at = (bf16_t*)(gp + GP_AT);
#pragma unroll
        for (int rep = 0; rep < 2; ++rep) {
            const int tt = wave + 8 * rep, ti = tt >> 2, tj = tt & 3;
            f32x4 a1 = {0.f, 0.f, 0.f, 0.f}, a2 = {0.f, 0.f, 0.f, 0.f};
            if (tj <= ti) { mma_nt<4>(a1, KN + 16 * ti * 136, 136, KN + 16 * tj * 136, 136, lane); mma_nt<4>(a2, QN + 16 * ti * 136, 136, KN + 16 * tj * 136, 136, lane); }
            const int j = 16 * tj + c; const float gcj = GC[j];
            const f32x4 gci = *(const LAS f32x4*)(GC + 16 * ti + 4 * g), bti4 = *(const LAS f32x4*)(BT + 16 * ti + 4 * g);
            f32x4 av;
#pragma unroll
            for (int rr = 0; rr < 4; ++rr) {
                const int i = 16 * ti + 4 * g + rr;
                const float dec = (i >= j) ? __expf(gci[rr] - gcj) : 0.f;
                const float aij = (i > j) ? a1[rr] * bti4[rr] * dec : 0.f;
                av[rr] = aij;
                if (ti >= 2 && tj < 2) AB[(i - 32) * 40 + j] = (bf16_t)f2bf(aij);
                at[i * 64 + kpos(j)] = (bf16_t)f2bf((i >= j) ? a2[rr] * dec : 0.f);
            }
            *(LAS f32x4*)(AM + j * 68 + 16 * ti + 4 * g) = av;
        }
    }
    lds_barrier();
    if (k + 1 < 16) {
        GP_LOADPRE(GP_ITEM(k + 1));
        if (wave == 1) { LAS float* GCn = (k & 1) ? GCB : (LAS float*)(lds + 129024); GP_STEP0(GP_ITEM(k + 1), GCn); }
    }
    if (wave == 0) {
        const int half = lane >> 5, cl = lane & 31, c = lane & 15, g = lane >> 4;
        const LAS float* Ab = AM + (32 * half) * 68 + 32 * half;
        float sv[32];
#pragma unroll
        for (int i = 0; i < 32; ++i) sv[i] = (cl == i) ? 1.f : 0.f;
        f32x4 ca[8], cb[8];
#define SV_LD(dst, j) do { _Pragma("unroll") for (int q = ((j) + 1) / 4; q < 8; ++q) dst[q] = *(const LAS f32x4*)(Ab + (j) * 68 + 4 * q); asm volatile("" ::: "memory"); } while (0)
#define SV_FM(src, j) do { const float tj = sv[j]; _Pragma("unroll") for (int q = ((j) + 1) / 4; q < 8; ++q) _Pragma("unroll") for (int e = 0; e < 4; ++e) if (4 * q + e > (j)) sv[4 * q + e] -= src[q][e] * tj; \
        asm volatile("" : "+v"(sv[0]), "+v"(sv[1]), "+v"(sv[2]), "+v"(sv[3]), "+v"(sv[4]), "+v"(sv[5]), "+v"(sv[6]), "+v"(sv[7]), "+v"(sv[8]), "+v"(sv[9]), "+v"(sv[10]), "+v"(sv[11]), "+v"(sv[12]), "+v"(sv[13]), "+v"(sv[14]), "+v"(sv[15]) :: "memory"); \
        asm volatile("" : "+v"(sv[16]), "+v"(sv[17]), "+v"(sv[18]), "+v"(sv[19]), "+v"(sv[20]), "+v"(sv[21]), "+v"(sv[22]), "+v"(sv[23]), "+v"(sv[24]), "+v"(sv[25]), "+v"(sv[26]), "+v"(sv[27]), "+v"(sv[28]), "+v"(sv[29]), "+v"(sv[30]), "+v"(sv[31]) :: "memory"); } while (0)
        SV_LD(ca, 0);
#pragma unroll
        for (int j = 0; j < 30; j += 2) {
            SV_LD(cb, j + 1); SV_FM(ca, j);
            SV_LD(ca, j + 2); SV_FM(cb, j + 1);
        }
        SV_FM(ca, 30);
#undef SV_LD
#undef SV_FM
#pragma unroll
        for (int i = 0; i < 32; ++i) TM[(32 * half + i) * 72 + 32 * half + cl] = (bf16_t)f2bf(sv[i]);
        if (half == 0) {
#pragma unroll
            for (int i = 0; i < 32; ++i) TM[i * 72 + 32 + cl] = (bf16_t)0;
#pragma unroll
            for (int q = 0; q < 4; ++q) { u32x4 w; w.x = pk2(sv[8 * q], sv[8 * q + 1]); w.y = pk2(sv[8 * q + 2], sv[8 * q + 3]); w.z = pk2(sv[8 * q + 4], sv[8 * q + 5]); w.w = pk2(sv[8 * q + 6], sv[8 * q + 7]); *(LAS u32x4*)(T11T + cl * 40 + 8 * q) = w; }
        }
        asm volatile("s_waitcnt lgkmcnt(0)" ::: "memory");
        f32x4 X[2][2];
#pragma unroll
        for (int t2 = 0; t2 < 2; ++t2)
#pragma unroll
            for (int tc = 0; tc < 2; ++tc) { X[t2][tc] = (f32x4){0.f, 0.f, 0.f, 0.f}; mma_nt<1>(X[t2][tc], AB + 16 * t2 * 40, 40, T11T + 16 * tc * 40, 40, lane); }
#pragma unroll
        for (int t2 = 0; t2 < 2; ++t2) {
            const LAS bf16_t* trow = TM + (32 + 16 * t2 + c) * 72 + 32 + 4 * g;
            const u32x2 lo = *(const LAS u32x2*)trow, hi = *(const LAS u32x2*)(trow + 16);
            const bf16x8 af = __builtin_bit_cast(bf16x8, (u32x4){lo.x, lo.y, hi.x, hi.y});
#pragma unroll
            for (int tc = 0; tc < 2; ++tc) {
                f32x4 acc = {0.f, 0.f, 0.f, 0.f};
                acc = __builtin_amdgcn_mfma_f32_16x16x32_bf16(af, pack_tiles(X[0][tc], X[1][tc]), acc, 0, 0, 0);
#pragma unroll
                for (int rr = 0; rr < 4; ++rr) TM[(32 + 16 * t2 + 4 * g + rr) * 72 + 16 * tc + c] = (bf16_t)f2bf(-acc[rr]);
            }
        }
    }
    lds_barrier();
    {
        const int c = lane & 15, g = lane >> 4;
#pragma unroll
        for (int rep = 0; rep < 8; ++rep) {
            const int tt = wave * 8 + rep;
            f32x4 acc = {0.f, 0.f, 0.f, 0.f};
            if (tt < 32) {
                const int ti = tt >> 3, te = tt & 7;
                mma_nt<2>(acc, TM + 16 * ti * 72, 72, VBT + 16 * te * 72, 72, lane);
                u32x2 w; w.x = pk2(acc[0], acc[1]); w.y = pk2(acc[2], acc[3]);
                *(u32x2*)((bf16_t*)(gp + GP_UT) + (16 * te + c) * 64 + 16 * ti + 4 * g) = w;
            } else {
                const int t2 = tt - 32, ti = t2 >> 3, td = t2 & 7;
                mma_nt<2>(acc, KBGT + 16 * td * 72, 72, TM + 16 * ti * 72, 72, lane);
                u32x2 w; w.x = pk2(acc[0], acc[1]); w.y = pk2(acc[2], acc[3]);
                *(u32x2*)((bf16_t*)(gp + GP_W) + (16 * ti + c) * 128 + kpos(16 * td + 4 * g)) = w;
            }
        }
#pragma unroll
        for (int u = 0; u < 2; ++u) { const int q = tid + NTHR * u, d = q >> 3, part = q & 7; *(u32x4*)(gp + GP_KT + (size_t)q * 16) = *(const LAS u32x4*)(KTT + d * 72 + part * 8); }
    }
    lds_barrier();
    }
#undef GP_ITEM
#undef GP_STEP0
#undef GP_LOADPRE
}

__device__ __forceinline__ void ret_kv_item(LAS unsigned char* lds, int item, const bf16_t* proj, float* KV, int tid, int lane, int wave) {
    const int n = item & 31, bh = item >> 5, h = bh & 3, b = bh >> 2;
    const int t0 = n * 128; const size_t m0 = (size_t)b * T + t0;
    LAS bf16_t* VT = (LAS bf16_t*)lds;
    LAS bf16_t* KDT = (LAS bf16_t*)(lds + 69632);
    const float lg = __logf(1.f - exp2f(-5.f - (float)h));
    {
        const int j = tid >> 2, part = tid & 3, d0 = 16 * part;
        const bf16_t* kp = proj + (m0 + j) * NC + C_RK + h * 128 + d0;
        float lo[16], hi[16];
        unpack8(((const u32x4*)kp)[0], lo); unpack8(((const u32x4*)kp)[1], lo + 8); unpack8(((const u32x4*)(kp + 64))[0], hi); unpack8(((const u32x4*)(kp + 64))[1], hi + 8);
        rot16(lo, hi, t0 + j, d0);
        const float kdec = __expf(lg * (float)(127 - j)) * QK_SCALE;
#pragma unroll
        for (int e = 0; e < 16; ++e) { KDT[(d0 + e) * 136 + j] = (bf16_t)f2bf(lo[e] * kdec); KDT[(64 + d0 + e) * 136 + j] = (bf16_t)f2bf(hi[e] * kdec); }
        const int e0 = 64 * part;
        const u32x4* vp = (const u32x4*)(proj + (m0 + j) * NC + C_RV + h * 256 + e0);
#pragma unroll
        for (int q = 0; q < 8; ++q) { const u32x4 w = vp[q]; const unsigned ww[4] = {w.x, w.y, w.z, w.w};
#pragma unroll
            for (int p = 0; p < 4; ++p) { VT[(e0 + 8 * q + 2 * p) * 136 + j] = (bf16_t)(ww[p] & 0xffffu); VT[(e0 + 8 * q + 2 * p + 1) * 136 + j] = (bf16_t)(ww[p] >> 16); } }
    }
    lds_barrier();
    {
        const int c = lane & 15, g = lane >> 4;
        bf16_t* kv = (bf16_t*)KV + (size_t)item * 32768;
#pragma unroll
        for (int r2 = 0; r2 < 2; ++r2) {
            const int te = 2 * wave + r2;
#pragma unroll
            for (int td = 0; td < 8; ++td) {
                f32x4 acc = {0.f, 0.f, 0.f, 0.f};
                mma_nt<4>(acc, KDT + 16 * td * 136, 136, VT + 16 * te * 136, 136, lane);
                u32x2 w; w.x = pk2(acc[0], acc[1]); w.y = pk2(acc[2], acc[3]);
                *(u32x2*)(kv + (16 * te + c) * 128 + 16 * td + 4 * g) = w;
            }
        }
    }
    lds_barrier();
}

constexpr int SC_UT = 62464, SC_GL = 67072, SC_BUF = 67088;
__device__ __forceinline__ void gdn_scan_task(LAS unsigned char* lds, int s, int slice, const unsigned char* gprep, const float* glv, bf16_t* mixed, float* KV, int rs_blk, int tid, int lane, int wave) {
    const int b = s >> 3, h = s & 7;
    const int c = lane & 15, g = lane >> 4, e0 = 32 * slice + 16 * (wave & 1);
    u32x4 SU[8]; bf16x8 Sb[4];
#pragma unroll
    for (int td = 0; td < 8; ++td) SU[td] = (u32x4){0u, 0u, 0u, 0u};
#pragma unroll
    for (int q = 0; q < 4; ++q) Sb[q] = (bf16x8){0, 0, 0, 0, 0, 0, 0, 0};
    u32x4 pf[8];
    const unsigned char* gp0 = gprep + (size_t)(s * 64) * GP_BYTES;
#define SC_LOAD(gq) do { _Pragma("unroll") for (int u = 0; u < 2; ++u) { pf[u] = *(const u32x4*)((gq) + GP_W + (size_t)(tid + NTHR * u) * 16); pf[2 + u] = *(const u32x4*)((gq) + GP_QE + (size_t)(tid + NTHR * u) * 16); \
        pf[5 + u] = *(const u32x4*)((gq) + GP_KT + (size_t)(tid + NTHR * u) * 16); } pf[4] = *(const u32x4*)((gq) + GP_AT + (size_t)tid * 16); \
        if (tid >= 256) pf[7] = *(const u32x4*)((gq) + GP_UT + (size_t)(32 * slice + ((tid - 256) >> 3)) * 128 + ((tid - 256) & 7) * 16); } while (0)
#define SC_STORE(bufp, itm) do { if (tid >= 256) *(LAS u32x4*)((bufp) + SC_UT + ((tid - 256) >> 3) * 144 + ((tid - 256) & 7) * 16) = pf[7]; if (tid == 255) *(LAS float*)((bufp) + SC_GL) = glv[itm]; \
        _Pragma("unroll") for (int u = 0; u < 2; ++u) { const int q = tid + NTHR * u; \
        *(LAS u32x4*)((LAS bf16_t*)(bufp) + (q >> 4) * 136 + (q & 15) * 8) = pf[u]; *(LAS u32x4*)((LAS bf16_t*)((bufp) + 17408) + (q >> 4) * 136 + (q & 15) * 8) = pf[2 + u]; \
        *(LAS u32x4*)((LAS bf16_t*)((bufp) + 44032) + (q >> 3) * 72 + (q & 7) * 8) = pf[5 + u]; } \
        *(LAS u32x4*)((LAS bf16_t*)((bufp) + 34816) + (tid >> 3) * 72 + (tid & 7) * 8) = pf[4]; } while (0)
    SC_LOAD(gp0); SC_STORE(lds, s * 64); SC_LOAD(gp0 + GP_BYTES);
    lds_barrier();
    for (int n = 0; n < 64; ++n) {
        LAS unsigned char* cur = lds + (n & 1) * SC_BUF; LAS unsigned char* nxt = lds + ((n + 1) & 1) * SC_BUF;
        const unsigned char* gp = gp0 + (size_t)n * GP_BYTES;
        if (n >= 1 && tid >= 128 && tid < 384) {
            const int u = tid - 128;
            const LAS bf16_t* OLp = (const LAS bf16_t*)(lds + 2 * SC_BUF + ((n - 1) & 1) * 5120);
            *(u32x4*)(mixed + ((size_t)b * T + (n - 1) * 64 + (u >> 2)) * D + 1024 + h * 128 + 32 * slice + (u & 3) * 8) = *(const LAS u32x4*)(OLp + (u >> 2) * 40 + (u & 3) * 8);
        }
        if (n + 1 < 64) SC_STORE(nxt, s * 64 + n + 1);
        if (n + 2 < 64) SC_LOAD(gp + 2 * GP_BYTES);
        if (wave >= 2 && rs_blk >= 0 && n < 7) {
            const int u = tid - 128;
            if (n >= 1 && (n - 1) * 384 + u < 2048) {
                const int cp = rs_blk * 2048 + (n - 1) * 384 + u, stream = cp >> 14;
                const float dec = __expf(128.f * __logf(1.f - exp2f(-5.f - (float)(stream & 3))));
                unsigned* p = (unsigned*)((bf16_t*)KV + (size_t)stream * 32 * 32768) + (cp & 16383);
                float st0 = 0.f, st1 = 0.f;
#pragma unroll
                for (int i = 0; i < 32; ++i) { const unsigned w = SU[i >> 2][i & 3]; p[(size_t)i * 16384] = pk2(st0, st1); st0 = st0 * dec + bflo(w); st1 = st1 * dec + bfhi(w); }
            }
            if (n < 6 && n * 384 + u < 2048) {
                const int cp = rs_blk * 2048 + n * 384 + u, stream = cp >> 14;
                const unsigned* p = (const unsigned*)((const bf16_t*)KV + (size_t)stream * 32 * 32768) + (cp & 16383);
#pragma unroll
                for (int i = 0; i < 32; ++i) SU[i >> 2][i & 3] = p[(size_t)i * 16384];
            }
        }
        if (wave < 2) {
            const LAS bf16_t* WL = (const LAS bf16_t*)cur; const LAS bf16_t* QE = (const LAS bf16_t*)(cur + 17408); const LAS bf16_t* AT = (const LAS bf16_t*)(cur + 34816); const LAS bf16_t* KT = (const LAS bf16_t*)(cur + 44032);
            const size_t m0 = (size_t)b * T + n * 64;
            const float gl = *(const LAS float*)(cur + SC_GL);
#define SC_SB __builtin_amdgcn_sched_barrier(0)
#define SC_LDP(dst, ti) do { _Pragma("unroll") for (int q = 0; q < 4; ++q) { dst[q] = *(const LAS bf16x8*)(WL + (16 * (ti) + c) * 136 + 32 * q + 8 * g); dst[4 + q] = *(const LAS bf16x8*)(QE + (16 * (ti) + c) * 136 + 32 * q + 8 * g); } } while (0)
#define SC_MMP(src, ti) do { _Pragma("unroll") for (int q = 0; q < 4; ++q) { P[ti] = __builtin_amdgcn_mfma_f32_16x16x32_bf16(src[q], Sb[q], P[ti], 0, 0, 0); O[ti] = __builtin_amdgcn_mfma_f32_16x16x32_bf16(src[4 + q], Sb[q], O[ti], 0, 0, 0); } } while (0)
#define SC_LDK(dst, t0) do { _Pragma("unroll") for (int t = 0; t < 4; ++t) _Pragma("unroll") for (int q = 0; q < 2; ++q) dst[2 * t + q] = *(const LAS bf16x8*)(KT + (16 * ((t0) + t) + c) * 72 + 32 * q + 8 * g); } while (0)
#define SC_MMK(src, t0) do { _Pragma("unroll") for (int t = 0; t < 4; ++t) { f32x4 a = __builtin_bit_cast(f32x4, SU[(t0) + t]) * gl; _Pragma("unroll") for (int q = 0; q < 2; ++q) a = __builtin_amdgcn_mfma_f32_16x16x32_bf16(src[2 * t + q], Vb[q], a, 0, 0, 0); SU[(t0) + t] = __builtin_bit_cast(u32x4, a); } } while (0)
            f32x4 P[4], O[4];
#pragma unroll
            for (int ti = 0; ti < 4; ++ti) { P[ti] = (f32x4){0.f, 0.f, 0.f, 0.f}; O[ti] = (f32x4){0.f, 0.f, 0.f, 0.f}; }
            bf16x8 fa[8], fb[8];
            SC_LDP(fa, 0);
            SC_LDP(fb, 1); SC_SB; SC_MMP(fa, 0); SC_SB;
            SC_LDP(fa, 2); SC_SB; SC_MMP(fb, 1); SC_SB;
            SC_LDP(fb, 3); SC_SB; SC_MMP(fa, 2); SC_SB;
#pragma unroll
            for (int ti = 0; ti < 4; ++ti)
#pragma unroll
                for (int q = 0; q < 2; ++q) fa[2 * ti + q] = *(const LAS bf16x8*)(AT + (16 * ti + c) * 72 + 32 * q + 8 * g);
            SC_SB; SC_MMP(fb, 3); SC_SB;
            u32x2 ut[4];
#pragma unroll
            for (int ti = 0; ti < 4; ++ti) ut[ti] = *(const LAS u32x2*)((const LAS bf16_t*)(cur + SC_UT) + (16 * (wave & 1) + c) * 72 + 16 * ti + 4 * g);
            f32x4 vn[4];
#pragma unroll
            for (int ti = 0; ti < 4; ++ti) vn[ti] = (f32x4){bflo(ut[ti].x) - P[ti][0], bfhi(ut[ti].x) - P[ti][1], bflo(ut[ti].y) - P[ti][2], bfhi(ut[ti].y) - P[ti][3]};
            bf16x8 Vb[2];
            Vb[0] = pack_tiles(vn[0], vn[1]); Vb[1] = pack_tiles(vn[2], vn[3]);
            SC_LDK(fb, 0); SC_SB;
#pragma unroll
            for (int ti = 0; ti < 4; ++ti)
#pragma unroll
                for (int q = 0; q < 2; ++q) O[ti] = __builtin_amdgcn_mfma_f32_16x16x32_bf16(fa[2 * ti + q], Vb[q], O[ti], 0, 0, 0);
            SC_SB;
            SC_LDK(fa, 4); SC_SB; SC_MMK(fb, 0); SC_SB;
            SC_MMK(fa, 4);
#undef SC_SB
#undef SC_LDP
#undef SC_MMP
#undef SC_LDK
#undef SC_MMK
#pragma unroll
            for (int q = 0; q < 4; ++q) Sb[q] = pack_tiles(__builtin_bit_cast(f32x4, SU[2 * q]), __builtin_bit_cast(f32x4, SU[2 * q + 1]));
            LAS bf16_t* OL = (LAS bf16_t*)(lds + 2 * SC_BUF + (n & 1) * 5120) + (4 * g) * 40 + 16 * (wave & 1) + c;
#pragma unroll
            for (int ti = 0; ti < 4; ++ti)
#pragma unroll
                for (int rr = 0; rr < 4; ++rr) OL[(16 * ti + rr) * 40] = (bf16_t)f2bf(O[ti][rr]);
        }
        lds_barrier();
    }
    if (tid >= 128 && tid < 384) {
        const int u = tid - 128;
        const LAS bf16_t* OLp = (const LAS bf16_t*)(lds + 2 * SC_BUF + 5120);
        *(u32x4*)(mixed + ((size_t)b * T + 63 * 64 + (u >> 2)) * D + 1024 + h * 128 + 32 * slice + (u & 3) * 8) = *(const LAS u32x4*)(OLp + (u >> 2) * 40 + (u & 3) * 8);
    }
    lds_barrier();
#undef SC_LOAD
#undef SC_STORE
}
__device__ __forceinline__ void gdn_norm_rows(const bf16_t* proj, const float* norm_w, bf16_t* mixed, int lane, int wave, int G) {
    const int gw = blockIdx.x * NWAVES + wave, NGW = G * NWAVES;
    float nw[16];
#pragma unroll
    for (int q = 0; q < 4; ++q) { const f32x4 w = *(const f32x4*)(norm_w + (lane & 7) * 16 + 4 * q); nw[4 * q] = w[0]; nw[4 * q + 1] = w[1]; nw[4 * q + 2] = w[2]; nw[4 * q + 3] = w[3]; }
    for (int m = gw; m < M; m += NGW) {
        bf16_t* op = mixed + (size_t)m * D + 1024 + lane * 16;
        const bf16_t* gq = proj + (size_t)m * NC + C_GG + lane * 16;
        float o[16], gg[16];
        unpack8(((const u32x4*)op)[0], o); unpack8(((const u32x4*)op)[1], o + 8); unpack8(__builtin_nontemporal_load((const u32x4*)gq), gg); unpack8(__builtin_nontemporal_load((const u32x4*)gq + 1), gg + 8);
        float ss = 0.f;
#pragma unroll
        for (int e = 0; e < 16; ++e) ss += o[e] * o[e];
        ss += __shfl_xor(ss, 1); ss += __shfl_xor(ss, 2); ss += __shfl_xor(ss, 4);
        const float rstd = rsqrtf(ss * (1.f / 128.f) + 1e-6f);
#pragma unroll
        for (int e = 0; e < 16; ++e) o[e] = o[e] * rstd * nw[e] * silu_f(gg[e]);
        ((u32x4*)op)[0] = pack8(o); ((u32x4*)op)[1] = pack8(o + 8);
    }
}

__device__ __forceinline__ void ret_scan(float* KV, float* KVdst, int tid, int first_blk, int G) {
    const long nthreads = (long)(G - first_blk) * NTHR, gid = (long)(blockIdx.x - first_blk) * NTHR + tid;
    for (long cp = gid; cp < 32L * 16384; cp += nthreads) {
        const int stream = (int)(cp >> 14), h = stream & 3;
        const float dec = __expf(128.f * __logf(1.f - exp2f(-5.f - (float)h)));
        const unsigned* p = (const unsigned*)((const bf16_t*)KV + (size_t)stream * 32 * 32768) + (cp & 16383);
        unsigned* pd = (unsigned*)((bf16_t*)KVdst + (size_t)stream * 32 * 32768) + (cp & 16383);
        unsigned kv[32];
#pragma unroll
        for (int n = 0; n < 32; ++n) kv[n] = p[(size_t)n * 16384];
        float st0 = 0.f, st1 = 0.f;
#pragma unroll
        for (int n = 0; n < 32; ++n) { pd[(size_t)n * 16384] = pk2(st0, st1); st0 = st0 * dec + bflo(kv[n]); st1 = st1 * dec + bfhi(kv[n]); }
    }
}

__device__ __forceinline__ void ret_out_item(LAS unsigned char* lds, int item, const bf16_t* proj, const float* KV, const float* gn_w, const float* gn_b, bf16_t* mixed, int tid, int lane, int wave) {
    const int n = item & 31, bh = item >> 5, h = bh & 3, b = bh >> 2;
    const int t0 = n * 128; const size_t m0 = (size_t)b * T + t0;
    LAS bf16_t* QS = (LAS bf16_t*)lds;
    LAS bf16_t* KD = (LAS bf16_t*)(lds + 34816);
    LAS bf16_t* VT = (LAS bf16_t*)(lds + 69632);
    LAS bf16_t* ST = (LAS bf16_t*)(lds + 104448);
    const float lg = __logf(1.f - exp2f(-5.f - (float)h));
    const int c = lane & 15, g = lane >> 4;
    {
        const int j = tid >> 2, part = tid & 3, d0 = 16 * part;
        float lo[16], hi[16];
        const bf16_t* qp = proj + (m0 + j) * NC + C_RQ + h * 128 + d0;
        unpack8(((const u32x4*)qp)[0], lo); unpack8(((const u32x4*)qp)[1], lo + 8); unpack8(((const u32x4*)(qp + 64))[0], hi); unpack8(((const u32x4*)(qp + 64))[1], hi + 8);
        rot16(lo, hi, t0 + j, d0);
        *(LAS u32x4*)(QS + j * 136 + d0) = pack8(lo); *(LAS u32x4*)(QS + j * 136 + d0 + 8) = pack8(lo + 8);
        *(LAS u32x4*)(QS + j * 136 + 64 + d0) = pack8(hi); *(LAS u32x4*)(QS + j * 136 + 64 + d0 + 8) = pack8(hi + 8);
        const bf16_t* kp = proj + (m0 + j) * NC + C_RK + h * 128 + d0;
        unpack8(((const u32x4*)kp)[0], lo); unpack8(((const u32x4*)kp)[1], lo + 8); unpack8(((const u32x4*)(kp + 64))[0], hi); unpack8(((const u32x4*)(kp + 64))[1], hi + 8);
        rot16(lo, hi, t0 + j, d0);
#pragma unroll
        for (int e = 0; e < 16; ++e) { lo[e] *= QK_SCALE; hi[e] *= QK_SCALE; }
        *(LAS u32x4*)(KD + j * 136 + d0) = pack8(lo); *(LAS u32x4*)(KD + j * 136 + d0 + 8) = pack8(lo + 8);
        *(LAS u32x4*)(KD + j * 136 + 64 + d0) = pack8(hi); *(LAS u32x4*)(KD + j * 136 + 64 + d0 + 8) = pack8(hi + 8);
    }
    lds_barrier();
    f32x4 sc[8];
#pragma unroll
    for (int tj = 0; tj < 8; ++tj) { sc[tj] = (f32x4){0.f, 0.f, 0.f, 0.f}; if (tj <= wave) mma_nt<4>(sc[tj], QS + 16 * wave * 136, 136, KD + 16 * tj * 136, 136, lane); }
    lds_barrier();
#pragma unroll
    for (int tj = 0; tj < 8; ++tj) {
        const int j = 16 * tj + c; const float gpw = __expf(-lg * (float)(j + 1));
#pragma unroll
        for (int rr = 0; rr < 4; ++rr) { const int i = 16 * wave + 4 * g + rr; KD[i * 136 + j] = (bf16_t)f2bf((i >= j) ? sc[tj][rr] * gpw : 0.f); }
    }
    f32x4 acc[16];
#pragma unroll
    for (int half = 0; half < 2; ++half) {
        if (half == 1) lds_barrier();
        {
            const int j = tid >> 2, part = tid & 3, e0 = 32 * part;
            const u32x4* vp = (const u32x4*)(proj + (m0 + j) * NC + C_RV + h * 256 + half * 128 + e0);
#pragma unroll
            for (int q = 0; q < 4; ++q) { const u32x4 w = vp[q]; const unsigned ww[4] = {w.x, w.y, w.z, w.w};
#pragma unroll
                for (int p = 0; p < 4; ++p) { VT[(e0 + 8 * q + 2 * p) * 136 + j] = (bf16_t)(ww[p] & 0xffffu); VT[(e0 + 8 * q + 2 * p + 1) * 136 + j] = (bf16_t)(ww[p] >> 16); } }
            const bf16_t* kv = (const bf16_t*)KV + (size_t)item * 32768 + (size_t)half * 128 * 128;
#pragma unroll
            for (int u = 0; u < 4; ++u) { const int q = tid + NTHR * u, e = q >> 4, part = q & 15; *(LAS u32x4*)(ST + e * 136 + part * 8) = *(const u32x4*)(kv + e * 128 + part * 8); }
        }
        lds_barrier();
#pragma unroll
        for (int te = 0; te < 8; ++te) {
            f32x4 a = {0.f, 0.f, 0.f, 0.f};
            mma_nt<4>(a, VT + 16 * te * 136, 136, KD + 16 * wave * 136, 136, lane);
            mma_nt<4>(a, ST + 16 * te * 136, 136, QS + 16 * wave * 136, 136, lane);
            acc[half * 8 + te] = a;
        }
    }
    {
        const int i = 16 * wave + c;
        const float qd = __expf(lg * (float)(i + 1));
        float sm = 0.f;
#pragma unroll
        for (int t = 0; t < 16; ++t) { acc[t] = acc[t] * qd; sm += (acc[t][0] + acc[t][1]) + (acc[t][2] + acc[t][3]); }
        sm += __shfl_xor(sm, 16); sm += __shfl_xor(sm, 32);
        const float mean = sm * (1.f / 256.f);
        float v = 0.f;
#pragma unroll
        for (int t = 0; t < 16; ++t) { acc[t] = acc[t] - mean; v += (acc[t][0] * acc[t][0] + acc[t][1] * acc[t][1]) + (acc[t][2] * acc[t][2] + acc[t][3] * acc[t][3]); }
        v += __shfl_xor(v, 16); v += __shfl_xor(v, 32);
        const float rstd = rsqrtf(v * (1.f / 256.f) + 1e-5f);
        const bf16_t* rg = proj + (m0 + i) * NC + C_RG + h * 256 + 4 * g;
        bf16_t* mo = mixed + (m0 + i) * D + h * 256 + 4 * g;
        const float* gw_ = gn_w + h * 256 + 4 * g; const float* gb_ = gn_b + h * 256 + 4 * g;
#pragma unroll
        for (int t = 0; t < 16; ++t) {
            const u32x2 rgv = *(const u32x2*)(rg + 16 * t);
            const f32x4 w4 = *(const f32x4*)(gw_ + 16 * t), b4 = *(const f32x4*)(gb_ + 16 * t);
            const f32x4 o = acc[t] * rstd * w4 + b4;
            u32x2 w; w.x = pk2(o[0] * silu_f(bflo(rgv.x)), o[1] * silu_f(bfhi(rgv.x))); w.y = pk2(o[2] * silu_f(bflo(rgv.y)), o[3] * silu_f(bfhi(rgv.y)));
            *(u32x2*)(mo + 16 * t) = w;
        }
    }
    lds_barrier();
}

__device__ __forceinline__ void ln_rows(const bf16_t* z, float* dst, const float* ln_w, const float* ln_b, int lane, int wave, int G) {
    const int gw = blockIdx.x * NWAVES + wave, NGW = G * NWAVES;
    for (int m = gw; m < M; m += NGW) {
        const u32x4* zr = (const u32x4*)(z + (size_t)m * D) + lane;
        float v[4][8]; float s = 0.f;
#pragma unroll
        for (int j = 0; j < 4; ++j) { unpack8(__builtin_nontemporal_load(zr + 64 * j), v[j]);
#pragma unroll
            for (int e = 0; e < 8; ++e) s += v[j][e]; }
        const float mean = wave_sum(s) * (1.f / D); float s2 = 0.f;
#pragma unroll
        for (int j = 0; j < 4; ++j)
#pragma unroll
            for (int e = 0; e < 8; ++e) { v[j][e] -= mean; s2 += v[j][e] * v[j][e]; }
        const float rstd = rsqrtf(wave_sum(s2) * (1.f / D) + 1e-5f);
        float* drow = dst + (size_t)m * D + 8 * lane;
#pragma unroll
        for (int j = 0; j < 4; ++j) {
            const f32x4 w0 = *(const f32x4*)(ln_w + 8 * lane + 512 * j), w1 = *(const f32x4*)(ln_w + 8 * lane + 512 * j + 4);
            const f32x4 b0 = *(const f32x4*)(ln_b + 8 * lane + 512 * j), b1 = *(const f32x4*)(ln_b + 8 * lane + 512 * j + 4);
            __builtin_nontemporal_store((f32x4){v[j][0], v[j][1], v[j][2], v[j][3]} * rstd * w0 + b0, (f32x4*)(drow + 512 * j));
            __builtin_nontemporal_store((f32x4){v[j][4], v[j][5], v[j][6], v[j][7]} * rstd * w1 + b1, (f32x4*)(drow + 512 * j + 4));
        }
    }
}

#ifndef MK_N_LAUNCHES
#define MK_N_LAUNCHES 1
#endif
constexpr int N_PHASES = 8;
constexpr size_t WS_CTL = 3 * MiB + 512 * 1024; constexpr int CTL_BYTES = 16384;
#define XB_TMO      128
#define XB_XCNT(j)  (256  + 64 * (j))
#define XB_XSUB(j)  (1280 + 64 * (j))
#define XB_XGEN(j)  (2304 + 64 * (j))
#define XB_TOP      3328
#define XB_TOPGEN   3392
#define XCD_BAR_WORDS 3456
#define XB_SPIN_CAP (1u << 18)

__device__ __forceinline__ unsigned xb_ld(unsigned* p)              { return __hip_atomic_load(p, __ATOMIC_RELAXED, __HIP_MEMORY_SCOPE_AGENT); }
__device__ __forceinline__ unsigned xb_add(unsigned* p, unsigned v) { return __hip_atomic_fetch_add(p, v, __ATOMIC_RELAXED, __HIP_MEMORY_SCOPE_AGENT); }
__device__ __forceinline__ unsigned xb_xcc_id() { return (unsigned)__builtin_amdgcn_s_getreg((3 << 11) | 20) & 0xFu; }
#define XB_SPIN(cond, bar) do { unsigned _sp = 0; while (cond) { __builtin_amdgcn_s_sleep(1); \
    if ((++_sp & 255u) == 0u) { if (xb_ld(&(bar)[XB_TMO])) break; if (_sp > XB_SPIN_CAP) { atomicAdd(&(bar)[XB_TMO], 1u); break; } } } } while (0)

struct XcdBarrier {
    unsigned* bar; unsigned x;
    volatile LAS unsigned* st;
};

__device__ __forceinline__ XcdBarrier xcd_barrier_post(unsigned* bar, volatile LAS unsigned* st) {
    XcdBarrier b; b.bar = bar; b.x = xb_xcc_id(); b.st = st;
    if (threadIdx.x == 0) (void)xb_add(&bar[XB_XCNT(b.x)], 1u);
    return b;
}
__device__ __forceinline__ void xcd_barrier_complete(unsigned* bar, unsigned x, unsigned& nloc, unsigned& nx) {
    const unsigned G = gridDim.x * gridDim.y * gridDim.z;
    unsigned sum, cnt, mine, sp = 0u;
    for (;;) {
        sum = 0u; cnt = 0u; mine = 0u;
#pragma unroll
        for (unsigned j = 0; j < 16; ++j) { const unsigned c = xb_ld(&bar[XB_XCNT(j)]); sum += c; cnt += (c > 0u) ? 1u : 0u; mine = (j == x) ? c : mine; }
        if (sum == G) break;
        __builtin_amdgcn_s_sleep(1);
        if ((++sp & 255u) == 0u) { if (xb_ld(&bar[XB_TMO])) break; if (sp > XB_SPIN_CAP) { atomicAdd(&bar[XB_TMO], 1u); break; } }
    }
    nloc = mine > 0u ? mine : 1u; nx = cnt > 0u ? cnt : 1u;
}

__device__ __forceinline__ void xcd_barrier(const XcdBarrier& b) {
    asm volatile("s_waitcnt vmcnt(0)" ::: "memory");
    __syncthreads();
    if (threadIdx.x == 0) {
        unsigned* bar = b.bar;
        __builtin_amdgcn_s_waitcnt(0);
        unsigned nloc = b.st[0], nx = b.st[1];
        if (nloc == 0u) { xcd_barrier_complete(bar, b.x, nloc, nx); b.st[0] = nloc; b.st[1] = nx; }
        const unsigned old = xb_add(&bar[XB_XSUB(b.x)], 1u);
        const unsigned gen = old / nloc;
        if (old + 1u == (gen + 1u) * nloc) {
            __builtin_amdgcn_fence(__ATOMIC_RELEASE, "agent");
            asm volatile("s_waitcnt vmcnt(0)" ::: "memory");
            const unsigned og = xb_add(&bar[XB_TOP], 1u);
            const unsigned tg = og / nx;
            if (og + 1u == (tg + 1u) * nx) xb_add(&bar[XB_TOPGEN], 1u);
            else XB_SPIN(xb_ld(&bar[XB_TOPGEN]) == tg, bar);
            __builtin_amdgcn_fence(__ATOMIC_ACQUIRE, "agent");
            xb_add(&bar[XB_XGEN(b.x)], 1u);
            asm volatile("s_waitcnt vmcnt(0)" ::: "memory");
        } else {
            XB_SPIN(xb_ld(&bar[XB_XGEN(b.x)]) == gen, bar);
            __builtin_amdgcn_fence(__ATOMIC_ACQUIRE, "agent");
            asm volatile("s_waitcnt vmcnt(0)" ::: "memory");
        }
    }
    __syncthreads();
}

struct Args { const float* in[14]; float* out; unsigned char* ws; int ph_lo, ph_hi, nsync, pad; };
__global__ void __launch_bounds__(NTHR) hybrid_fwd(Args args) {
    extern __shared__ __attribute__((aligned(16))) unsigned char lds_raw[];
    LAS unsigned char* lds = (LAS unsigned char*)lds_raw;
    cg::grid_group grid = cg::this_grid();
    const int tid = threadIdx.x, lane = tid & 63, wave = __builtin_amdgcn_readfirstlane(tid >> 6), G = gridDim.x;
    const float* x = args.in[0]; const float* cvec = args.in[1]; const float* w_ada = args.in[2]; const float* b_ada = args.in[3]; const float* w_in = args.in[4];
    const float* conv_w = args.in[5]; const float* a_log = args.in[6]; const float* dt_bias = args.in[7]; const float* gn_w = args.in[8]; const float* gn_b = args.in[9];
    const float* norm_w = args.in[10]; const float* w_out = args.in[11]; const float* ln_w = args.in[12]; const float* ln_b = args.in[13];
    unsigned char* ws = args.ws; float* out = args.out;
    float* mod = (float*)(ws + WS_MOD); float* gdec = (float*)(ws + WS_G); float* beta = (float*)(ws + WS_BETA); float* glv = (float*)(ws + WS_GL);
    bf16_t* WoutT = (bf16_t*)(ws + WS_WOUT); bf16_t* WinT = (bf16_t*)(ws + WS_WIN); bf16_t* hin = (bf16_t*)(ws + WS_HIN); bf16_t* mixed = hin;
    bf16_t* proj = (bf16_t*)(ws + WS_PROJ); unsigned char* gprep = ws + WS_GPREP; float* KV = out;
    const int lo = args.ph_lo, hi = args.ph_hi;
#define IN(k) (lo <= (k) && (k) < hi)
#define SEAM(k) do { if (IN(k) && IN((k) + 1)) xcd_barrier(bar); } while (0)

    volatile LAS unsigned* bst = (volatile LAS unsigned*)(lds + LDS_BYTES - 16);
    if (tid == 0) { bst[0] = 0u; bst[1] = 0u; }
    __syncthreads();
    XcdBarrier bar = xcd_barrier_post((unsigned*)(ws + WS_CTL), bst);
    for (int i = 0; i < args.nsync; ++i) grid.sync();
    if (IN(0)) p0_phase(lds, cvec, w_ada, b_ada, w_in, w_out, mod, WinT, WoutT, tid, lane, wave, G, 1);
    SEAM(0);
    if (IN(1)) p1_phase(lds, x, w_in, mod, a_log, dt_bias, hin, gdec, beta, tid, lane, wave, G, 1);
    SEAM(1);
    if (IN(2)) {
        pg8::Gemm g{hin, WinT, M, NC, D}; pg8::StaticOrder S; S.init(M, NC, G, (int)blockIdx.x, 1);
        pg8::EpiBf16 E{proj, NC};
        pg8::gemm_phase<pg8::EpiBf16, pg8::StaticOrder, true, true>(lds, g, S, E);
    }
    SEAM(2);
    if (IN(3)) {
        for (int v = blockIdx.x; v < 256; v += G) gdn_prep_block(lds, v & 255, proj, conv_w, gdec, beta, gprep, glv, tid, lane, wave);
        for (int it = blockIdx.x; it < 1024; it += G) ret_kv_item(lds, it & 1023, proj, KV, tid, lane, wave);
    }
    SEAM(3);
    if (IN(4)) {
        const bool fuse = (G == 256);
        for (int task = blockIdx.x; task < 256; task += G) { const int tk = task & 255, xcd = tk & 7, loc = tk >> 3; gdn_scan_task(lds, xcd * 8 + (loc >> 2), loc & 3, gprep, glv, mixed, KV, (fuse && task < 256) ? tk : -1, tid, lane, wave); }
        if (!fuse) ret_scan(KV, KV, tid, 0, G);
    }
    SEAM(4);
    if (IN(5)) { gdn_norm_rows(proj, norm_w, mixed, lane, wave, G);
        for (int it = blockIdx.x; it < 1024; it += G) ret_out_item(lds, it & 1023, proj, KV, gn_w, gn_b, mixed, tid, lane, wave); }
    SEAM(5);
    if (IN(6)) {
        pg8::Gemm g{mixed, WoutT, M, D, D}; pg8::StaticOrder S; S.init(M, D, G, (int)blockIdx.x, 1);
        pg8::EpiZ16 E{x, mod + 4096, (bf16_t*)(ws + WS_PROJ), 1.189207115002721f};
        pg8::gemm_phase<pg8::EpiZ16, pg8::StaticOrder, true, true>(lds, g, S, E);
    }
    SEAM(6);
    if (IN(7)) { ln_rows((const bf16_t*)(ws + WS_PROJ), out, ln_w, ln_b, lane, wave, G); }
#undef IN
#undef SEAM
}

extern "C" void kernel_launch(void* const* d_in, const int* in_sizes, int n_in, void* d_out, int out_size, void* d_ws, size_t ws_size, hipStream_t stream) {
    static int grid = 0;
    if (grid == 0) {
        if (n_in != 14 || out_size != M * D || ws_size < WS_END) { fprintf(stderr, "kernel_launch: unexpected problem (n_in %d, out %d, ws %zu)\n", n_in, out_size, ws_size); grid = -1; return; }
        int dev = 0, cus = 0, per_cu = 0;
        if (hipGetDevice(&dev) != hipSuccess || hipDeviceGetAttribute(&cus, hipDeviceAttributeMultiprocessorCount, dev) != hipSuccess) { grid = -1; return; }
        if (hipFuncSetAttribute((const void*)hybrid_fwd, hipFuncAttributeMaxDynamicSharedMemorySize, LDS_BYTES) != hipSuccess) { fprintf(stderr, "kernel_launch: hipFuncSetAttribute failed\n"); grid = -1; return; }
        if (hipOccupancyMaxActiveBlocksPerMultiprocessor(&per_cu, (const void*)hybrid_fwd, NTHR, LDS_BYTES) != hipSuccess || per_cu < 1) { fprintf(stderr, "kernel_launch: occupancy query reports %d blocks per CU\n", per_cu); (void)hipGetLastError(); per_cu = 1; }
        grid = cus * 1;
    }
    if (grid < 0) return;
    if (hipMemsetAsync((char*)d_ws + WS_CTL, 0, CTL_BYTES, stream) != hipSuccess) { fprintf(stderr, "kernel_launch: memset of the barrier words failed\n"); return; }
    Args a{};
    for (int i = 0; i < 14; ++i) a.in[i] = (const float*)d_in[i];
    a.out = (float*)d_out; a.ws = (unsigned char*)d_ws; a.nsync = 0;
    for (int li = 0; li < MK_N_LAUNCHES; ++li) {
        if (MK_N_LAUNCHES == 1) { a.ph_lo = 0; a.ph_hi = N_PHASES; } else { a.ph_lo = li; a.ph_hi = li + 1; }
        void* kargs[] = {&a};
        const hipError_t e = hipLaunchCooperativeKernel((const void*)hybrid_fwd, dim3(grid), dim3(NTHR), kargs, LDS_BYTES, stream);
        if (e != hipSuccess) { fprintf(stderr, "kernel_launch: cooperative launch failed: %s (grid %d)\n", hipGetErrorString(e), grid); break; }
    }
}
```
